# Optimizing an MI355X kernel written in HIP

```python
import jax, jax.numpy as jnp
from jax import lax
import numpy as np

D_MODEL = 2048
BATCH = 4
SEQ = 4096
DEPTH = 2

GRID_W = 64
CTX_LEN = 256
D_FF = 5632
N_MOD = 9
LN_EPS = 1e-6

RWKV_HEADS = 16
RWKV_HEAD_DIM = 64
RWKV_W = RWKV_HEADS * RWKV_HEAD_DIM
W_LORA = 64
A_LORA = 64
G_LORA = 160
RWKV_IN = 3 * RWKV_W + W_LORA + A_LORA + G_LORA
RWKV_GN_EPS = 64e-5

MLA_HEADS = 16
QK_NOPE = 128
QK_ROPE = 64
V_HEAD = 128
Q_LORA = 512
KV_LORA = 256
MLA_IN = Q_LORA + KV_LORA + QK_ROPE
MLA_W = MLA_HEADS * V_HEAD
ROPE_BASE = 10000.0
Q_BLOCK = 128

LRU_W = 1024
LRU_BLOCKS = 8
LRU_BW = LRU_W // LRU_BLOCKS
CONV_W = 4
LRU_C = 8.0
LRU_IN = 2 * LRU_W

N_BRANCH = 3
GATE_IN = N_BRANCH * D_MODEL
IN_COLS = RWKV_IN + MLA_IN + LRU_IN + GATE_IN

kernel_name = 'hybrid_rwkv7_mla_rglru_macaron_dit'


def layer_norm(x, g, b):
    xf = x.astype(jnp.float32)
    mu = xf.mean(-1, keepdims=True)
    var = jnp.square(xf - mu).mean(-1, keepdims=True)
    return ((xf - mu) * lax.rsqrt(var + LN_EPS) * g.astype(jnp.float32) + b.astype(jnp.float32)).astype(x.dtype)


def rms_norm(x, g):
    xf = x.astype(jnp.float32)
    y = xf * lax.rsqrt(jnp.mean(xf * xf, -1, keepdims=True) + LN_EPS) * g.astype(jnp.float32)
    return y.astype(x.dtype)


def swiglu(h, w_gate, w_up, w_down):
    return (jax.nn.silu(h @ w_gate) * (h @ w_up)) @ w_down


def axial_rope(n_tok):
    t = jnp.arange(n_tok, dtype=jnp.int32)
    row = (t // GRID_W).astype(jnp.float32)
    col = (t % GRID_W).astype(jnp.float32)
    n_pairs = QK_ROPE // 4
    inv = ROPE_BASE ** (-jnp.arange(n_pairs, dtype=jnp.float32) / n_pairs)
    ang = jnp.concatenate([row[:, None] * inv, col[:, None] * inv], axis=-1)
    return jnp.cos(ang), jnp.sin(ang)


def apply_rope(x, cos, sin):
    xf = x.astype(jnp.float32)
    x1, x2 = xf[..., 0::2], xf[..., 1::2]
    out = jnp.stack([x1 * cos - x2 * sin, x1 * sin + x2 * cos], axis=-1)
    return out.reshape(x.shape).astype(x.dtype)


def shift_latent_grid(f, rows):
    b, s, ch = f.shape
    g = f.reshape(b, rows, GRID_W, 4, ch // 4)
    left = jnp.pad(g[:, :, :-1, 0], ((0, 0), (0, 0), (1, 0), (0, 0)))
    right = jnp.pad(g[:, :, 1:, 1], ((0, 0), (0, 0), (0, 1), (0, 0)))
    up = jnp.pad(g[:, :-1, :, 2], ((0, 0), (1, 0), (0, 0), (0, 0)))
    down = jnp.pad(g[:, 1:, :, 3], ((0, 0), (0, 1), (0, 0), (0, 0)))
    return jnp.stack([left, right, up, down], axis=3).reshape(b, s, ch)


def shift_context(f):
    b, t, ch = f.shape
    g = f.reshape(b, t, 4, ch // 4)
    prev = jnp.pad(g[:, :-1], ((0, 0), (1, 0), (0, 0), (0, 0)))
    nxt = jnp.pad(g[:, 1:], ((0, 0), (0, 1), (0, 0), (0, 0)))
    return jnp.stack([prev[:, :, 0], nxt[:, :, 1], prev[:, :, 2], nxt[:, :, 3]], axis=2).reshape(b, t, ch)


def rwkv7_features(f, lp):
    b, t, _ = f.shape
    c0 = 3 * RWKV_W
    r, k, v, wd, ad, gd = jnp.split(f.astype(jnp.float32), [RWKV_W, 2 * RWKV_W, c0, c0 + W_LORA, c0 + W_LORA + A_LORA], axis=-1)
    heads = lambda z: z.reshape(b, t, RWKV_HEADS, RWKV_HEAD_DIM)
    kk = heads(k * lp['rwkv_k_k'])
    kk = kk / jnp.maximum(jnp.linalg.norm(kk, axis=-1, keepdims=True), 1e-12)
    per_dir = []
    for d in range(2):
        w_log = -jax.nn.softplus(-(lp['rwkv_w0'][d] + jnp.tanh(wd) @ lp['rwkv_w_up'][d])) - 0.5
        decay = jnp.exp(-jnp.exp(w_log))
        a = jax.nn.sigmoid(lp['rwkv_a0'][d] + ad @ lp['rwkv_a_up'][d])
        k_mod = k * (1.0 + (a - 1.0) * lp['rwkv_k_a'])
        per_dir.append((heads(decay), heads(a), heads(k_mod)))
    g = jax.nn.sigmoid(gd) @ lp['rwkv_g_up']
    return heads(r), heads(v), kk, per_dir, g


def rwkv7_scan(r, decay, k, v, kk, a, s0, reverse):
    def step(s, inp):
        r_t, w_t, k_t, v_t, kk_t, a_t = inp
        sa = jnp.einsum('bhvk,bhk->bhv', s, kk_t)
        s = s * w_t[:, :, None, :] - sa[..., None] * (kk_t * a_t)[:, :, None, :] + v_t[..., None] * k_t[:, :, None, :]
        return s, jnp.einsum('bhvk,bhk->bhv', s, r_t)
    xs = tuple(jnp.moveaxis(z, 1, 0) for z in (r, decay, k, v, kk, a))
    s_fin, ys = lax.scan(step, s0, xs, reverse=reverse)
    return jnp.moveaxis(ys, 0, 1), s_fin


def rwkv7_bidir(feat, s0_pair):
    r, v, kk, per_dir, _ = feat
    ys, finals = [], []
    for d, (decay, a, k_mod) in enumerate(per_dir):
        y, s_fin = rwkv7_scan(r, decay, k_mod, v, kk, a, s0_pair[d], d == 1)
        ys.append(y)
        finals.append(s_fin)
    return ys[0] + ys[1], (finals[0], finals[1])


def rwkv7_readout(y, feat, lp):
    r, v, _, per_dir, g = feat
    b, t = y.shape[:2]
    mu = y.mean(-1, keepdims=True)
    var = jnp.square(y - mu).mean(-1, keepdims=True)
    yn = ((y - mu) * lax.rsqrt(var + RWKV_GN_EPS)).reshape(b, t, RWKV_W) * lp['rwkv_lnx_g'] + lp['rwkv_lnx_b']
    k_bonus = 0.5 * (per_dir[0][2] + per_dir[1][2])
    r_k = lp['rwkv_r_k'].reshape(RWKV_HEADS, RWKV_HEAD_DIM)
    bonus = jnp.sum(r * k_bonus * r_k, axis=-1, keepdims=True) * v
    return (yn + bonus.reshape(b, t, RWKV_W)) * g


def mla_project(f, lp, cos_sin):
    b, t, _ = f.shape
    q_lat, kv_lat, k_rope = jnp.split(f, [Q_LORA, Q_LORA + KV_LORA], axis=-1)
    q = (rms_norm(q_lat, lp['mla_q_norm']) @ lp['mla_w_uq']).reshape(b, t, MLA_HEADS, QK_NOPE + QK_ROPE)
    q_nope, q_rope = q[..., :QK_NOPE], q[..., QK_NOPE:]
    kv_c = rms_norm(kv_lat, lp['mla_kv_norm'])
    k_nope = (kv_c @ lp['mla_w_uk']).reshape(b, t, MLA_HEADS, QK_NOPE)
    v = (kv_c @ lp['mla_w_uv']).reshape(b, t, MLA_HEADS, V_HEAD)
    if cos_sin is not None:
        cos, sin = cos_sin
        q_rope = apply_rope(q_rope, cos[None, :, None], sin[None, :, None])
        k_rope = apply_rope(k_rope, cos[None], sin[None])
    return q_nope, q_rope, k_nope, k_rope, v


def mla_attend(q_nope, q_rope, k_nope, k_rope, v):
    scale = (QK_NOPE + QK_ROPE) ** -0.5
    s = jnp.einsum('bqhd,bkhd->bhqk', q_nope, k_nope) + jnp.einsum('bqhd,bkd->bhqk', q_rope, k_rope)
    p = jax.nn.softmax(s.astype(jnp.float32) * scale, axis=-1).astype(v.dtype)
    return jnp.einsum('bhqk,bkhd->bqhd', p, v)


def mla_latent_blocks(q_nope, q_rope, k_nope, k_rope, v):
    b, s = q_nope.shape[:2]
    nb = s // Q_BLOCK
    to_blocks = lambda z: jnp.moveaxis(z.reshape((b, nb, Q_BLOCK) + z.shape[2:]), 1, 0)
    o = lax.map(lambda qs: mla_attend(qs[0], qs[1], k_nope, k_rope, v), (to_blocks(q_nope), to_blocks(q_rope)))
    return jnp.moveaxis(o, 0, 1).reshape(b, s, MLA_W)


def centred_dwconv(x, w, bias):
    t = x.shape[1]
    left = CONV_W // 2
    xp = jnp.pad(x, ((0, 0), (left, CONV_W - 1 - left), (0, 0)))
    y = bias + xp[:, 0:t] * w[0]
    for j in range(1, CONV_W):
        y = y + xp[:, j:j + t] * w[j]
    return y


def rglru_coeffs(xc, lp, d):
    b, t, _ = xc.shape
    xf = xc.astype(jnp.float32)
    xh = xf.reshape(b, t, LRU_BLOCKS, LRU_BW)
    gate_r = jax.nn.sigmoid(jnp.einsum('btnd,nde->btne', xh, lp['lru_wa'][d]).reshape(b, t, LRU_W) + lp['lru_ba'][d])
    gate_i = jax.nn.sigmoid(jnp.einsum('btnd,nde->btne', xh, lp['lru_wx'][d]).reshape(b, t, LRU_W) + lp['lru_bx'][d])
    log_a = -LRU_C * gate_r * jax.nn.softplus(-lp['lru_lambda'][d])
    a = jnp.exp(log_a)
    inp = jnp.sqrt(-jnp.expm1(2.0 * log_a)) * gate_i * xf
    return a, inp


def linear_scan(a, b_in, h0, reverse):
    def combine(e1, e2):
        return e1[0] * e2[0], e2[0] * e1[1] + e2[1]
    a_cum, h = lax.associative_scan(combine, (a, b_in), axis=1, reverse=reverse)
    h = h + a_cum * h0[:, None, :]
    h_fin = h[:, 0] if reverse else h[:, -1]
    return h, h_fin


def gated_merge(gates, y_rw, y_mla, y_lru, lp):
    g = jax.nn.sigmoid(gates + lp['gate_b'])
    g_rw, g_mla, g_lru = jnp.split(g, N_BRANCH, axis=-1)
    y = g_rw * (y_rw @ lp['proj_rwkv']) + g_mla * (y_mla @ lp['proj_mla']) + g_lru * (y_lru @ lp['proj_lru'])
    return y @ lp['w_out']


def hybrid_mixer(hc, hl, rows, cos_sin, lp, ctx_out):
    dt = hl.dtype
    batch = hl.shape[0]
    cuts = [RWKV_IN, RWKV_IN + MLA_IN, RWKV_IN + MLA_IN + LRU_IN]
    rw_c, mla_c, lru_c, gate_c = jnp.split(hc @ lp['w_in'], cuts, axis=-1)
    rw_l, mla_l, lru_l, gate_l = jnp.split(hl @ lp['w_in'], cuts, axis=-1)

    mu = lp['rwkv_mu']
    feat_c = rwkv7_features(rw_c + (shift_context(rw_c) - rw_c) * mu, lp)
    feat_l = rwkv7_features(rw_l + (shift_latent_grid(rw_l, rows) - rw_l) * mu, lp)
    s0 = jnp.zeros((batch, RWKV_HEADS, RWKV_HEAD_DIM, RWKV_HEAD_DIM), jnp.float32)
    y_rw_c, s_fin_c = rwkv7_bidir(feat_c, (s0, s0))
    y_rw_l, _ = rwkv7_bidir(feat_l, s_fin_c)
    rw_out_l = rwkv7_readout(y_rw_l, feat_l, lp).astype(dt)

    qn_c, qr_c, kn_c, kr_c, v_c = mla_project(mla_c, lp, None)
    qn_l, qr_l, kn_l, kr_l, v_l = mla_project(mla_l, lp, cos_sin)
    kn_all = jnp.concatenate([kn_c, kn_l], axis=1)
    kr_all = jnp.concatenate([kr_c, kr_l], axis=1)
    v_all = jnp.concatenate([v_c, v_l], axis=1)
    mla_out_l = mla_latent_blocks(qn_l, qr_l, kn_all, kr_all, v_all)

    xr_c, gb_c = jnp.split(lru_c, 2, axis=-1)
    xr_l, gb_l = jnp.split(lru_l, 2, axis=-1)
    xr_c = centred_dwconv(xr_c, lp['lru_conv_w'], lp['lru_conv_b'])
    xr_l = centred_dwconv(xr_l, lp['lru_conv_w'], lp['lru_conv_b'])
    h0 = jnp.zeros((batch, LRU_W), jnp.float32)
    hs_c, hs_l = [], []
    for d in range(2):
        rev = d == 1
        h_c, h_fin_c = linear_scan(*rglru_coeffs(xr_c, lp, d), h0, rev)
        h_l, _ = linear_scan(*rglru_coeffs(xr_l, lp, d), h_fin_c, rev)
        hs_c.append(h_c)
        hs_l.append(h_l)
    lru_out_l = ((hs_l[0] + hs_l[1]) * jax.nn.gelu(gb_l.astype(jnp.float32))).astype(dt)

    out_l = gated_merge(gate_l, rw_out_l, mla_out_l, lru_out_l, lp)
    if not ctx_out:
        return None, out_l
    rw_out_c = rwkv7_readout(y_rw_c, feat_c, lp).astype(dt)
    mla_out_c = mla_attend(qn_c, qr_c, kn_c, kr_c, v_c).reshape(batch, -1, MLA_W)
    lru_out_c = ((hs_c[0] + hs_c[1]) * jax.nn.gelu(gb_c.astype(jnp.float32))).astype(dt)
    out_c = gated_merge(gate_c, rw_out_c, mla_out_c, lru_out_c, lp)
    return out_c, out_l


def ffn_sublayer(s, mod, j, lp, alpha):
    shift, scale, gate = mod
    h = s * (1.0 + scale) + shift
    y = swiglu(h, lp['ffn_w_gate'][j], lp['ffn_w_up'][j], lp['ffn_w_down'][j])
    return layer_norm(alpha * s + 0.5 * gate * y, lp['ln_g'][2 * j], lp['ln_b'][2 * j])


def setup_inputs(seed: int = 0) -> dict:
    key = jax.random.key(seed)
    ks = iter(jax.random.split(key, 64))
    f32 = jnp.float32
    beta = (8 * DEPTH) ** -0.25
    L = DEPTH

    def nrm(shape, scale):
        return scale * jax.random.normal(next(ks), shape, f32)

    def unif(shape, lo, hi):
        return jax.random.uniform(next(ks), shape, f32, lo, hi)

    lam_u = unif((L, 2, LRU_W), 0.9, 0.999)
    return {
        'x': nrm((BATCH, SEQ, D_MODEL), 1.0),
        'c': nrm((BATCH, D_MODEL), 1.0),
        'ctx': nrm((BATCH, CTX_LEN, D_MODEL), 1.0),
        'c_ctx': nrm((D_MODEL,), 1.0),
        'ada_w': nrm((L, D_MODEL, N_MOD * D_MODEL), 0.5 * D_MODEL ** -0.5),
        'ada_b': nrm((L, N_MOD * D_MODEL), 0.02),
        'ln_g': 1.0 + nrm((L, 3, D_MODEL), 0.02),
        'ln_b': nrm((L, 3, D_MODEL), 0.02),
        'ffn_w_gate': nrm((L, 2, D_MODEL, D_FF), D_MODEL ** -0.5),
        'ffn_w_up': nrm((L, 2, D_MODEL, D_FF), D_MODEL ** -0.5),
        'ffn_w_down': nrm((L, 2, D_FF, D_MODEL), beta * D_FF ** -0.5),
        'w_in': nrm((L, D_MODEL, IN_COLS), D_MODEL ** -0.5),
        'gate_b': nrm((L, GATE_IN), 0.02),
        'rwkv_mu': unif((L, RWKV_IN), 0.0, 1.0),
        'rwkv_w0': unif((L, 2, RWKV_W), -6.0, 1.0),
        'rwkv_w_up': nrm((L, 2, W_LORA, RWKV_W), 0.5 * W_LORA ** -0.5),
        'rwkv_a0': nrm((L, 2, RWKV_W), 0.1),
        'rwkv_a_up': nrm((L, 2, A_LORA, RWKV_W), A_LORA ** -0.5),
        'rwkv_g_up': nrm((L, G_LORA, RWKV_W), G_LORA ** -0.5),
        'rwkv_k_k': 0.85 + nrm((L, RWKV_W), 0.02),
        'rwkv_k_a': 1.0 + nrm((L, RWKV_W), 0.02),
        'rwkv_r_k': nrm((L, RWKV_W), 0.1),
        'rwkv_lnx_g': 1.0 + nrm((L, RWKV_W), 0.02),
        'rwkv_lnx_b': nrm((L, RWKV_W), 0.02),
        'mla_q_norm': 1.0 + nrm((L, Q_LORA), 0.02),
        'mla_kv_norm': 1.0 + nrm((L, KV_LORA), 0.02),
        'mla_w_uq': nrm((L, Q_LORA, MLA_HEADS * (QK_NOPE + QK_ROPE)), Q_LORA ** -0.5),
        'mla_w_uk': nrm((L, KV_LORA, MLA_HEADS * QK_NOPE), KV_LORA ** -0.5),
        'mla_w_uv': nrm((L, KV_LORA, MLA_HEADS * V_HEAD), KV_LORA ** -0.5),
        'lru_conv_w': nrm((L, CONV_W, LRU_W), CONV_W ** -0.5),
        'lru_conv_b': nrm((L, LRU_W), 0.02),
        'lru_wa': nrm((L, 2, LRU_BLOCKS, LRU_BW, LRU_BW), LRU_BW ** -0.5),
        'lru_ba': nrm((L, 2, LRU_W), 0.02),
        'lru_wx': nrm((L, 2, LRU_BLOCKS, LRU_BW, LRU_BW), LRU_BW ** -0.5),
        'lru_bx': nrm((L, 2, LRU_W), 0.02),
        'lru_lambda': jnp.log(lam_u) - jnp.log1p(-lam_u),
        'proj_rwkv': nrm((L, RWKV_W, D_MODEL), RWKV_W ** -0.5),
        'proj_mla': nrm((L, MLA_W, D_MODEL), MLA_W ** -0.5),
        'proj_lru': nrm((L, LRU_W, D_MODEL), LRU_W ** -0.5),
        'w_out': nrm((L, D_MODEL, D_MODEL), beta * D_MODEL ** -0.5),
    }


def reference(x, c, ctx, c_ctx, ada_w, ada_b, ln_g, ln_b, ffn_w_gate, ffn_w_up, ffn_w_down, w_in, gate_b,
              rwkv_mu, rwkv_w0, rwkv_w_up, rwkv_a0, rwkv_a_up, rwkv_g_up, rwkv_k_k, rwkv_k_a, rwkv_r_k,
              rwkv_lnx_g, rwkv_lnx_b, mla_q_norm, mla_kv_norm, mla_w_uq, mla_w_uk, mla_w_uv,
              lru_conv_w, lru_conv_b, lru_wa, lru_ba, lru_wx, lru_bx, lru_lambda,
              proj_rwkv, proj_mla, proj_lru, w_out):
    alpha = (2 * DEPTH) ** 0.25
    n_tok = x.shape[1]
    rows = n_tok // GRID_W
    cos_sin = axial_rope(n_tok)
    silu_c = jax.nn.silu(c)[:, None, :]
    silu_cc = jax.nn.silu(c_ctx)[None, None, :]
    xl, xc = x, ctx
    for l in range(DEPTH):
        last = l == DEPTH - 1
        lp = {
            'ln_g': ln_g[l], 'ln_b': ln_b[l],
            'ffn_w_gate': ffn_w_gate[l], 'ffn_w_up': ffn_w_up[l], 'ffn_w_down': ffn_w_down[l],
            'w_in': w_in[l], 'gate_b': gate_b[l],
            'rwkv_mu': rwkv_mu[l], 'rwkv_w0': rwkv_w0[l], 'rwkv_w_up': rwkv_w_up[l],
            'rwkv_a0': rwkv_a0[l], 'rwkv_a_up': rwkv_a_up[l], 'rwkv_g_up': rwkv_g_up[l],
            'rwkv_k_k': rwkv_k_k[l], 'rwkv_k_a': rwkv_k_a[l], 'rwkv_r_k': rwkv_r_k[l],
            'rwkv_lnx_g': rwkv_lnx_g[l], 'rwkv_lnx_b': rwkv_lnx_b[l],
            'mla_q_norm': mla_q_norm[l], 'mla_kv_norm': mla_kv_norm[l],
            'mla_w_uq': mla_w_uq[l], 'mla_w_uk': mla_w_uk[l], 'mla_w_uv': mla_w_uv[l],
            'lru_conv_w': lru_conv_w[l], 'lru_conv_b': lru_conv_b[l],
            'lru_wa': lru_wa[l], 'lru_ba': lru_ba[l], 'lru_wx': lru_wx[l], 'lru_bx': lru_bx[l],
            'lru_lambda': lru_lambda[l],
            'proj_rwkv': proj_rwkv[l], 'proj_mla': proj_mla[l], 'proj_lru': proj_lru[l], 'w_out': w_out[l],
        }
        mod_l = jnp.split(silu_c @ ada_w[l] + ada_b[l], N_MOD, axis=-1)
        mod_c = jnp.split(silu_cc @ ada_w[l] + ada_b[l], N_MOD, axis=-1)

        xl = ffn_sublayer(xl, mod_l[0:3], 0, lp, alpha)
        xc = ffn_sublayer(xc, mod_c[0:3], 0, lp, alpha)

        hl = xl * (1.0 + mod_l[4]) + mod_l[3]
        hc = xc * (1.0 + mod_c[4]) + mod_c[3]
        out_c, out_l = hybrid_mixer(hc, hl, rows, cos_sin, lp, not last)
        xl = layer_norm(alpha * xl + mod_l[5] * out_l, lp['ln_g'][1], lp['ln_b'][1])
        if not last:
            xc = layer_norm(alpha * xc + mod_c[5] * out_c, lp['ln_g'][1], lp['ln_b'][1])

        xl = ffn_sublayer(xl, mod_l[6:9], 1, lp, alpha)
        if not last:
            xc = ffn_sublayer(xc, mod_c[6:9], 1, lp, alpha)
    return xl
```

```cpp
#include <hip/hip_runtime.h>
#include <cstdio>
#include <cstdint>

#define LAS __attribute__((address_space(3)))
#define GAS __attribute__((address_space(1)))
typedef unsigned short bf16_t;
typedef short bf16x8 __attribute__((ext_vector_type(8)));
typedef short s16x4 __attribute__((ext_vector_type(4)));
typedef float f32x2 __attribute__((ext_vector_type(2)));
typedef float f32x4 __attribute__((ext_vector_type(4)));
typedef float f32x8 __attribute__((ext_vector_type(8)));
typedef float f32x16 __attribute__((ext_vector_type(16)));
typedef unsigned u32x2 __attribute__((ext_vector_type(2)));
typedef unsigned u32x4 __attribute__((ext_vector_type(4)));

constexpr int D = 2048, NB = 4, SEQ = 4096, CTX = 256, TPB = CTX + SEQ  , M = NB * TPB  , DFF = 5632, NMOD = 9, DEPTH = 2;
constexpr int NPAN = M / 256;
constexpr int RWKV_W = 1024, RW_IN = 3360, MLA_IN = 832, LRU_IN = 2048, GATE_IN = 6144, IN_COLS = 12384;
constexpr int FA = RW_IN + MLA_IN + LRU_IN  , FA_PAD = 6400;
constexpr int OFF_QLAT = 3360, OFF_KVLAT = 3872, OFF_KROPE = 4128, OFF_XR = 4192, OFF_GB = 5216;
constexpr int LORA_K = 384, LORA_N = 5120;
constexpr int NHEAD = 16, QK_NOPE = 128, QK_ROPE = 64, QKD = 192, VD = 128;
constexpr float LN_EPS = 1e-6f, GN_EPS = 64e-5f, ALPHA = 1.41421356237309515f;

constexpr size_t al256(size_t x) { return (x + 255) & ~(size_t)255; }
constexpr size_t WS_CTL = 0, CTL_BYTES = 65536;
constexpr size_t WS_MOD = WS_CTL + CTL_BYTES;
constexpr size_t WS_ROPE = al256(WS_MOD + (size_t)2 * 5 * 18432 * 4);
constexpr size_t WS_W = al256(WS_ROPE + (size_t)4096 * 32 * 2 * 4);
constexpr size_t W_GU0 = 0, W_GU1 = W_GU0 + (size_t)11264 * 2048 * 2, W_D0 = W_GU1 + (size_t)11264 * 2048 * 2, W_D1 = W_D0 + (size_t)2048 * 5632 * 2;
constexpr size_t W_INA = W_D1 + (size_t)2048 * 5632 * 2, W_ING = W_INA + (size_t)FA_PAD * 2048 * 2, W_UQ = W_ING + (size_t)6144 * 2048 * 2;
constexpr size_t W_UKV = W_UQ + (size_t)3072 * 512 * 2, W_LORA = W_UKV + (size_t)4096 * 256 * 2, W_LRU = W_LORA + (size_t)LORA_N * LORA_K * 2;
constexpr size_t W_PROJ = W_LRU + (size_t)8 * 512 * 256 * 2, W_OUT = W_PROJ + (size_t)2048 * 4096 * 2, W_END = W_OUT + (size_t)2048 * 2048 * 2;
constexpr size_t WS_X = al256(WS_W + W_END);
constexpr size_t WS_H = WS_X + (size_t)M * D * 4;
constexpr size_t WS_YCAT = WS_H + (size_t)M * D * 2;
constexpr size_t WS_R = WS_YCAT + (size_t)M * 4096 * 2;
constexpr size_t R_ACT = 0;
constexpr size_t R_MODP = 0;
constexpr size_t R_FA = 0;
constexpr size_t R_PREP = (size_t)M * FA_PAD * 2;
constexpr size_t R_LIN = R_PREP;
constexpr size_t R_RKV = R_LIN + (size_t)M * LORA_K * 2;
constexpr size_t R_XC = R_RKV + (size_t)M * 3072 * 2;
constexpr size_t R_GB = R_XC + (size_t)M * 1024 * 2;
constexpr size_t R_QL = R_GB + (size_t)M * 1024 * 2;
constexpr size_t R_KVC = R_QL + (size_t)M * 512 * 2;
constexpr size_t R_KR = R_KVC + (size_t)M * 256 * 2;
constexpr size_t R_PREP_END = R_KR + (size_t)M * 64 * 2;
constexpr size_t R_LO = 0;
constexpr size_t R_GT = R_PREP_END;
constexpr size_t R_YS = R_GT + (size_t)M * 4096 * 2;
constexpr size_t R_Q = 0;
constexpr size_t R_KN = R_Q + (size_t)M * 3072 * 2;
constexpr size_t R_V = R_KN + (size_t)M * 2048 * 2;
constexpr size_t R_GATE = R_PREP_END;
constexpr size_t R_Y2F = 0;
constexpr size_t R_Y2B = R_Y2F + (size_t)M * 2048 * 4;
constexpr size_t R_END = R_YS + (size_t)2 * M * 1024 * 2;
static_assert(R_LO + (size_t)M * LORA_N * 2 <= R_PREP, "LO fits the dead FA slot");
static_assert(R_V + (size_t)M * 2048 * 2 <= R_QL, "Q|K|V fit below the live QL/KVC/KR");
static_assert(R_GATE + (size_t)M * 6144 * 2 <= R_END, "GATE fits");
static_assert(R_Y2B + (size_t)M * 2048 * 2 <= R_GATE, "Y2 below GATE");
constexpr size_t WS_END = WS_R + R_END;

constexpr int RING_BYTES = 145408;
constexpr int LDSCTL_OFF = RING_BYTES;
constexpr int LDS_BYTES = 147456;

typedef __bf16 bf16x2_n __attribute__((ext_vector_type(2)));
__device__ __forceinline__ unsigned cvt_pk_bf16(float lo, float hi) { const f32x2 v = {lo, hi}; const bf16x2_n r = __builtin_convertvector(v, bf16x2_n); return __builtin_bit_cast(unsigned, r); }
__device__ __forceinline__ float bf_lo(unsigned w) { return __uint_as_float(w << 16); }
__device__ __forceinline__ float bf_hi(unsigned w) { return __uint_as_float(w & 0xffff0000u); }
__device__ __forceinline__ float bf2f(bf16_t b) { return __uint_as_float(((unsigned)b) << 16); }
__device__ __forceinline__ bf16_t f2bf(float f) { return (bf16_t)(cvt_pk_bf16(f, 0.f) & 0xffffu); }
__device__ __forceinline__ float wave_sum(float v) {
#pragma unroll
    for (int o = 1; o < 64; o <<= 1) v += __shfl_xor(v, o);
    return v;
}
__device__ __forceinline__ float sigmoidf_(float x) { return 1.0f / (1.0f + __expf(-x)); }
__device__ __forceinline__ float siluf_(float x) { return x / (1.0f + __expf(-x)); }
__device__ __forceinline__ float softplusf_(float x) { return x > 20.f ? x : log1pf(__expf(x)); }
__device__ __forceinline__ float gelu_tanh_(float x) { const float u = 0.7978845608028654f * (x + 0.044715f * x * x * x); return 0.5f * x * (1.0f + tanhf(u)); }
__device__ __forceinline__ int modrow_of_panel(int pm) { return (pm % 17 == 0) ? 4 : pm / 17; }
#define MK_MULTI 1
namespace pg8 {
constexpr int BM = 256, BK = 64, HALF = 128, HTB = HALF * BK * 2  , STAGE_BYTES = 8 * HTB, NXCD = 8, WGM = 8;
__host__ __device__ __forceinline__ int lds_byte(int r, int c) { const int st = (r >> 4) * 2 + (c >> 5), rr = r & 15, cc = c & 31, ob = rr * 64 + cc * 2; return st * 1024 + (ob ^ (((ob >> 9) & 1) << 5)); }
__host__ __device__ __forceinline__ void stage_rc(int b, int& R, int& C) { const int st = b / 1024, sb = b % 1024, swz = sb ^ (((sb >> 9) & 1) << 5); R = (st >> 1) * 16 + swz / 64; C = (st & 1) * 32 + (swz % 64) / 2; }
__host__ __device__ __forceinline__ int perm32(int rho) { const int n = rho >> 4, i = rho & 15; return 8 * (i >> 2) + 4 * n + (i & 3); }

struct Unit { int pm, pn, g; };
struct Gemm { const bf16_t* A; const bf16_t* Bt; int lda, ldb, K; int lru_groups; };
__device__ __forceinline__ size_t a_base(const Gemm& g, const Unit& u) { return (size_t)u.pm * 256 * g.lda * 2 + (g.lru_groups ? (size_t)(u.g >> 1) * 256 * 2 : 0); }
__device__ __forceinline__ size_t b_base(const Gemm& g, const Unit& u) { return (size_t)u.pn * 256 * g.ldb * 2 + (g.lru_groups ? (size_t)u.g * 512 * 256 * 2 : 0); }

struct Order {
    int nM, nN, nG, per, nwg, G, c, pmode;
    __device__ void init(int nM_, int nN_, int nG_, int G_, int c_, int pmode_) { nM = nM_; nN = nN_; nG = nG_; per = nM * nN; nwg = per * nG; G = G_; c = c_; pmode = pmode_; }
    __device__ bool next(int i, Unit& u) const {
        const long L = (long)i * G + c; if (L >= nwg) return false;
        const int g = (int)(L / per); int wgid = (int)(L % per);
        { const int q = per / NXCD, r = per % NXCD, xcd = wgid % NXCD, off = wgid / NXCD; wgid = (xcd < r ? xcd * (q + 1) : r * (q + 1) + (xcd - r) * q) + off; }
        const int nig = WGM * nN, gid = wgid / nig, fm = gid * WGM, gsz = (nM - fm) < WGM ? (nM - fm) : WGM;
        int pm = fm + ((wgid % nig) % gsz); u.pn = (wgid % nig) / gsz; u.g = g;
        if (pmode == 1) pm = (pm >> 4) * 17 + 1 + (pm & 15);
        u.pm = pm; return true;
    }
};

typedef f32x4 Acc[2][2][4][2];

template <class Epi>
__device__ __forceinline__ void gemm_phase(LAS unsigned char* lds, const Gemm g, const Order& S, const Epi& E) {
    int tid_ = threadIdx.x; asm volatile("" : "+v"(tid_));
    const int tid = tid_, wid = __builtin_amdgcn_readfirstlane(tid >> 6), lane = tid & 63, wr = wid >> 2, wc = wid & 3, fr = lane & 15, fq = lane >> 4;
    const int nt = g.K / BK;
    unsigned voffA[2], voffB[2];
#pragma unroll
    for (int i = 0; i < 2; ++i) { int R, C; stage_rc(tid * 16 + i * 8192, R, C); const int Rb = Epi::PERM ? ((R & ~31) + perm32(R & 31)) : R;
        voffA[i] = (unsigned)(R * g.lda + C) * 2u; voffB[i] = (unsigned)(Rb * g.ldb + C) * 2u; }
    const size_t kstep = (size_t)(BK * 2);
    const size_t hstepA = (size_t)HALF * g.lda * 2, hstepB = (size_t)HALF * g.ldb * 2;
    const unsigned ldsw = (unsigned)wid * 1024u;
    const int aoff = lds_byte(wr * 64 + fr, fq * 8), boff = lds_byte(wc * 32 + fr, fq * 8);
#define PG8_SA(b, h) (((b) * 2 + (h)) * HTB)
#define PG8_SB(b, h) ((4 + (b) * 2 + (h)) * HTB)
#define PG8_STAGE(bufoff, gbase, voff) do { _Pragma("unroll") for (int _i = 0; _i < 2; ++_i) \
        __builtin_amdgcn_global_load_lds((const unsigned*)((const char*)(gbase) + (voff)[_i]), (LAS unsigned*)(lds + (bufoff) + ldsw + _i * 8192), 16, 0, 0); } while (0)
#define PG8_LDA(dst, b, h) do { _Pragma("unroll") for (int m = 0; m < 4; ++m) _Pragma("unroll") for (int k = 0; k < 2; ++k) dst[m][k] = *(const LAS bf16x8*)(lds + PG8_SA(b, h) + aoff + m * 2048 + k * 1024); } while (0)
#define PG8_LDB(dst, b, h) do { _Pragma("unroll") for (int n = 0; n < 2; ++n) _Pragma("unroll") for (int k = 0; k < 2; ++k) dst[n][k] = *(const LAS bf16x8*)(lds + PG8_SB(b, h) + boff + n * 2048 + k * 1024); } while (0)
#define PG8_MMA(ai, bj, At, Bt) do { __builtin_amdgcn_s_setprio(1); _Pragma("unroll") for (int m = 0; m < 4; ++m) _Pragma("unroll") for (int n = 0; n < 2; ++n) _Pragma("unroll") for (int k = 0; k < 2; ++k) \
        acc[ai][bj][m][n] = __builtin_amdgcn_mfma_f32_16x16x32_bf16(Bt[n][k], At[m][k], acc[ai][bj][m][n], 0, 0, 0); __builtin_amdgcn_s_setprio(0); } while (0)
#define PG8_WAIT_V(n) asm volatile("s_waitcnt vmcnt(" #n ")" ::: "memory")
#define PG8_WAIT_L(n) asm volatile("s_waitcnt lgkmcnt(" #n ")" ::: "memory")
#define PG8_BAR __builtin_amdgcn_s_barrier()
#define PG8_SCHED __builtin_amdgcn_sched_barrier(0)
    Unit cur, nxt; int ui = 0;
    if (!S.next(0, cur)) return;
    Acc acc;
#pragma unroll
    for (int a = 0; a < 2; ++a)
#pragma unroll
        for (int b = 0; b < 2; ++b)
#pragma unroll
            for (int m = 0; m < 4; ++m)
#pragma unroll
                for (int n = 0; n < 2; ++n) acc[a][b][m][n] = (f32x4){0.f, 0.f, 0.f, 0.f};
    bf16x8 At[4][2], B0[2][2], B1[2][2];
    const char* cA = (const char*)g.A + a_base(g, cur); const char* cB = (const char*)g.Bt + b_base(g, cur);
    PG8_STAGE(PG8_SB(0, 0), cB, voffB); PG8_STAGE(PG8_SB(0, 1), cB + hstepB, voffB); PG8_STAGE(PG8_SA(0, 0), cA, voffA); PG8_STAGE(PG8_SA(0, 1), cA + hstepA, voffA);
    if (wr == 1) PG8_BAR;
    PG8_WAIT_V(2); PG8_BAR;
    PG8_STAGE(PG8_SB(1, 0), cB + kstep, voffB); PG8_STAGE(PG8_SA(1, 0), cA + kstep, voffA); PG8_STAGE(PG8_SB(1, 1), cB + hstepB + kstep, voffB);
    PG8_WAIT_V(6); PG8_BAR;
    for (;;) {
        const bool has_next = S.next(ui + 1, nxt);
        const char* nA = has_next ? (const char*)g.A + a_base(g, nxt) : cA; const char* nB = has_next ? (const char*)g.Bt + b_base(g, nxt) : cB;
        for (int t = 0; t < nt; t += 2) {
            const bool last = (t == nt - 2);
            const char* a1 = cA + (size_t)(t + 1) * kstep;
            const char* a2 = last ? nA : cA + (size_t)(t + 2) * kstep; const char* b2 = last ? nB : cB + (size_t)(t + 2) * kstep;
            const char* a3 = a2 + kstep; const char* b3 = b2 + kstep;
            PG8_LDB(B0, 0, 0); PG8_LDB(B1, 0, 1); PG8_SCHED; PG8_LDA(At, 0, 0); PG8_STAGE(PG8_SA(1, 1), a1 + hstepA, voffA);
            PG8_WAIT_V(8); PG8_WAIT_L(0); PG8_BAR; PG8_MMA(0, 0, At, B0); PG8_MMA(0, 1, At, B1); PG8_BAR; PG8_SCHED;
            PG8_LDA(At, 0, 1); PG8_STAGE(PG8_SB(0, 0), b2, voffB); PG8_STAGE(PG8_SB(0, 1), b2 + hstepB, voffB); PG8_STAGE(PG8_SA(0, 0), a2, voffA);
            PG8_WAIT_V(8); PG8_WAIT_L(0); PG8_BAR; PG8_MMA(1, 0, At, B0); PG8_MMA(1, 1, At, B1); PG8_BAR; PG8_SCHED;
            PG8_LDB(B0, 1, 0); PG8_LDB(B1, 1, 1); PG8_SCHED; PG8_LDA(At, 1, 0); PG8_STAGE(PG8_SA(0, 1), a2 + hstepA, voffA);
            PG8_WAIT_V(8); PG8_WAIT_L(0); PG8_BAR; PG8_MMA(0, 0, At, B0); PG8_MMA(0, 1, At, B1); PG8_BAR; PG8_SCHED;
            PG8_LDA(At, 1, 1); PG8_STAGE(PG8_SB(1, 0), b3, voffB); PG8_STAGE(PG8_SB(1, 1), b3 + hstepB, voffB); PG8_STAGE(PG8_SA(1, 0), a3, voffA);
            PG8_WAIT_V(8); PG8_WAIT_L(0); PG8_BAR; PG8_MMA(1, 0, At, B0); PG8_MMA(1, 1, At, B1); PG8_BAR; PG8_SCHED;
        }
        if (wr == 0) PG8_BAR;
        E(acc, cur, wr, wc, fr, fq);
        if (!has_next) break;
#pragma unroll
        for (int a = 0; a < 2; ++a)
#pragma unroll
            for (int b = 0; b < 2; ++b)
#pragma unroll
                for (int m = 0; m < 4; ++m)
#pragma unroll
                    for (int n = 0; n < 2; ++n) acc[a][b][m][n] = (f32x4){0.f, 0.f, 0.f, 0.f};
        cur = nxt; cA = nA; cB = nB; ++ui;
        if (wr == 1) PG8_BAR;
    }
    PG8_WAIT_V(0);
    PG8_BAR;
#undef PG8_SA
#undef PG8_SB
#undef PG8_STAGE
#undef PG8_LDA
#undef PG8_LDB
#undef PG8_MMA
#undef PG8_WAIT_V
#undef PG8_WAIT_L
#undef PG8_BAR
#undef PG8_SCHED
}

struct EpiBf16 {
    static constexpr bool PERM = true;
    bf16_t* O; int ldc; int gcols;
    bf16_t* O2; int split_pn;
    __device__ __forceinline__ void operator()(const Acc& acc, const Unit& u, int wr, int wc, int fr, int fq) const {
        const bool second = u.pn >= split_pn; bf16_t* base = second ? O2 : O;
        const int row0 = u.pm * BM + wr * 64 + fr, col0 = u.g * gcols + (second ? u.pn - split_pn : u.pn) * BM + wc * 32 + 8 * fq;
#pragma unroll
        for (int ai = 0; ai < 2; ++ai)
#pragma unroll
            for (int m = 0; m < 4; ++m) { bf16_t* rowp = base + (size_t)(row0 + ai * HALF + m * 16) * ldc + col0;
#pragma unroll
                for (int bj = 0; bj < 2; ++bj) { const f32x4 v0 = acc[ai][bj][m][0], v1 = acc[ai][bj][m][1];
                    u32x4 w; w.x = cvt_pk_bf16(v0[0], v0[1]); w.y = cvt_pk_bf16(v0[2], v0[3]); w.z = cvt_pk_bf16(v1[0], v1[1]); w.w = cvt_pk_bf16(v1[2], v1[3]);
                    *(u32x4*)(rowp + bj * HALF) = w; } }
    }
};
struct EpiSwiGLU {
    static constexpr bool PERM = true;
    bf16_t* O; int ldc;
    __device__ __forceinline__ void operator()(const Acc& acc, const Unit& u, int wr, int wc, int fr, int fq) const {
        const int row0 = u.pm * BM + wr * 64 + fr, col0 = u.pn * HALF + wc * 32 + 8 * fq;
#pragma unroll
        for (int ai = 0; ai < 2; ++ai)
#pragma unroll
            for (int m = 0; m < 4; ++m) { bf16_t* rowp = O + (size_t)(row0 + ai * HALF + m * 16) * ldc + col0;
                float o[8];
#pragma unroll
                for (int n = 0; n < 2; ++n)
#pragma unroll
                    for (int j = 0; j < 4; ++j) { const float gg = acc[ai][0][m][n][j], uu = acc[ai][1][m][n][j]; o[n * 4 + j] = gg * uu * __builtin_amdgcn_rcpf(1.0f + __expf(-gg)); }
                u32x4 w; w.x = cvt_pk_bf16(o[0], o[1]); w.y = cvt_pk_bf16(o[2], o[3]); w.z = cvt_pk_bf16(o[4], o[5]); w.w = cvt_pk_bf16(o[6], o[7]);
                *(u32x4*)rowp = w; }
    }
};
struct EpiResid {
    static constexpr bool PERM = false;
    float* X; const float* gvec; float coef;
    __device__ __forceinline__ void operator()(const Acc& acc, const Unit& u, int wr, int wc, int fr, int fq) const {
        const int row0 = u.pm * BM + wr * 64 + fr, col0 = u.pn * BM + wc * 32 + 4 * fq;
        const float* gp = gvec + (size_t)modrow_of_panel(u.pm) * 18432 + col0;
        f32x4 gv[2][2];
#pragma unroll
        for (int bj = 0; bj < 2; ++bj)
#pragma unroll
            for (int n = 0; n < 2; ++n) gv[bj][n] = *(const f32x4*)(gp + bj * HALF + n * 16) * coef;
#pragma unroll
        for (int ai = 0; ai < 2; ++ai)
#pragma unroll
            for (int m = 0; m < 4; ++m) { float* rowp = X + (size_t)(row0 + ai * HALF + m * 16) * D + col0;
#pragma unroll
                for (int bj = 0; bj < 2; ++bj)
#pragma unroll
                    for (int n = 0; n < 2; ++n) { float* p = rowp + bj * HALF + n * 16; const f32x4 x = *(const f32x4*)p; *(f32x4*)p = x * ALPHA + gv[bj][n] * acc[ai][bj][m][n]; }
                asm volatile("" ::: "memory"); }
    }
};
struct EpiGate {
    static constexpr bool PERM = true;
    bf16_t* O; const float* bias;
    __device__ __forceinline__ void operator()(const Acc& acc, const Unit& u, int wr, int wc, int fr, int fq) const {
        const int row0 = u.pm * BM + wr * 64 + fr, col0 = u.pn * BM + wc * 32 + 8 * fq;
        f32x4 bv[2][2];
#pragma unroll
        for (int bj = 0; bj < 2; ++bj)
#pragma unroll
            for (int n = 0; n < 2; ++n) bv[bj][n] = *(const f32x4*)(bias + col0 + bj * HALF + 4 * n);
#pragma unroll
        for (int ai = 0; ai < 2; ++ai)
#pragma unroll
            for (int m = 0; m < 4; ++m) { bf16_t* rowp = O + (size_t)(row0 + ai * HALF + m * 16) * GATE_IN + col0;
#pragma unroll
                for (int bj = 0; bj < 2; ++bj) { f32x4 v0 = acc[ai][bj][m][0] + bv[bj][0], v1 = acc[ai][bj][m][1] + bv[bj][1];
#pragma unroll
                    for (int j = 0; j < 4; ++j) { v0[j] = __builtin_amdgcn_rcpf(1.0f + __expf(-v0[j])); v1[j] = __builtin_amdgcn_rcpf(1.0f + __expf(-v1[j])); }
                    u32x4 w; w.x = cvt_pk_bf16(v0[0], v0[1]); w.y = cvt_pk_bf16(v0[2], v0[3]); w.z = cvt_pk_bf16(v1[0], v1[1]); w.w = cvt_pk_bf16(v1[2], v1[3]);
                    *(u32x4*)(rowp + bj * HALF) = w; } }
    }
};
template <int MODE> struct EpiMerge {
    static constexpr bool PERM = true;
    const bf16_t* G; float* Yf; bf16_t* Yb; float gs;
    __device__ __forceinline__ void operator()(const Acc& acc, const Unit& u, int wr, int wc, int fr, int fq) const {
        const int row0 = u.pm * BM + wr * 64 + fr, col0 = u.pn * BM + wc * 32 + 8 * fq;
#pragma unroll
        for (int ai = 0; ai < 2; ++ai)
#pragma unroll
            for (int m = 0; m < 4; ++m) { const size_t r = (size_t)(row0 + ai * HALF + m * 16);
#pragma unroll
                for (int bj = 0; bj < 2; ++bj) { const int c = col0 + bj * HALF;
#ifdef DBG_GHALF
                    const u32x4 gw = (u32x4){0x3f003f00u, 0x3f003f00u, 0x3f003f00u, 0x3f003f00u};
#else
                    const u32x4 gw = *(const u32x4*)(G + r * GATE_IN + c);
#endif
                    f32x4 v0 = acc[ai][bj][m][0], v1 = acc[ai][bj][m][1];
                    v0[0] *= bf_lo(gw.x); v0[1] *= bf_hi(gw.x); v0[2] *= bf_lo(gw.y); v0[3] *= bf_hi(gw.y);
                    v1[0] *= bf_lo(gw.z); v1[1] *= bf_hi(gw.z); v1[2] *= bf_lo(gw.w); v1[3] *= bf_hi(gw.w); v0 *= gs; v1 *= gs;
                    float* yp = Yf + r * D + c;
                    if (MODE >= 1) { v0 += *(const f32x4*)yp; v1 += *(const f32x4*)(yp + 4); }
                    if (MODE <= 1) { *(f32x4*)yp = v0; *(f32x4*)(yp + 4) = v1; }
                    else { u32x4 w; w.x = cvt_pk_bf16(v0[0], v0[1]); w.y = cvt_pk_bf16(v0[2], v0[3]); w.z = cvt_pk_bf16(v1[0], v1[1]); w.w = cvt_pk_bf16(v1[2], v1[3]);
                        *(u32x4*)(Yb + r * D + c) = w; } }
                asm volatile("" ::: "memory"); }
    }
};
}
namespace att {
constexpr int NW = 8, QBLK = 32, KVBLK = 64;
constexpr float SCALE = 0.072168783648703216f;
constexpr float THR = 8.f;
constexpr int SDEPTH = 1;
constexpr int LDQ = 3072, LDK = 2048, LDR = 64, LDV = 2048, LDO = 4096;
constexpr int NQREG = 5;
constexpr int SHM_V = KVBLK * VD * 2, SHM_K = KVBLK * QKD * 2, SHM_QS = 2 * SHM_V + 2 * SHM_K + NW * 64 * 4, SHM_ATTN = SHM_QS + (12 - NQREG) * 8192;
#define KSWZ(row, colB) ((row) * 384 + ((colB) ^ ((((row) >> 1) & 7) << 4)))
#define SBAR() __builtin_amdgcn_sched_barrier(0)
__device__ __forceinline__ int crow(int r, int hi) { return (r & 3) + 8 * (r >> 2) + 4 * hi; }

__device__ __forceinline__ void partialSM(f32x16& p0, f32x16& p1, float& m_reg, float& mn, float& alpha) {
  constexpr float C = SCALE * 1.4426950408889634f;
  float pmax = p0[0];
#pragma unroll
  for (int r = 1; r < 16; ++r) pmax = fmaxf(pmax, p0[r]);
#pragma unroll
  for (int r = 0; r < 16; ++r) pmax = fmaxf(pmax, p1[r]);
  { auto rr = __builtin_amdgcn_permlane32_swap(__float_as_uint(pmax), __float_as_uint(pmax), false, false);
    pmax = fmaxf(__uint_as_float(rr[0]), __uint_as_float(rr[1])); }
  if (__builtin_expect(__all(pmax - m_reg <= THR / SCALE), 1)) { mn = m_reg; alpha = 1.f; }
  else { mn = fmaxf(m_reg, pmax); alpha = __builtin_amdgcn_exp2f((m_reg - mn) * C); m_reg = mn; }
  float mnC = -mn * C;
#pragma unroll
  for (int r = 0; r < 16; ++r) p0[r] = fmaf(p0[r], C, mnC);
#pragma unroll
  for (int r = 0; r < 16; ++r) p1[r] = fmaf(p1[r], C, mnC);
#pragma unroll
  for (int r = 0; r < 16; ++r) p0[r] = __builtin_amdgcn_exp2f(p0[r]);
}
__device__ __forceinline__ void finishSM(f32x16& p0, f32x16& p1, float alpha, float& l_reg, bf16x8& pa0, bf16x8& pa1, bf16x8& pa2, bf16x8& pa3) {
#pragma unroll
  for (int r = 0; r < 16; ++r) p1[r] = __builtin_amdgcn_exp2f(p1[r]);
  float ps = 0;
#pragma unroll
  for (int r = 0; r < 16; ++r) ps += p0[r];
#pragma unroll
  for (int r = 0; r < 16; ++r) ps += p1[r];
  { auto rr = __builtin_amdgcn_permlane32_swap(__float_as_uint(ps), __float_as_uint(ps), false, false);
    ps = __uint_as_float(rr[0]) + __uint_as_float(rr[1]); }
  l_reg = l_reg * alpha + ps;
#define PK4(P, BASE, OUT) do { unsigned a0 = cvt_pk_bf16(P[BASE + 0], P[BASE + 1]), a1 = cvt_pk_bf16(P[BASE + 2], P[BASE + 3]);   \
    unsigned b0 = cvt_pk_bf16(P[BASE + 4], P[BASE + 5]), b1 = cvt_pk_bf16(P[BASE + 6], P[BASE + 7]);                              \
    auto r0 = __builtin_amdgcn_permlane32_swap(a0, b0, false, false); auto r1 = __builtin_amdgcn_permlane32_swap(a1, b1, false, false); \
    u32x4 w = {r0[0], r1[0], r0[1], r1[1]}; OUT = *reinterpret_cast<bf16x8*>(&w); } while (0)
  PK4(p0, 0, pa0); PK4(p0, 8, pa1); PK4(p1, 0, pa2); PK4(p1, 8, pa3);
#undef PK4
}
__device__ __forceinline__ void qkt(f32x16& p0, f32x16& p1, const char* Ks, const bf16x8* qr, const char* qsp, int r32, int hi) {
  p0 = f32x16{}; p1 = f32x16{};
#pragma unroll
  for (int d0 = 0; d0 < 12; ++d0) { const int cb = (d0 * 16 + hi * 8) * 2;
    bf16x8 b0 = *reinterpret_cast<const bf16x8*>(Ks + KSWZ(r32, cb));
    bf16x8 b1 = *reinterpret_cast<const bf16x8*>(Ks + KSWZ(32 + r32, cb));
    bf16x8 qv; if (d0 < NQREG) qv = qr[d0]; else qv = *reinterpret_cast<const bf16x8*>(qsp + (d0 - NQREG) * 8192);
    p0 = __builtin_amdgcn_mfma_f32_32x32x16_bf16(b0, qv, p0, 0, 0, 0);
    p1 = __builtin_amdgcn_mfma_f32_32x32x16_bf16(b1, qv, p1, 0, 0, 0);
    if (d0 == 5) SBAR(); }
}
__device__ __forceinline__ int v_st(int k, int c) { const int kk = (k & ~0xC) | ((k & 4) << 1) | ((k & 8) >> 1); return ((kk >> 3) * 4 + (c >> 5)) * 512 + ((kk & 7) * 32 + (c & 31)) * 2; }
__device__ __forceinline__ int v_rd_base(int lane) { return ((lane & 3) << 3) | (((lane >> 2) & 3) << 6) | (((lane >> 4) & 1) << 5) | (((lane >> 5) & 1) << 8); }
constexpr int v_rd_off(int d0, int ks, int half) { return d0 * 512 + ks * 4096 + half * 2048; }
template <int OFF> __device__ __forceinline__ s16x4 tr_read(int vb) {
  s16x4 r; asm volatile("ds_read_b64_tr_b16 %0, %1 offset:%2" : "=&v"(r) : "v"(vb), "i"(OFF) : "memory"); return r;
}
template <int D0> __device__ __forceinline__ void pv_one(f32x16& od, int vb, bf16x8 pa0, bf16x8 pa1, bf16x8 pa2, bf16x8 pa3) {
  const s16x4 l0 = tr_read<v_rd_off(D0, 0, 0)>(vb), h0 = tr_read<v_rd_off(D0, 0, 1)>(vb), l1 = tr_read<v_rd_off(D0, 1, 0)>(vb), h1 = tr_read<v_rd_off(D0, 1, 1)>(vb);
  const s16x4 l2 = tr_read<v_rd_off(D0, 2, 0)>(vb), h2 = tr_read<v_rd_off(D0, 2, 1)>(vb), l3 = tr_read<v_rd_off(D0, 3, 0)>(vb), h3 = tr_read<v_rd_off(D0, 3, 1)>(vb);
  asm volatile("s_waitcnt lgkmcnt(0)" ::: "memory"); SBAR();
#define PK(L, H) (bf16x8){L[0], L[1], L[2], L[3], H[0], H[1], H[2], H[3]}
  od = __builtin_amdgcn_mfma_f32_32x32x16_bf16(pa0, PK(l0, h0), od, 0, 0, 0);
  od = __builtin_amdgcn_mfma_f32_32x32x16_bf16(pa1, PK(l1, h1), od, 0, 0, 0);
  od = __builtin_amdgcn_mfma_f32_32x32x16_bf16(pa2, PK(l2, h2), od, 0, 0, 0);
  od = __builtin_amdgcn_mfma_f32_32x32x16_bf16(pa3, PK(l3, h3), od, 0, 0, 0);
#undef PK
}
__device__ __forceinline__ void pv_d0(f32x16* o, int vb, bf16x8 pa0, bf16x8 pa1, bf16x8 pa2, bf16x8 pa3) {
  pv_one<0>(o[0], vb, pa0, pa1, pa2, pa3); pv_one<1>(o[1], vb, pa0, pa1, pa2, pa3); pv_one<2>(o[2], vb, pa0, pa1, pa2, pa3); pv_one<3>(o[3], vb, pa0, pa1, pa2, pa3);
}
__device__ __forceinline__ void attn_body(const bf16_t* __restrict__ Qb, const bf16_t* __restrict__ Kh, const bf16_t* __restrict__ Rh, const bf16_t* __restrict__ Vh, bf16_t* __restrict__ Ob, int seq, const float* __restrict__ rope  , char* lds) {
  int tid_ = threadIdx.x; asm volatile("" : "+v"(tid_));
  const int tid = tid_, wid = tid >> 6, lane = tid & 63, r32 = lane & 31, hi = lane >> 5;
  char* V_lds = lds; char* K_lds = lds + 2 * SHM_V;
  float* ws = (float*)(lds + 2 * SHM_V + 2 * SHM_K) + wid * 64; float* li_l = ws; float* al_l = ws + 32;
  float m_reg = -1e30f, l_reg = 0; f32x16 o[4] = {}; bf16x8 qr[NQREG];
  const bf16_t* Qw = Qb + (long)(wid * QBLK + r32) * LDQ + hi * 8;
  char* qsp = lds + SHM_QS + tid * 16;
#pragma unroll
  for (int d0 = 0; d0 < 12; ++d0) { bf16x8 qv = *reinterpret_cast<const bf16x8*>(Qw + d0 * 16);
    if (d0 >= 8 && rope) {
      const f32x4* cs = reinterpret_cast<const f32x4*>(rope + ((long)(wid * QBLK + r32) * 32 + (d0 - 8) * 8 + hi * 4) * 2); const f32x4 c0 = cs[0], c1 = cs[1];
      const u32x4 w = *reinterpret_cast<const u32x4*>(&qv);
      const float x0 = bf_lo(w.x), x1 = bf_hi(w.x), x2 = bf_lo(w.y), x3 = bf_hi(w.y), x4 = bf_lo(w.z), x5 = bf_hi(w.z), x6 = bf_lo(w.w), x7 = bf_hi(w.w);
      u32x4 o; o.x = cvt_pk_bf16(x0 * c0[0] - x1 * c0[1], x0 * c0[1] + x1 * c0[0]); o.y = cvt_pk_bf16(x2 * c0[2] - x3 * c0[3], x2 * c0[3] + x3 * c0[2]);
      o.z = cvt_pk_bf16(x4 * c1[0] - x5 * c1[1], x4 * c1[1] + x5 * c1[0]); o.w = cvt_pk_bf16(x6 * c1[2] - x7 * c1[3], x6 * c1[3] + x7 * c1[2]);
      qv = *reinterpret_cast<const bf16x8*>(&o); }
    if (d0 < NQREG) qr[d0] = qv; else *reinterpret_cast<bf16x8*>(qsp + (d0 - NQREG) * 8192) = qv; }
  const int sr = tid >> 4, sc = (tid & 15) * 8, vst0 = v_st(sr, sc);
  const int krow = tid >> 3, kc = tid & 7, kst = krow * 384 + ((kc * 16) ^ (((krow >> 1) & 7) << 4));
  const bf16_t* Vg = Vh + (long)sr * LDV + sc; const bf16_t* Kg = Kh + (long)krow * LDK + kc * 8; const bf16_t* Rg = Rh + (long)krow * LDR + kc * 8;
  const int vb0 = (int)(uintptr_t)V_lds + v_rd_base(lane);
  struct { bf16x8 vs0, vs1, ks0, ks1, ks2; } sr_[SDEPTH];
#define SLOAD(i, k0) do { sr_[i].vs0 = *reinterpret_cast<const bf16x8*>(Vg + (long)(k0) * LDV); sr_[i].vs1 = *reinterpret_cast<const bf16x8*>(Vg + (long)((k0) + 32) * LDV); \
    sr_[i].ks0 = *reinterpret_cast<const bf16x8*>(Kg + (long)(k0) * LDK); sr_[i].ks1 = *reinterpret_cast<const bf16x8*>(Kg + (long)(k0) * LDK + 64); \
    sr_[i].ks2 = *reinterpret_cast<const bf16x8*>(Rg + (long)(k0) * LDR); } while (0)
#define SWRITE(b, i) do { *(bf16x8*)(V_lds + (b) * SHM_V + vst0) = sr_[i].vs0; *(bf16x8*)(V_lds + (b) * SHM_V + vst0 + 8192) = sr_[i].vs1; \
    *(bf16x8*)(K_lds + (b) * SHM_K + kst) = sr_[i].ks0; *(bf16x8*)(K_lds + (b) * SHM_K + kst + 128) = sr_[i].ks1; *(bf16x8*)(K_lds + (b) * SHM_K + kst + 256) = sr_[i].ks2; } while (0)
#define SWAIT() do { if constexpr (SDEPTH == 2) asm volatile("s_waitcnt vmcnt(5)" ::: "memory"); else asm volatile("s_waitcnt vmcnt(0)" ::: "memory"); } while (0)
#define RESC(a) do { if (__any((a) < 1.f)) { if (hi == 0) al_l[r32] = (a); asm volatile("s_waitcnt lgkmcnt(0)" ::: "memory"); \
    _Pragma("unroll") for (int d = 0; d < 4; ++d) _Pragma("unroll") for (int r = 0; r < 16; ++r) o[d][r] *= al_l[crow(r, hi)]; } } while (0)
  f32x16 pA0, pA1, pB0, pB1; float mnA, mnB, alA, alB; bf16x8 pa0, pa1, pa2, pa3; const int NT = seq / KVBLK;
  constexpr int SE = 0, SO = SDEPTH - 1;
  SLOAD(SE, 0); asm volatile("s_waitcnt vmcnt(0)" ::: "memory"); SWRITE(0, SE); __syncthreads();
  qkt(pA0, pA1, K_lds, qr, qsp, r32, hi); partialSM(pA0, pA1, m_reg, mnA, alA);
  SLOAD(SO, KVBLK); if constexpr (SDEPTH == 2) { if (2 < NT) SLOAD(SE, 2 * KVBLK); }
  SWAIT(); SWRITE(1, SO); __syncthreads();
  for (int j = 1; j + 1 < NT; j += 2) {
    SBAR(); qkt(pB0, pB1, K_lds + SHM_K, qr, qsp, r32, hi);
    finishSM(pA0, pA1, alA, l_reg, pa0, pa1, pa2, pa3); SBAR();
    SLOAD(SO, (j + SDEPTH) * KVBLK); SBAR();
    pv_d0(o, vb0, pa0, pa1, pa2, pa3); partialSM(pB0, pB1, m_reg, mnB, alB);
    __syncthreads(); SWAIT(); SWRITE(0, SE);
    RESC(alB); __syncthreads();
    SBAR(); qkt(pA0, pA1, K_lds, qr, qsp, r32, hi);
    finishSM(pB0, pB1, alB, l_reg, pa0, pa1, pa2, pa3); SBAR();
    if (SDEPTH == 1 || j + 3 < NT) SLOAD(SE, (j + 1 + SDEPTH) * KVBLK); SBAR();
    pv_d0(o, vb0 + (int)SHM_V, pa0, pa1, pa2, pa3); partialSM(pA0, pA1, m_reg, mnA, alA);
    __syncthreads(); SWAIT(); SWRITE(1, SO);
    RESC(alA); __syncthreads();
  }
  SBAR(); qkt(pB0, pB1, K_lds + SHM_K, qr, qsp, r32, hi);
  finishSM(pA0, pA1, alA, l_reg, pa0, pa1, pa2, pa3); SBAR();
  pv_d0(o, vb0, pa0, pa1, pa2, pa3); partialSM(pB0, pB1, m_reg, mnB, alB);
  __syncthreads(); RESC(alB);
  finishSM(pB0, pB1, alB, l_reg, pa0, pa1, pa2, pa3); SBAR();
  pv_d0(o, vb0 + (int)SHM_V, pa0, pa1, pa2, pa3);
  if (hi == 0) li_l[r32] = l_reg; asm volatile("s_waitcnt lgkmcnt(0)" ::: "memory");
  float rli[16];
#pragma unroll
  for (int r = 0; r < 16; ++r) rli[r] = __builtin_amdgcn_rcpf(li_l[crow(r, hi)]);
  bf16_t* Ow = Ob + (long)(wid * QBLK) * LDO;
#pragma unroll
  for (int r = 0; r < 16; ++r) { const int orow = crow(r, hi);
#pragma unroll
    for (int d0 = 0; d0 < 4; ++d0) Ow[(long)orow * LDO + d0 * 32 + r32] = f2bf(o[d0][r] * rli[r]); }
#undef SLOAD
#undef SWRITE
#undef SWAIT
#undef RESC
}
}
#define RLX_AGENT __ATOMIC_RELAXED, __HIP_MEMORY_SCOPE_AGENT
#define LDS_WAIT() asm volatile("s_waitcnt lgkmcnt(0)" ::: "memory")
#define VM_WAIT() asm volatile("s_waitcnt vmcnt(0)" ::: "memory")

#define XB_TMO      128
#define XB_XCNT(j)  (256  + 64 * (j))
#define XB_XSUB(j)  (1280 + 64 * (j))
#define XB_XGEN(j)  (2304 + 64 * (j))
#define XB_TOP      3328
#define XB_TOPGEN   3392
#define XCD_BAR_WORDS 3456
#define XB_SPIN_CAP (1u << 22)
__device__ __forceinline__ unsigned xb_ld(unsigned* p)              { return __hip_atomic_load(p, __ATOMIC_RELAXED, __HIP_MEMORY_SCOPE_AGENT); }
__device__ __forceinline__ unsigned xb_add(unsigned* p, unsigned v) { return __hip_atomic_fetch_add(p, v, __ATOMIC_RELAXED, __HIP_MEMORY_SCOPE_AGENT); }
__device__ __forceinline__ unsigned xb_xcc_id() { return (unsigned)__builtin_amdgcn_s_getreg((3 << 11) | 20) & 0xFu; }
#define XB_SPIN(cond, bar) do { unsigned _sp = 0; while (cond) { __builtin_amdgcn_s_sleep(1); \
    if ((++_sp & 255u) == 0u) { if (xb_ld(&(bar)[XB_TMO])) break; if (_sp > XB_SPIN_CAP) { atomicAdd(&(bar)[XB_TMO], 1u); break; } } } } while (0)
struct XcdBarrier { unsigned* bar; unsigned x; volatile LAS unsigned* st; };
__device__ __forceinline__ XcdBarrier xcd_barrier_post(unsigned* bar, volatile LAS unsigned* st) {
    XcdBarrier b; b.bar = bar; b.x = xb_xcc_id(); b.st = st;
    if (threadIdx.x == 0) (void)xb_add(&bar[XB_XCNT(b.x)], 1u);
    return b;
}
__device__ __forceinline__ void xcd_barrier_complete(unsigned* bar, unsigned x, unsigned& nloc, unsigned& nx) {
    const unsigned G = gridDim.x * gridDim.y * gridDim.z;
    unsigned sum, cnt, mine, sp = 0u;
    for (;;) {
        sum = 0u; cnt = 0u; mine = 0u;
#pragma unroll
        for (unsigned j = 0; j < 16; ++j) { const unsigned c = xb_ld(&bar[XB_XCNT(j)]); sum += c; cnt += (c > 0u) ? 1u : 0u; mine = (j == x) ? c : mine; }
        if (sum == G) break;
        __builtin_amdgcn_s_sleep(1);
        if ((++sp & 255u) == 0u) { if (xb_ld(&bar[XB_TMO])) break; if (sp > XB_SPIN_CAP) { atomicAdd(&bar[XB_TMO], 1u); break; } }
    }
    nloc = mine > 0u ? mine : 1u; nx = cnt > 0u ? cnt : 1u;
}
__device__ __forceinline__ void xcd_barrier(const XcdBarrier& b) {
    asm volatile("s_waitcnt vmcnt(0)" ::: "memory");
    __syncthreads();
    if (threadIdx.x == 0) {
        unsigned* bar = b.bar;
        __builtin_amdgcn_s_waitcnt(0);
        unsigned nloc = b.st[0], nx = b.st[1];
        if (nloc == 0u) { xcd_barrier_complete(bar, b.x, nloc, nx); b.st[0] = nloc; b.st[1] = nx; }
        const unsigned old = xb_add(&bar[XB_XSUB(b.x)], 1u);
        const unsigned gen = old / nloc;
        if (old + 1u == (gen + 1u) * nloc) {
            __builtin_amdgcn_fence(__ATOMIC_RELEASE, "agent");
            asm volatile("s_waitcnt vmcnt(0)" ::: "memory");
            const unsigned og = xb_add(&bar[XB_TOP], 1u);
            const unsigned tg = og / nx;
            if (og + 1u == (tg + 1u) * nx) xb_add(&bar[XB_TOPGEN], 1u);
            else XB_SPIN(xb_ld(&bar[XB_TOPGEN]) == tg, bar);
            __builtin_amdgcn_fence(__ATOMIC_ACQUIRE, "agent");
            xb_add(&bar[XB_XGEN(b.x)], 1u);
            asm volatile("s_waitcnt vmcnt(0)" ::: "memory");
        } else {
            XB_SPIN(xb_ld(&bar[XB_XGEN(b.x)]) == gen, bar);
            __builtin_amdgcn_fence(__ATOMIC_ACQUIRE, "agent");
            asm volatile("s_waitcnt vmcnt(0)" ::: "memory");
        }
    }
    __syncthreads();
}

enum { I_X = 0, I_C, I_CTX, I_CCTX, I_ADAW, I_ADAB, I_LNG, I_LNB, I_WGATE, I_WUP, I_WDOWN, I_WIN, I_GATEB, I_MU, I_W0, I_WUPL, I_A0, I_AUP, I_GUP, I_KK, I_KA, I_RK, I_LNXG, I_LNXB,
       I_QNORM, I_KVNORM, I_WUQ, I_WUK, I_WUV, I_CONVW, I_CONVB, I_LRUWA, I_LRUBA, I_LRUWX, I_LRUBX, I_LAMBDA, I_PRWKV, I_PMLA, I_PLRU, I_WOUT };

struct Ctx {
    LAS unsigned char* lds; unsigned char* ws; const float* const* in; float* out;
    int tid, lane, wave, G, vcu, gw, NGW;
};

__device__ __forceinline__ void ph_modp(Ctx& F) {
    LAS float* sl = (LAS float*)F.lds;
    for (int i = F.tid; i < 5 * 2048; i += 512) { const int r = i >> 11, k = i & 2047; const float v = r < 4 ? F.in[I_C][r * 2048 + k] : F.in[I_CCTX][k]; sl[i] = siluf_(v); }
    __syncthreads();
    float* modp = (float*)(F.ws + WS_R + R_MODP);
    const int NIT = 16 * 9216;
    for (int it = blockIdx.x * 512 + F.tid; it < NIT; it += F.G * 512) {
        const int kc = it / 9216, c4 = it % 9216, cc = c4 * 4, l = cc / 18432, c = cc % 18432;
        const float* w = F.in[I_ADAW] + ((size_t)l * 2048 + kc * 128) * 18432 + c;
        f32x4 a0 = {0, 0, 0, 0}, a1 = a0, a2 = a0, a3 = a0, a4 = a0;
#pragma unroll 4
        for (int k = 0; k < 128; ++k) { const f32x4 wv = *(const f32x4*)(w + (size_t)k * 18432); const int kk = kc * 128 + k;
            a0 += wv * sl[kk]; a1 += wv * sl[2048 + kk]; a2 += wv * sl[4096 + kk]; a3 += wv * sl[6144 + kk]; a4 += wv * sl[8192 + kk]; }
        float* o = modp + (size_t)kc * 5 * 36864 + cc;
        *(f32x4*)(o) = a0; *(f32x4*)(o + 36864) = a1; *(f32x4*)(o + 2 * 36864) = a2; *(f32x4*)(o + 3 * 36864) = a3; *(f32x4*)(o + 4 * 36864) = a4;
    }
    __syncthreads();
}
__device__ __forceinline__ void ph_rope(Ctx& F) {
    float* rope = (float*)(F.ws + WS_ROPE);
    for (int i = blockIdx.x * 512 + F.tid; i < 4096 * 32; i += F.G * 512) { const int t = i >> 5, p = i & 31;
        const float inv = powf(10000.0f, -(float)(p & 15) / 16.0f); const float pos = (float)(p < 16 ? (t >> 6) : (t & 63)); const float ang = pos * inv;
        rope[2 * i] = cosf(ang); rope[2 * i + 1] = sinf(ang); }
}
__device__ __forceinline__ void ph_xasm(Ctx& F) {
    f32x4* X = (f32x4*)(F.ws + WS_X);
    for (size_t i = (size_t)blockIdx.x * 512 + F.tid; i < (size_t)M * 512; i += (size_t)F.G * 512) { const int n = (int)(i >> 9), c = (int)(i & 511), b = n / TPB, j = n % TPB;
        const f32x4* src = j < CTX ? (const f32x4*)(F.in[I_CTX] + ((size_t)b * CTX + j) * D) : (const f32x4*)(F.in[I_X] + ((size_t)b * SEQ + (j - CTX)) * D);
        X[i] = src[c]; }
}
struct CvtJob { const float* src; int sld, K, N, n0;  bf16_t* dst; int dld, kd0, rgrp, rstride, roff; };
__device__ __forceinline__ void cvt_item(const CvtJob& J, int item, LAS float* scr, int lane) {
    const int nblk = J.N / 32, kb = item / nblk, nb = item % nblk, k0 = 64 * kb, n0 = 32 * nb;
#pragma unroll 8
    for (int i = 0; i < 32; ++i) { const int kk = 2 * i + (lane >> 5); scr[kk * 33 + (lane & 31)] = (k0 + kk < J.K) ? J.src[(size_t)(k0 + kk) * J.sld + J.n0 + n0 + (lane & 31)] : 0.f; }
    LDS_WAIT(); asm volatile("" ::: "memory");
    const int c = lane & 7;
    if (k0 + 8 * c < J.K) {
#pragma unroll
    for (int j = 0; j < 4; ++j) { const int n = (lane >> 3) + 8 * j; const LAS float* s = scr + (8 * c) * 33 + n;
        u32x4 o; o.x = cvt_pk_bf16(s[0 * 33], s[1 * 33]); o.y = cvt_pk_bf16(s[2 * 33], s[3 * 33]); o.z = cvt_pk_bf16(s[4 * 33], s[5 * 33]); o.w = cvt_pk_bf16(s[6 * 33], s[7 * 33]);
        const int nn = n0 + n; const int row = (nn / J.rgrp) * J.rstride + nn % J.rgrp + J.roff;
        *(u32x4*)(J.dst + (size_t)row * J.dld + J.kd0 + k0 + 8 * c) = o; }
    }
    LDS_WAIT(); asm volatile("" ::: "memory");
}
constexpr int NCVT = 20 + 32;
__device__ __forceinline__ CvtJob cvt_job(Ctx& F, int l, int j) {
    unsigned char* W = F.ws + WS_W; CvtJob J; const int BIG = 1 << 30;
    J.n0 = 0; J.kd0 = 0; J.rgrp = BIG; J.rstride = 0; J.roff = 0;
    switch (j) {
    case 0: case 1: case 2: case 3: { const int ff = j >> 1, up = j & 1;
        J.src = F.in[up ? I_WUP : I_WGATE] + ((size_t)l * 2 + ff) * 2048 * DFF; J.sld = DFF; J.K = 2048; J.N = DFF; J.dst = (bf16_t*)(W + (ff ? W_GU1 : W_GU0)); J.dld = 2048; J.rgrp = 128; J.rstride = 256; J.roff = up * 128; break; }
    case 4: case 5: { const int ff = j - 4; J.src = F.in[I_WDOWN] + ((size_t)l * 2 + ff) * DFF * 2048; J.sld = 2048; J.K = DFF; J.N = 2048; J.dst = (bf16_t*)(W + (ff ? W_D1 : W_D0)); J.dld = DFF; break; }
    case 6: J.src = F.in[I_WIN] + (size_t)l * 2048 * IN_COLS; J.sld = IN_COLS; J.K = 2048; J.N = FA; J.dst = (bf16_t*)(W + W_INA); J.dld = 2048; break;
    case 7: J.src = F.in[I_WIN] + (size_t)l * 2048 * IN_COLS; J.sld = IN_COLS; J.K = 2048; J.N = GATE_IN; J.n0 = FA; J.dst = (bf16_t*)(W + W_ING); J.dld = 2048; break;
    case 8: J.src = F.in[I_WUQ] + (size_t)l * 512 * 3072; J.sld = 3072; J.K = 512; J.N = 3072; J.dst = (bf16_t*)(W + W_UQ); J.dld = 512; break;
    case 9: J.src = F.in[I_WUK] + (size_t)l * 256 * 2048; J.sld = 2048; J.K = 256; J.N = 2048; J.dst = (bf16_t*)(W + W_UKV); J.dld = 256; break;
    case 10: J.src = F.in[I_WUV] + (size_t)l * 256 * 2048; J.sld = 2048; J.K = 256; J.N = 2048; J.dst = (bf16_t*)(W + W_UKV); J.dld = 256; J.roff = 2048; break;
    case 11: case 12: { const int d = j - 11; J.src = F.in[I_WUPL] + ((size_t)l * 2 + d) * 64 * 1024; J.sld = 1024; J.K = 64; J.N = 1024; J.dst = (bf16_t*)(W + W_LORA); J.dld = LORA_K; J.roff = d * 1024; break; }
    case 13: case 14: { const int d = j - 13; J.src = F.in[I_AUP] + ((size_t)l * 2 + d) * 64 * 1024; J.sld = 1024; J.K = 64; J.N = 1024; J.dst = (bf16_t*)(W + W_LORA); J.dld = LORA_K; J.roff = 2048 + d * 1024; J.kd0 = 64; break; }
    case 15: J.src = F.in[I_GUP] + (size_t)l * 160 * 1024; J.sld = 1024; J.K = 160; J.N = 1024; J.dst = (bf16_t*)(W + W_LORA); J.dld = LORA_K; J.roff = 4096; J.kd0 = 128; break;
    case 16: J.src = F.in[I_PRWKV] + (size_t)l * 1024 * 2048; J.sld = 2048; J.K = 1024; J.N = 2048; J.dst = (bf16_t*)(W + W_PROJ); J.dld = 4096; J.kd0 = 0; break;
    case 17: J.src = F.in[I_PMLA] + (size_t)l * 2048 * 2048; J.sld = 2048; J.K = 2048; J.N = 2048; J.dst = (bf16_t*)(W + W_PROJ); J.dld = 4096; J.kd0 = 1024; break;
    case 18: J.src = F.in[I_PLRU] + (size_t)l * 1024 * 2048; J.sld = 2048; J.K = 1024; J.N = 2048; J.dst = (bf16_t*)(W + W_PROJ); J.dld = 4096; J.kd0 = 3072; break;
    case 19: J.src = F.in[I_WOUT] + (size_t)l * 2048 * 2048; J.sld = 2048; J.K = 2048; J.N = 2048; J.dst = (bf16_t*)(W + W_OUT); J.dld = 2048; break;
    default: { const int q = j - 20, x = q >> 4, d = (q >> 3) & 1, nb = q & 7;
        J.src = F.in[x ? I_LRUWX : I_LRUWA] + (((size_t)l * 2 + d) * 8 + nb) * 128 * 128; J.sld = 128; J.K = 128; J.N = 128; J.dst = (bf16_t*)(W + W_LRU) + (size_t)nb * 512 * 256; J.dld = 256; J.roff = d * 256 + x * 128; J.kd0 = (nb & 1) * 128; break; }
    }
    return J;
}
__device__ __forceinline__ int cvt_items(const CvtJob& J) { return ((J.K + 63) / 64) * (J.N / 32); }
__device__ __forceinline__ void zero_rect(Ctx& F, bf16_t* dst, int ld, int row0, int nrows, int k0, int nk) {
    const int per = nk / 8; const long tot = (long)nrows * per;
    for (long i = (long)blockIdx.x * 512 + F.tid; i < tot; i += (long)F.G * 512) { const int r = (int)(i / per), c = (int)(i % per);
        *(u32x4*)(dst + (size_t)(row0 + r) * ld + k0 + c * 8) = (u32x4){0u, 0u, 0u, 0u}; }
}
__device__ __forceinline__ void ph_cvt(Ctx& F, int l) {
    LAS float* scr = (LAS float*)(F.lds + F.wave * 16384);
    int base = 0;
    for (int j = 0; j < NCVT; ++j) { const CvtJob J = cvt_job(F, l, j); const int ni = cvt_items(J);
        int first = (F.gw - base % F.NGW + F.NGW) % F.NGW;
        for (int it = first; it < ni; it += F.NGW) cvt_item(J, it, scr, F.lane);
        base += ni; }
    unsigned char* W = F.ws + WS_W;
    zero_rect(F, (bf16_t*)(W + W_INA), 2048, FA, FA_PAD - FA, 0, 2048);
    zero_rect(F, (bf16_t*)(W + W_LORA), LORA_K, 0, 2048, 64, LORA_K - 64);
    zero_rect(F, (bf16_t*)(W + W_LORA), LORA_K, 2048, 2048, 0, 64);
    zero_rect(F, (bf16_t*)(W + W_LORA), LORA_K, 2048, 2048, 128, LORA_K - 128);
    zero_rect(F, (bf16_t*)(W + W_LORA), LORA_K, 4096, 1024, 0, 128);
    zero_rect(F, (bf16_t*)(W + W_LORA), LORA_K, 4096, 1024, 288, LORA_K - 288);
    for (int nb = 0; nb < 8; ++nb) zero_rect(F, (bf16_t*)(W + W_LRU) + (size_t)nb * 512 * 256, 256, 0, 512, (1 - (nb & 1)) * 128, 128);
}
__device__ __forceinline__ void ph_modr(Ctx& F) {
    const float* modp = (const float*)(F.ws + WS_R + R_MODP); float* mod = (float*)(F.ws + WS_MOD);
    for (int i = blockIdx.x * 512 + F.tid; i < 5 * 36864; i += F.G * 512) { const int r = i / 36864, cc = i % 36864, l = cc / 18432, c = cc % 18432;
        float s = F.in[I_ADAB][cc];
#pragma unroll
        for (int kc = 0; kc < 16; ++kc) s += modp[(size_t)kc * 5 * 36864 + i];
        mod[((size_t)l * 5 + r) * 18432 + c] = s; }
}
__device__ __forceinline__ void ph_h0(Ctx& F) {
    const float* X = (const float*)(F.ws + WS_X); bf16_t* H = (bf16_t*)(F.ws + WS_H); const float* mod = (const float*)(F.ws + WS_MOD);
    for (int n = F.gw; n < M; n += F.NGW) { const int mr = (n % TPB) < CTX ? 4 : n / TPB; const float* sh = mod + (size_t)mr * 18432; const float* sc = sh + 2048;
#pragma unroll
        for (int j = 0; j < 8; ++j) { const int c = 4 * F.lane + 256 * j; const f32x4 x = *(const f32x4*)(X + (size_t)n * D + c), s = *(const f32x4*)(sc + c), t = *(const f32x4*)(sh + c);
            const f32x4 y = x * (1.0f + s) + t; u32x2 w; w.x = cvt_pk_bf16(y[0], y[1]); w.y = cvt_pk_bf16(y[2], y[3]); *(u32x2*)(H + (size_t)n * D + c) = w; } }
}
__device__ __forceinline__ void ph_ln(Ctx& F, const float* g, const float* b, const float* modl  , int sh_chunk, int sc_chunk, bool final_) {
    float* X = (float*)(F.ws + WS_X); bf16_t* H = (bf16_t*)(F.ws + WS_H);
    for (int n = F.gw; n < M; n += F.NGW) { const int bb = n / TPB, j0 = n % TPB; const int mr = j0 < CTX ? 4 : bb;
        if (final_ && j0 < CTX) continue;
        f32x4 v[8]; float s = 0.f;
#pragma unroll
        for (int j = 0; j < 8; ++j) { v[j] = *(const f32x4*)(X + (size_t)n * D + 4 * F.lane + 256 * j); s += (v[j][0] + v[j][1]) + (v[j][2] + v[j][3]); }
        const float mean = wave_sum(s) * (1.f / D); float s2 = 0.f;
#pragma unroll
        for (int j = 0; j < 8; ++j) { v[j] = v[j] - mean; s2 += (v[j][0] * v[j][0] + v[j][1] * v[j][1]) + (v[j][2] * v[j][2] + v[j][3] * v[j][3]); }
        const float rstd = 1.0f / sqrtf(wave_sum(s2) * (1.f / D) + LN_EPS);
        const float* sh = modl + (size_t)mr * 18432 + sh_chunk * 2048; const float* sc = modl + (size_t)mr * 18432 + sc_chunk * 2048;
#pragma unroll
        for (int j = 0; j < 8; ++j) { const int c = 4 * F.lane + 256 * j; const f32x4 y = v[j] * rstd * *(const f32x4*)(g + c) + *(const f32x4*)(b + c);
            if (final_) { *(f32x4*)(F.out + ((size_t)bb * SEQ + (j0 - CTX)) * D + c) = y; }
            else { *(f32x4*)(X + (size_t)n * D + c) = y; const f32x4 h = y * (1.0f + *(const f32x4*)(sc + c)) + *(const f32x4*)(sh + c);
                u32x2 w; w.x = cvt_pk_bf16(h[0], h[1]); w.y = cvt_pk_bf16(h[2], h[3]); *(u32x2*)(H + (size_t)n * D + c) = w; } } }
}
#ifndef DBG_RW_D0
#define DBG_RW_D0 1.0f
#endif
#ifndef DBG_RW_D1
#define DBG_RW_D1 1.0f
#endif
#ifndef DBG_LRU_D0
#define DBG_LRU_D0 1.0f
#endif
#ifndef DBG_LRU_D1
#define DBG_LRU_D1 1.0f
#endif
__device__ __forceinline__ void unpack8(const u32x4 w, float (&x)[8]) { x[0] = bf_lo(w.x); x[1] = bf_hi(w.x); x[2] = bf_lo(w.y); x[3] = bf_hi(w.y); x[4] = bf_lo(w.z); x[5] = bf_hi(w.z); x[6] = bf_lo(w.w); x[7] = bf_hi(w.w); }
__device__ __forceinline__ u32x4 pack8(const float (&x)[8]) { u32x4 w; w.x = cvt_pk_bf16(x[0], x[1]); w.y = cvt_pk_bf16(x[2], x[3]); w.z = cvt_pk_bf16(x[4], x[5]); w.w = cvt_pk_bf16(x[6], x[7]); return w; }
__device__ __forceinline__ int seq_j(int dir, int p) { return dir == 0 ? p : (p < CTX ? (CTX - 1 - p) : (TPB + CTX - 1 - p)); }

__device__ __forceinline__ void ph_prep(Ctx& F, int l) {
    const bf16_t* FAp = (const bf16_t*)(F.ws + WS_R + R_FA);
    bf16_t* LIN = (bf16_t*)(F.ws + WS_R + R_LIN); bf16_t* RKV = (bf16_t*)(F.ws + WS_R + R_RKV); bf16_t* XC = (bf16_t*)(F.ws + WS_R + R_XC); bf16_t* GB = (bf16_t*)(F.ws + WS_R + R_GB);
    bf16_t* QL = (bf16_t*)(F.ws + WS_R + R_QL); bf16_t* KVC = (bf16_t*)(F.ws + WS_R + R_KVC); bf16_t* KR = (bf16_t*)(F.ws + WS_R + R_KR);
    const float* mu = F.in[I_MU] + (size_t)l * RW_IN; const float* qn = F.in[I_QNORM] + (size_t)l * 512; const float* kvn = F.in[I_KVNORM] + (size_t)l * 256;
    const float* cw = F.in[I_CONVW] + (size_t)l * 4 * 1024; const float* cb = F.in[I_CONVB] + (size_t)l * 1024; const float* rope = (const float*)(F.ws + WS_ROPE);
    const int lane = F.lane;
    for (int n = F.gw; n < M; n += F.NGW) {
        const int j = n % TPB; const bool isctx = j < CTX; const int t = j - CTX;
        int nb0, nb1, nb2, nb3;
        if (isctx) { nb0 = j > 0 ? n - 1 : -1; nb1 = j < CTX - 1 ? n + 1 : -1; nb2 = nb0; nb3 = nb1; }
        else { const int gc = t & 63, gr = t >> 6; nb0 = gc > 0 ? n - 1 : -1; nb1 = gc < 63 ? n + 1 : -1; nb2 = gr > 0 ? n - 64 : -1; nb3 = gr < 63 ? n + 64 : -1; }
        const bf16_t* Fr = FAp + (size_t)n * FA_PAD;
#pragma unroll 1
        for (int it = 0; it < 7; ++it) { const int ch = lane + 64 * it; if (ch >= 420) break;
            const int q = ch / 105; const int nb = q == 0 ? nb0 : (q == 1 ? nb1 : (q == 2 ? nb2 : nb3));
            float own[8], sh[8], f[8]; unpack8(*(const u32x4*)(Fr + ch * 8), own);
            if (nb >= 0) unpack8(*(const u32x4*)(FAp + (size_t)nb * FA_PAD + ch * 8), sh); else {
#pragma unroll
                for (int i = 0; i < 8; ++i) sh[i] = 0.f; }
            const f32x4 m0 = *(const f32x4*)(mu + ch * 8), m1 = *(const f32x4*)(mu + ch * 8 + 4);
#pragma unroll
            for (int i = 0; i < 8; ++i) { const float mm = i < 4 ? m0[i] : m1[i - 4]; f[i] = own[i] + (sh[i] - own[i]) * mm; }
            if (ch < 384) { *(u32x4*)(RKV + (size_t)n * 3072 + ch * 8) = pack8(f); }
            else if (ch < 392) {
#pragma unroll
                for (int i = 0; i < 8; ++i) f[i] = tanhf(f[i]);
                *(u32x4*)(LIN + (size_t)n * LORA_K + (ch - 384) * 8) = pack8(f); }
            else if (ch < 400) { *(u32x4*)(LIN + (size_t)n * LORA_K + 64 + (ch - 392) * 8) = pack8(f); }
            else {
#pragma unroll
                for (int i = 0; i < 8; ++i) f[i] = sigmoidf_(f[i]);
                *(u32x4*)(LIN + (size_t)n * LORA_K + 128 + (ch - 400) * 8) = pack8(f); }
        }
        if (lane < 12) *(u32x4*)(LIN + (size_t)n * LORA_K + 288 + lane * 8) = (u32x4){0u, 0u, 0u, 0u};
        { float x[8]; unpack8(*(const u32x4*)(Fr + OFF_QLAT + lane * 8), x); float ss = 0.f;
#pragma unroll
          for (int i = 0; i < 8; ++i) ss += x[i] * x[i];
          const float r = 1.0f / sqrtf(wave_sum(ss) * (1.f / 512.f) + LN_EPS); const f32x4 g0 = *(const f32x4*)(qn + lane * 8), g1 = *(const f32x4*)(qn + lane * 8 + 4);
#pragma unroll
          for (int i = 0; i < 8; ++i) x[i] = x[i] * r * (i < 4 ? g0[i] : g1[i - 4]);
          *(u32x4*)(QL + (size_t)n * 512 + lane * 8) = pack8(x); }
        { float x[8]; const int ll = lane & 31; unpack8(*(const u32x4*)(Fr + OFF_KVLAT + ll * 8), x); float ss = 0.f;
#pragma unroll
          for (int i = 0; i < 8; ++i) ss += x[i] * x[i];
          if (lane >= 32) ss = 0.f;
          const float r = 1.0f / sqrtf(wave_sum(ss) * (1.f / 256.f) + LN_EPS); const f32x4 g0 = *(const f32x4*)(kvn + ll * 8), g1 = *(const f32x4*)(kvn + ll * 8 + 4);
#pragma unroll
          for (int i = 0; i < 8; ++i) x[i] = x[i] * r * (i < 4 ? g0[i] : g1[i - 4]);
          if (lane < 32) *(u32x4*)(KVC + (size_t)n * 256 + ll * 8) = pack8(x); }
        if (lane < 8) { float x[8], y[8]; unpack8(*(const u32x4*)(Fr + OFF_KROPE + lane * 8), x);
            if (!isctx) { const float* cs = rope + ((size_t)t * 32 + lane * 4) * 2;
#pragma unroll
                for (int p = 0; p < 4; ++p) { const float c = cs[2 * p], s = cs[2 * p + 1]; y[2 * p] = x[2 * p] * c - x[2 * p + 1] * s; y[2 * p + 1] = x[2 * p] * s + x[2 * p + 1] * c; } }
            else {
#pragma unroll
                for (int i = 0; i < 8; ++i) y[i] = x[i]; }
            *(u32x4*)(KR + (size_t)n * 64 + lane * 8) = pack8(y); }
        const int spos = isctx ? j : t, slen = isctx ? CTX : SEQ;
#pragma unroll 1
        for (int it = 0; it < 2; ++it) { const int c0 = (lane + 64 * it) * 8; float acc[8];
            { const f32x4 b0 = *(const f32x4*)(cb + c0), b1 = *(const f32x4*)(cb + c0 + 4);
#pragma unroll
              for (int i = 0; i < 8; ++i) acc[i] = i < 4 ? b0[i] : b1[i - 4]; }
#pragma unroll
            for (int jj = 0; jj < 4; ++jj) { const int pos = spos - 2 + jj; if (pos < 0 || pos >= slen) continue;
                float x[8]; unpack8(*(const u32x4*)(FAp + (size_t)(n - 2 + jj) * FA_PAD + OFF_XR + c0), x);
                const f32x4 w0 = *(const f32x4*)(cw + jj * 1024 + c0), w1 = *(const f32x4*)(cw + jj * 1024 + c0 + 4);
#pragma unroll
                for (int i = 0; i < 8; ++i) acc[i] += x[i] * (i < 4 ? w0[i] : w1[i - 4]); }
            *(u32x4*)(XC + (size_t)n * 1024 + c0) = pack8(acc);
            *(u32x4*)(GB + (size_t)n * 1024 + c0) = *(const u32x4*)(Fr + OFF_GB + c0); }
    }
}
__device__ __forceinline__ float dpp_red8(float x) {
    x += __builtin_bit_cast(float, __builtin_amdgcn_update_dpp(0, __builtin_bit_cast(int, x), 0xB1, 0xF, 0xF, true));
    x += __builtin_bit_cast(float, __builtin_amdgcn_update_dpp(0, __builtin_bit_cast(int, x), 0x4E, 0xF, 0xF, true));
    x += __builtin_bit_cast(float, __builtin_amdgcn_update_dpp(0, __builtin_bit_cast(int, x), 0x141, 0xF, 0xF, true));
    return x;
}
constexpr int SC_T = 32, SC_STEP = 352  , SC_BUF = SC_T * SC_STEP, SC_NCH = TPB / SC_T;
__device__ __forceinline__ void ph_rwkv_scan(Ctx& F, int l) {
    const bf16_t* RKV = (const bf16_t*)(F.ws + WS_R + R_RKV); const bf16_t* LO = (const bf16_t*)(F.ws + WS_R + R_LO); bf16_t* YS = (bf16_t*)(F.ws + WS_R + R_YS);
    LAS float* OP = (LAS float*)F.lds; LAS float* YB = (LAS float*)(F.lds + 2 * SC_BUF * 4);
    const int lane = F.lane, wave = F.wave;
    for (int item = F.vcu; item < 256; item += F.G) {
        const int vhalf = item & 1, dir = (item >> 1) & 1, h = (item >> 2) & 15, b = item >> 6;
        const int ch = h * 64 + lane; const size_t nb0 = (size_t)b * TPB;
        if (wave >= 4) {
            const float kkc = F.in[I_KK][(size_t)l * 1024 + ch], kac = F.in[I_KA][(size_t)l * 1024 + ch];
            const float w0c = F.in[I_W0][((size_t)l * 2 + dir) * 1024 + ch], a0c = F.in[I_A0][((size_t)l * 2 + dir) * 1024 + ch];
            const int sw = wave - 4, st = F.tid - 256;
            for (int ci = -1; ci < SC_NCH; ++ci) {
                if (ci + 1 < SC_NCH) { const int cn = ci + 1; LAS float* ob = OP + (cn & 1) * SC_BUF;
                    bf16_t vr[8], vk[8], vv[8], vw[8], va[8];
#pragma unroll
                    for (int q = 0; q < 8; ++q) { const int s = sw * 8 + q; const size_t n = nb0 + seq_j(dir, cn * SC_T + s);
                        vr[q] = RKV[n * 3072 + ch]; vk[q] = RKV[n * 3072 + 1024 + ch]; vv[q] = RKV[n * 3072 + 2048 + ch];
                        vw[q] = LO[n * LORA_N + dir * 1024 + ch]; va[q] = LO[n * LORA_N + 2048 + dir * 1024 + ch]; }
#pragma unroll
                    for (int q = 0; q < 8; ++q) { const int s = sw * 8 + q; LAS float* o = ob + s * SC_STEP;
                        const float r = bf2f(vr[q]), kx = bf2f(vk[q]), v = bf2f(vv[q]), wl = bf2f(vw[q]), al = bf2f(va[q]);
                        const float kkv = kx * kkc; const float nrm = sqrtf(wave_sum(kkv * kkv)); const float kk = kkv / fmaxf(nrm, 1e-12f);
                        const float wlog = -softplusf_(-(w0c + wl)) - 0.5f; const float dec = __expf(-__expf(wlog));
                        const float a = sigmoidf_(a0c + al); const float km = kx * (1.0f + (a - 1.0f) * kac);
                        o[lane] = dec; o[64 + lane] = kk; o[128 + lane] = a * kk; o[192 + lane] = km; o[256 + lane] = r;
                        if ((lane >> 5) == vhalf) o[320 + (lane & 31)] = v; } }
                if (ci >= 1) { const int cp = ci - 1; const LAS float* yb = YB + (cp & 1) * (SC_T * 32); const int s = st >> 3, i0 = (st & 7) * 4;
                    const size_t n = nb0 + seq_j(dir, cp * SC_T + s); const f32x4 y = *(const LAS f32x4*)(yb + s * 32 + i0);
                    u32x2 w; w.x = cvt_pk_bf16(y[0], y[1]); w.y = cvt_pk_bf16(y[2], y[3]);
                    *(u32x2*)(YS + ((size_t)dir * M + n) * 1024 + h * 64 + vhalf * 32 + i0) = w; }
                LDS_WAIT(); __builtin_amdgcn_s_barrier(); asm volatile("" ::: "memory");
            }
            { const int cp = SC_NCH - 1; const LAS float* yb = YB + (cp & 1) * (SC_T * 32); const int s = st >> 3, i0 = (st & 7) * 4;
                const size_t n = nb0 + seq_j(dir, cp * SC_T + s); const f32x4 y = *(const LAS f32x4*)(yb + s * 32 + i0);
                u32x2 w; w.x = cvt_pk_bf16(y[0], y[1]); w.y = cvt_pk_bf16(y[2], y[3]);
                *(u32x2*)(YS + ((size_t)dir * M + n) * 1024 + h * 64 + vhalf * 32 + i0) = w; }
        } else {
            const int rl = lane >> 3, c = lane & 7, rowl = wave * 8 + rl;
            f32x2 s0 = {0.f, 0.f}, s1 = s0, s2 = s0, s3 = s0;
            __builtin_amdgcn_s_barrier(); asm volatile("" ::: "memory");
            for (int ci = 0; ci < SC_NCH; ++ci) { const LAS float* ob = OP + (ci & 1) * SC_BUF + 8 * c; LAS float* yb = YB + (ci & 1) * (SC_T * 32) + rowl;
#pragma unroll 1
                for (int s8 = 0; s8 < SC_T; s8 += 8) { float ys[8];
#pragma unroll
                    for (int q = 0; q < 8; ++q) { const LAS float* o = ob + (s8 + q) * SC_STEP;
                        const f32x4 d0 = *(const LAS f32x4*)(o), d1 = *(const LAS f32x4*)(o + 4), k0 = *(const LAS f32x4*)(o + 64), k1 = *(const LAS f32x4*)(o + 68);
                        const f32x4 a0 = *(const LAS f32x4*)(o + 128), a1 = *(const LAS f32x4*)(o + 132), m0 = *(const LAS f32x4*)(o + 192), m1 = *(const LAS f32x4*)(o + 196);
                        const f32x4 r0 = *(const LAS f32x4*)(o + 256), r1 = *(const LAS f32x4*)(o + 260); const float vv = (ob - 8 * c)[(s8 + q) * SC_STEP + 320 + rowl];
                        f32x2 acc = s0 * (f32x2){k0[0], k0[1]}; acc += s1 * (f32x2){k0[2], k0[3]}; acc += s2 * (f32x2){k1[0], k1[1]}; acc += s3 * (f32x2){k1[2], k1[3]};
                        const float sa = dpp_red8(acc[0] + acc[1]);
                        s0 = s0 * (f32x2){d0[0], d0[1]} - sa * (f32x2){a0[0], a0[1]} + vv * (f32x2){m0[0], m0[1]};
                        s1 = s1 * (f32x2){d0[2], d0[3]} - sa * (f32x2){a0[2], a0[3]} + vv * (f32x2){m0[2], m0[3]};
                        s2 = s2 * (f32x2){d1[0], d1[1]} - sa * (f32x2){a1[0], a1[1]} + vv * (f32x2){m1[0], m1[1]};
                        s3 = s3 * (f32x2){d1[2], d1[3]} - sa * (f32x2){a1[2], a1[3]} + vv * (f32x2){m1[2], m1[3]};
                        f32x2 ya = s0 * (f32x2){r0[0], r0[1]}; ya += s1 * (f32x2){r0[2], r0[3]}; ya += s2 * (f32x2){r1[0], r1[1]}; ya += s3 * (f32x2){r1[2], r1[3]};
                        ys[q] = dpp_red8(ya[0] + ya[1]); }
                    if (c == 0) {
#pragma unroll
                        for (int q = 0; q < 8; ++q) yb[(s8 + q) * 32] = ys[q]; } }
                LDS_WAIT(); __builtin_amdgcn_s_barrier(); asm volatile("" ::: "memory");
            }
        }
        __syncthreads();
    }
}
__device__ __forceinline__ void ph_rwkv_readout(Ctx& F, int l) {
    const bf16_t* RKV = (const bf16_t*)(F.ws + WS_R + R_RKV); const bf16_t* LO = (const bf16_t*)(F.ws + WS_R + R_LO); const bf16_t* YS = (const bf16_t*)(F.ws + WS_R + R_YS);
    bf16_t* YC = (bf16_t*)(F.ws + WS_YCAT); const int lane = F.lane;
    const float* a0p = F.in[I_A0] + (size_t)l * 2 * 1024; const float* kap = F.in[I_KA] + (size_t)l * 1024; const float* rkp = F.in[I_RK] + (size_t)l * 1024;
    const float* lg = F.in[I_LNXG] + (size_t)l * 1024; const float* lb = F.in[I_LNXB] + (size_t)l * 1024;
    for (int n = F.gw; n < M; n += F.NGW) {
#pragma unroll 2
        for (int h = 0; h < 16; ++h) { const int ch = h * 64 + lane;
            const float y = DBG_RW_D0 * bf2f(YS[(size_t)n * 1024 + ch]) + DBG_RW_D1 * bf2f(YS[((size_t)M + n) * 1024 + ch]);
            const float mu_ = wave_sum(y) * (1.f / 64.f); const float dl = y - mu_; const float var = wave_sum(dl * dl) * (1.f / 64.f);
            const float yn = dl * (1.0f / sqrtf(var + GN_EPS)) * lg[ch] + lb[ch];
            const float r = bf2f(RKV[(size_t)n * 3072 + ch]), kx = bf2f(RKV[(size_t)n * 3072 + 1024 + ch]), v = bf2f(RKV[(size_t)n * 3072 + 2048 + ch]);
            const float a_0 = sigmoidf_(a0p[ch] + bf2f(LO[(size_t)n * LORA_N + 2048 + ch])), a_1 = sigmoidf_(a0p[1024 + ch] + bf2f(LO[(size_t)n * LORA_N + 3072 + ch]));
            const float kb = kx * (1.0f + (0.5f * (a_0 + a_1) - 1.0f) * kap[ch]);
            const float bonus = wave_sum(r * kb * rkp[ch]) * v; const float gg = bf2f(LO[(size_t)n * LORA_N + 4096 + ch]);
            YC[(size_t)n * 4096 + ch] = f2bf((yn + bonus) * gg); }
    }
}
__device__ __forceinline__ void ph_lru_scan(Ctx& F, int l) {
    bf16_t* GT = (bf16_t*)(F.ws + WS_R + R_GT); const bf16_t* XC = (const bf16_t*)(F.ws + WS_R + R_XC);
    LAS float* agg = (LAS float*)F.lds;
    constexpr int CL = TPB / 16;
    for (int item = F.vcu; item < 256; item += F.G) {
        const int cg = item & 31, dir = (item >> 5) & 1, b = item >> 6; const int tc = F.tid >> 5, cl = F.tid & 31, c = cg * 32 + cl, blk = c >> 7, e = c & 127;
        const float sp = softplusf_(-F.in[I_LAMBDA][((size_t)l * 2 + dir) * 1024 + c]), ba = F.in[I_LRUBA][((size_t)l * 2 + dir) * 1024 + c], bx = F.in[I_LRUBX][((size_t)l * 2 + dir) * 1024 + c];
        const size_t nb0 = (size_t)b * TPB; const int gcol = blk * 512 + dir * 256 + e;
        float A = 1.f, hh = 0.f;
#pragma unroll 1
        for (int q0 = 0; q0 < CL; q0 += 8) { bf16_t gr[8], gi[8], xx[8];
#pragma unroll
            for (int q = 0; q < 8; ++q) { const size_t n = nb0 + seq_j(dir, tc * CL + q0 + q); gr[q] = GT[n * 4096 + gcol]; gi[q] = GT[n * 4096 + gcol + 128]; xx[q] = XC[n * 1024 + c]; }
#pragma unroll
            for (int q = 0; q < 8; ++q) { const float g_r = sigmoidf_(bf2f(gr[q]) + ba), g_i = sigmoidf_(bf2f(gi[q]) + bx); const float la = -8.0f * g_r * sp; const float a = __expf(la);
                const float bb = sqrtf(-expm1f(2.0f * la)) * g_i * bf2f(xx[q]); A *= a; hh = a * hh + bb; } }
        agg[(tc * 32 + cl) * 2] = A; agg[(tc * 32 + cl) * 2 + 1] = hh;
        __syncthreads();
        float hc = 0.f;
        for (int i = 0; i < tc; ++i) hc = agg[(i * 32 + cl) * 2] * hc + agg[(i * 32 + cl) * 2 + 1];
        hh = hc;
#pragma unroll 1
        for (int q0 = 0; q0 < CL; q0 += 8) { bf16_t gr[8], gi[8], xx[8]; size_t nn[8];
#pragma unroll
            for (int q = 0; q < 8; ++q) { const size_t n = nb0 + seq_j(dir, tc * CL + q0 + q); nn[q] = n; gr[q] = GT[n * 4096 + gcol]; gi[q] = GT[n * 4096 + gcol + 128]; xx[q] = XC[n * 1024 + c]; }
#pragma unroll
            for (int q = 0; q < 8; ++q) { const float g_r = sigmoidf_(bf2f(gr[q]) + ba), g_i = sigmoidf_(bf2f(gi[q]) + bx); const float la = -8.0f * g_r * sp; const float a = __expf(la);
                const float bb = sqrtf(-expm1f(2.0f * la)) * g_i * bf2f(xx[q]); hh = a * hh + bb; GT[nn[q] * 4096 + gcol] = f2bf(hh); } }
        __syncthreads();
    }
}
__device__ __forceinline__ void ph_lru_readout(Ctx& F) {
    const bf16_t* GT = (const bf16_t*)(F.ws + WS_R + R_GT); const bf16_t* GB = (const bf16_t*)(F.ws + WS_R + R_GB); bf16_t* YC = (bf16_t*)(F.ws + WS_YCAT);
    for (int n = F.gw; n < M; n += F.NGW) {
#pragma unroll
        for (int it = 0; it < 2; ++it) { const int c0 = (F.lane + 64 * it) * 8, blk = c0 >> 7, e0 = c0 & 127; float h0[8], h1[8], g[8], o[8];
            unpack8(*(const u32x4*)(GT + (size_t)n * 4096 + blk * 512 + e0), h0); unpack8(*(const u32x4*)(GT + (size_t)n * 4096 + blk * 512 + 256 + e0), h1); unpack8(*(const u32x4*)(GB + (size_t)n * 1024 + c0), g);
#pragma unroll
            for (int i = 0; i < 8; ++i) o[i] = (DBG_LRU_D0 * h0[i] + DBG_LRU_D1 * h1[i]) * gelu_tanh_(g[i]);
            *(u32x4*)(YC + (size_t)n * 4096 + 3072 + c0) = pack8(o); } }
}
__device__ __forceinline__ void ph_attn(Ctx& F, bool with_ctx, char* lds_gen) {
    const bf16_t* Q = (const bf16_t*)(F.ws + WS_R + R_Q); const bf16_t* KN = (const bf16_t*)(F.ws + WS_R + R_KN); const bf16_t* KR = (const bf16_t*)(F.ws + WS_R + R_KR); const bf16_t* V = (const bf16_t*)(F.ws + WS_R + R_V); bf16_t* YC = (bf16_t*)(F.ws + WS_YCAT);
    const int NU = 1024 + (with_ctx ? 64 : 0);
    for (int u = F.vcu; u < NU; u += F.G) {
        int b, h, seq; size_t q0; const float* rp = nullptr;
        if (u < 1024) { b = u >> 8; h = (u >> 4) & 15; q0 = (size_t)b * TPB + CTX + (size_t)(u & 15) * 256; seq = TPB; rp = (const float*)(F.ws + WS_ROPE) + (size_t)(u & 15) * 256 * 64; }
        else { const int uu = u - 1024; b = uu >> 4; h = uu & 15; q0 = (size_t)b * TPB; seq = CTX; }
        att::attn_body(Q + q0 * 3072 + h * QKD, KN + (size_t)b * TPB * 2048 + h * QK_NOPE, KR + (size_t)b * TPB * 64, V + (size_t)b * TPB * 2048 + h * VD, YC + q0 * 4096 + 1024 + h * VD, seq, rp, lds_gen);
        __syncthreads();
    }
}
#ifndef MK_MULTI
#define MK_MULTI 0
#endif
constexpr int NPL = 16, NPH = 3 + DEPTH * NPL;
#ifndef DBG_MIX
#define DBG_MIX 1.0f
#endif
#ifndef DBG_FFN
#define DBG_FFN 1.0f
#endif
#ifndef DBG_RW
#define DBG_RW 1.0f
#endif
#ifndef DBG_MLA
#define DBG_MLA 1.0f
#endif
#ifndef DBG_LRU
#define DBG_LRU 1.0f
#endif
struct Args { const float* in[40]; float* out; unsigned char* ws; int ph_lo, ph_hi; };
#define GEMM(EPI, e, Aptr, Bptr, lda_, ldb_, K_, nM_, nN_, nG_, pmode_, lrug_) do { pg8::Gemm g_{(const bf16_t*)(Aptr), (const bf16_t*)(Bptr), lda_, ldb_, K_, lrug_}; pg8::Order S_; \
        S_.init(nM_, nN_, nG_, G, (bx + G - rot) % G, pmode_); pg8::gemm_phase<EPI>(F.lds, g_, S_, e); rot = (rot + (nM_) * (nN_) * (nG_)) % G; } while (0)
template <int KIND> __device__ __forceinline__ void run_phase(Ctx& F, int l, char* lds_gen) {
    unsigned char* W = F.ws + WS_W; unsigned char* R = F.ws + WS_R;
    bf16_t* H = (bf16_t*)(F.ws + WS_H); float* X = (float*)(F.ws + WS_X); bf16_t* YC = (bf16_t*)(F.ws + WS_YCAT);
    const int bx = blockIdx.x, G = F.G; int rot = 0;
    const float* modl = (const float*)(F.ws + WS_MOD) + (size_t)l * 5 * 18432;
    const float* lng = F.in[I_LNG] + (size_t)l * 3 * D; const float* lnb = F.in[I_LNB] + (size_t)l * 3 * D;
    if constexpr (KIND == 0) { ph_modp(F); ph_rope(F); ph_xasm(F); ph_cvt(F, 0); }
    if constexpr (KIND == 1) { ph_modr(F); }
    if constexpr (KIND == 2) { ph_h0(F); }
    if constexpr (KIND == 3) { pg8::EpiSwiGLU e{(bf16_t*)(R + R_ACT), DFF}; GEMM(pg8::EpiSwiGLU, e, H, W + W_GU0, D, D, D, NPAN, 44, 1, 0, 0); }
    if constexpr (KIND == 4) { pg8::EpiResid e{X, modl + 2 * 2048, 0.5f * DBG_FFN}; GEMM(pg8::EpiResid, e, R + R_ACT, W + W_D0, DFF, DFF, DFF, NPAN, 8, 1, 0, 0); }
    if constexpr (KIND == 5) { ph_ln(F, lng, lnb, modl, 3, 4, false); }
    if constexpr (KIND == 6) { pg8::EpiBf16 e{(bf16_t*)(R + R_FA), FA_PAD, 0, nullptr, 1 << 30}; GEMM(pg8::EpiBf16, e, H, W + W_INA, D, D, D, NPAN, FA_PAD / 256, 1, 0, 0); }
    if constexpr (KIND == 7) { ph_prep(F, l); }
    if constexpr (KIND == 8) { { pg8::EpiBf16 e{(bf16_t*)(R + R_LO), LORA_N, 0, nullptr, 1 << 30}; GEMM(pg8::EpiBf16, e, R + R_LIN, W + W_LORA, LORA_K, LORA_K, LORA_K, NPAN, LORA_N / 256, 1, 0, 0); }
                               { pg8::EpiBf16 e{(bf16_t*)(R + R_GT), 4096, 512, nullptr, 1 << 30}; GEMM(pg8::EpiBf16, e, R + R_XC, W + W_LRU, 1024, 256, 256, NPAN, 2, 8, 0, 1); } }
    if constexpr (KIND == 9) { ph_rwkv_scan(F, l); ph_lru_scan(F, l); }
    if constexpr (KIND == 10) { ph_rwkv_readout(F, l); ph_lru_readout(F); }
    if constexpr (KIND == 11) { { pg8::EpiBf16 e{(bf16_t*)(R + R_Q), 3072, 0, nullptr, 1 << 30}; GEMM(pg8::EpiBf16, e, R + R_QL, W + W_UQ, 512, 512, 512, NPAN, 12, 1, 0, 0); }
                                { pg8::EpiBf16 e{(bf16_t*)(R + R_KN), 2048, 0, (bf16_t*)(R + R_V), 8}; GEMM(pg8::EpiBf16, e, R + R_KVC, W + W_UKV, 256, 256, 256, NPAN, 16, 1, 0, 0); } }
    if constexpr (KIND == 12) { ph_attn(F, l + 1 < DEPTH, lds_gen); }
    if constexpr (KIND == 19) {
                                { pg8::EpiGate e{(bf16_t*)(R + R_GATE), F.in[I_GATEB] + (size_t)l * GATE_IN}; GEMM(pg8::EpiGate, e, H, W + W_ING, D, D, D, NPAN, 24, 1, 0, 0); } }
    if constexpr (KIND == 13) {
        { pg8::EpiMerge<0> e{(const bf16_t*)(R + R_GATE), (float*)(R + R_Y2F), (bf16_t*)(R + R_Y2B), DBG_RW}; rot = 0; GEMM(pg8::EpiMerge<0>, e, YC, W + W_PROJ, 4096, 4096, 1024, NPAN, 8, 1, 0, 0); }
        { pg8::EpiMerge<1> e{(const bf16_t*)(R + R_GATE) + 2048, (float*)(R + R_Y2F), (bf16_t*)(R + R_Y2B), DBG_MLA}; rot = 0; GEMM(pg8::EpiMerge<1>, e, YC + 1024, (bf16_t*)(W + W_PROJ) + 1024, 4096, 4096, 2048, NPAN, 8, 1, 0, 0); }
        { pg8::EpiMerge<2> e{(const bf16_t*)(R + R_GATE) + 4096, (float*)(R + R_Y2F), (bf16_t*)(R + R_Y2B), DBG_LRU}; rot = 0; GEMM(pg8::EpiMerge<2>, e, YC + 3072, (bf16_t*)(W + W_PROJ) + 3072, 4096, 4096, 1024, NPAN, 8, 1, 0, 0); } }
    if constexpr (KIND == 14) { pg8::EpiResid e{X, modl + 5 * 2048, 1.0f * DBG_MIX}; GEMM(pg8::EpiResid, e, R + R_Y2B, W + W_OUT, D, D, D, NPAN, 8, 1, 0, 0); }
    if constexpr (KIND == 15) { ph_ln(F, lng + D, lnb + D, modl, 6, 7, false); }
    if constexpr (KIND == 16) { pg8::EpiSwiGLU e{(bf16_t*)(R + R_ACT), DFF}; GEMM(pg8::EpiSwiGLU, e, H, W + W_GU1, D, D, D, NPAN, 44, 1, 0, 0); }
    if constexpr (KIND == 17) { pg8::EpiResid e{X, modl + 8 * 2048, 0.5f * DBG_FFN}; GEMM(pg8::EpiResid, e, R + R_ACT, W + W_D1, DFF, DFF, DFF, NPAN, 8, 1, 0, 0); }
    if constexpr (KIND == 18) { ph_ln(F, lng + 2 * D, lnb + 2 * D, modl + 5 * 18432, 0, 1, l + 1 == DEPTH); if (l + 1 < DEPTH) ph_cvt(F, l + 1); }
}
__device__ __forceinline__ void make_ctx(Ctx& F, const Args& args, unsigned char* lds_) {
    F.lds = (LAS unsigned char*)lds_; F.ws = args.ws; F.in = args.in; F.out = args.out;
    F.tid = threadIdx.x; F.lane = F.tid & 63; F.wave = __builtin_amdgcn_readfirstlane(F.tid >> 6);
    F.G = gridDim.x; { const int bx = blockIdx.x; F.vcu = (F.G % 8 == 0) ? (bx % 8) * (F.G / 8) + bx / 8 : bx; }
    F.gw = F.vcu * 8 + F.wave; F.NGW = F.G * 8;
}
#if MK_MULTI
template <int KIND> __global__ void __launch_bounds__(512, 2) k_one(Args args, int l) {
    extern __shared__ __attribute__((aligned(16))) unsigned char lds_[];
    Ctx F; make_ctx(F, args, lds_);
    run_phase<KIND>(F, l, (char*)lds_);
}
#else
__global__ void __launch_bounds__(512, 2) fwd(Args args) {
    extern __shared__ __attribute__((aligned(16))) unsigned char lds_[];
    Ctx F; make_ctx(F, args, lds_);
    volatile LAS unsigned* MISC = (volatile LAS unsigned*)(F.lds + LDSCTL_OFF);
    for (int u = F.tid; u < 256; u += 512) MISC[u] = 0u;
    __syncthreads();
    XcdBarrier bar = xcd_barrier_post((unsigned*)(F.ws + WS_CTL), MISC + 8);
#define PH(K, l) run_phase<K>(F, l, (char*)lds_); xcd_barrier(bar);
    PH(0, 0) PH(1, 0) PH(2, 0)
    for (int l = 0; l < DEPTH; ++l) {
        PH(3, l) PH(4, l) PH(5, l) PH(6, l) PH(7, l) PH(8, l) PH(9, l) PH(10, l) PH(11, l) PH(12, l) PH(13, l) PH(14, l) PH(15, l) PH(16, l) PH(17, l)
        run_phase<18>(F, l, (char*)lds_); if (l + 1 < DEPTH) xcd_barrier(bar);
    }
#undef PH
}
#endif

#if MK_MULTI && defined(DBG_PROBE)
__device__ __forceinline__ void dbg_max(unsigned char* ws, float d) { atomicMax((unsigned*)(ws + WS_CTL) + 8192, __float_as_uint(fabsf(d))); }
__global__ void k_dbg_gate(Args a, int l) {
    const bf16_t* H = (const bf16_t*)(a.ws + WS_H); const bf16_t* GATE = (const bf16_t*)(a.ws + WS_R + R_GATE);
    const int s = blockIdx.x * blockDim.x + threadIdx.x; if (s >= 8192) return;
    const unsigned hsh = (unsigned)s * 2654435761u; const int r = (int)(hsh % (unsigned)M), c = (int)((hsh / 17408u) % 6144u);
    float z = 0.f; const float* w = a.in[I_WIN] + (size_t)l * 2048 * IN_COLS + FA + c;
    for (int k = 0; k < 2048; ++k) z += bf2f(H[(size_t)r * 2048 + k]) * w[(size_t)k * IN_COLS];
    z += a.in[I_GATEB][(size_t)l * GATE_IN + c];
    const float g = 1.0f / (1.0f + expf(-z));
    dbg_max(a.ws, g - bf2f(GATE[(size_t)r * GATE_IN + c]));
}
__global__ void k_dbg_fa(Args a, int l) {
    const bf16_t* H = (const bf16_t*)(a.ws + WS_H); const bf16_t* FAp = (const bf16_t*)(a.ws + WS_R + R_FA);
    const int s = blockIdx.x * blockDim.x + threadIdx.x; if (s >= 8192) return;
    const unsigned hsh = (unsigned)s * 2654435761u; const int r = (int)(hsh % (unsigned)M), c = (int)((hsh / 17408u) % 6240u);
    float z = 0.f; const float* w = a.in[I_WIN] + (size_t)l * 2048 * IN_COLS + c;
    for (int k = 0; k < 2048; ++k) z += bf2f(H[(size_t)r * 2048 + k]) * w[(size_t)k * IN_COLS];
    dbg_max(a.ws, z - bf2f(FAp[(size_t)r * FA_PAD + c]));
}
__global__ void k_dbg_gate_range(Args a, int mode) {
    const bf16_t* GATE = (const bf16_t*)(a.ws + WS_R + R_GATE); unsigned bad = 0; unsigned minrow = 0xffffffffu, maxrow = 0;
    for (size_t i = (size_t)blockIdx.x * blockDim.x + threadIdx.x; i < (size_t)M * GATE_IN; i += (size_t)gridDim.x * blockDim.x) { const float v = bf2f(GATE[i]);
        if (!(v >= -0.001f && v <= 1.001f)) { ++bad; const unsigned r = (unsigned)(i / GATE_IN); minrow = r < minrow ? r : minrow; maxrow = r > maxrow ? r : maxrow; } }
    unsigned* ctl = (unsigned*)(a.ws + WS_CTL);
    if (bad) { atomicAdd(ctl + 8200, bad); atomicMin(ctl + 8201, minrow); atomicMax(ctl + 8202, maxrow); }
}
__global__ void k_dbg_range_fin(Args a, int mode) { unsigned* ctl = (unsigned*)(a.ws + WS_CTL); if (threadIdx.x == 0) {
    float d = 0.f; if (mode == 3) d = (float)ctl[8200] / ((float)M * GATE_IN); else if (mode == 4) d = (float)ctl[8201] * 1e-5f; else d = (float)ctl[8202] * 1e-5f;
    ctl[8192] = __float_as_uint(d); } }
__global__ void k_dbg_gate_tiles(Args a) {
    const bf16_t* GATE = (const bf16_t*)(a.ws + WS_R + R_GATE); const int pm = blockIdx.x / 24, pn = blockIdx.x % 24; __shared__ unsigned cnt;
    if (threadIdx.x == 0) cnt = 0; __syncthreads(); unsigned bad = 0;
    for (int i = threadIdx.x; i < 65536; i += blockDim.x) { const int r = i >> 8, c = i & 255; const float v = bf2f(GATE[(size_t)(pm * 256 + r) * GATE_IN + pn * 256 + c]); if (!(v >= -0.001f && v <= 1.001f)) ++bad; }
    atomicAdd(&cnt, bad); __syncthreads();
    if (threadIdx.x == 0) { unsigned* ctl = (unsigned*)(a.ws + WS_CTL); if (cnt >= 65536 * 3 / 10) { atomicAdd(ctl + 8210, 1u); atomicMin(ctl + 8201, (unsigned)blockIdx.x); atomicMax(ctl + 8202, (unsigned)blockIdx.x); } if (cnt > 0) atomicAdd(ctl + 8211, 1u); }
}
__global__ void k_dbg_tiles_fin(Args a, int mode) { unsigned* ctl = (unsigned*)(a.ws + WS_CTL); if (threadIdx.x == 0) {
    float d = 0.f; if (mode == 6) d = (float)ctl[8210] * 1e-2f; else if (mode == 7) d = (float)ctl[8211] * 1e-2f; else if (mode == 8) d = (float)(ctl[8201] / 24) * 1e-2f; else if (mode == 9) d = (float)(ctl[8201] % 24) * 1e-2f; else if (mode == 10) d = (float)(ctl[8202] / 24) * 1e-2f; else d = (float)(ctl[8202] % 24) * 1e-2f;
    ctl[8192] = __float_as_uint(d); } }
__global__ void k_dbg_final(Args a) { if (threadIdx.x == 0 && blockIdx.x == 0) { const float d = __uint_as_float(((const unsigned*)(a.ws + WS_CTL))[8192]); a.out[0] += 10000.0f * d + 100.0f; } }
#endif

#if MK_MULTI
template <int K> static void launch_kind(int grid, hipStream_t stream, const Args& a, int l) {
    static bool attr = false;
    if (!attr) { (void)hipFuncSetAttribute((const void*)k_one<K>, hipFuncAttributeMaxDynamicSharedMemorySize, LDS_BYTES); attr = true; }
    hipLaunchKernelGGL(k_one<K>, dim3(grid), dim3(512), LDS_BYTES, stream, a, l);
}
template <int K> static void launch_layer(int grid, hipStream_t stream, const Args& a, int l) { if constexpr (K <= 18) { launch_kind<K>(grid, stream, a, l); if (K == 12) { launch_kind<19>(grid, stream, a, l);
#if defined(DBG_PROBE)
        if (DBG_PROBE == 1 && l == 0) hipLaunchKernelGGL(k_dbg_gate, dim3(32), dim3(256), 0, stream, a, l);
        if (DBG_PROBE >= 6 && DBG_PROBE <= 11 && l == 0) { (void)hipMemsetAsync((char*)a.ws + WS_CTL + 8201 * 4, 0xff, 4, stream); hipLaunchKernelGGL(k_dbg_gate_tiles, dim3(68 * 24), dim3(256), 0, stream, a); hipLaunchKernelGGL(k_dbg_tiles_fin, dim3(1), dim3(64), 0, stream, a, DBG_PROBE); }
        if (DBG_PROBE >= 3 && DBG_PROBE <= 5 && l == 0) { (void)hipMemsetAsync((char*)a.ws + WS_CTL + 8201 * 4, 0xff, 4, stream); hipLaunchKernelGGL(k_dbg_gate_range, dim3(1024), dim3(256), 0, stream, a, DBG_PROBE); hipLaunchKernelGGL(k_dbg_range_fin, dim3(1), dim3(64), 0, stream, a, DBG_PROBE); }
#endif
        }
#if defined(DBG_PROBE)
        if (K == 6 && DBG_PROBE == 2 && l == 0) hipLaunchKernelGGL(k_dbg_fa, dim3(32), dim3(256), 0, stream, a, l);
#endif
        launch_layer<K + 1>(grid, stream, a, l); } }
#endif
extern "C" void kernel_launch(void* const* d_in, const int* in_sizes, int n_in, void* d_out, int out_size, void* d_ws, size_t ws_size, hipStream_t stream) {
    static int grid = 0;
    if (grid == 0) {
        if (n_in != 40 || in_sizes[0] != NB * SEQ * D || out_size != NB * SEQ * D || ws_size < WS_END) {
            fprintf(stderr, "kernel_launch: shape mismatch: n_in %d in0 %d out %d ws %zu (need %zu); nothing launched\n", n_in, n_in > 0 ? in_sizes[0] : -1, out_size, ws_size, (size_t)WS_END); grid = -1; return; }
        int dev = 0, cus = 0;
        if (hipGetDevice(&dev) != hipSuccess || hipDeviceGetAttribute(&cus, hipDeviceAttributeMultiprocessorCount, dev) != hipSuccess) { grid = -1; return; }
#if !MK_MULTI
        int per_cu = 0;
        if (hipFuncSetAttribute((const void*)fwd, hipFuncAttributeMaxDynamicSharedMemorySize, LDS_BYTES) != hipSuccess) { fprintf(stderr, "kernel_launch: hipFuncSetAttribute failed\n"); grid = -1; return; }
        if (hipOccupancyMaxActiveBlocksPerMultiprocessor(&per_cu, (const void*)fwd, 512, LDS_BYTES) != hipSuccess || per_cu < 1) { fprintf(stderr, "kernel_launch: occupancy query says %d blocks per CU\n", per_cu); }
        (void)hipGetLastError();
#endif
        grid = cus;
    }
    if (grid < 0) return;
    if (hipMemsetAsync((char*)d_ws + WS_CTL, 0, CTL_BYTES, stream) != hipSuccess) return;
    Args a{};
    for (int i = 0; i < 40; ++i) a.in[i] = (const float*)d_in[i];
    a.out = (float*)d_out; a.ws = (unsigned char*)d_ws; a.ph_lo = 0; a.ph_hi = NPH;
#if MK_MULTI
    launch_kind<0>(grid, stream, a, 0); launch_kind<1>(grid, stream, a, 0); launch_kind<2>(grid, stream, a, 0);
    for (int l = 0; l < DEPTH; ++l) launch_layer<3>(grid, stream, a, l);
#if defined(DBG_PROBE)
    hipLaunchKernelGGL(k_dbg_final, dim3(1), dim3(64), 0, stream, a);
#endif
#else
    hipLaunchKernelGGL(fwd, dim3(grid), dim3(512), LDS_BYTES, stream, a);
#endif
    const hipError_t le = hipPeekAtLastError();
    if (le != hipSuccess) fprintf(stderr, "kernel_launch: launch failed: %s\n", hipGetErrorName(le));
}
```

```cpp
#include <hip/hip_runtime.h>
#include <cstdio>
#include <cstdint>

#define LAS __attribute__((address_space(3)))
#define GAS __attribute__((address_space(1)))
typedef unsigned short bf16_t;
typedef short bf16x8 __attribute__((ext_vector_type(8)));
typedef short s16x4 __attribute__((ext_vector_type(4)));
typedef float f32x2 __attribute__((ext_vector_type(2)));
typedef float f32x4 __attribute__((ext_vector_type(4)));
typedef float f32x8 __attribute__((ext_vector_type(8)));
typedef float f32x16 __attribute__((ext_vector_type(16)));
typedef unsigned u32x2 __attribute__((ext_vector_type(2)));
typedef unsigned u32x4 __attribute__((ext_vector_type(4)));

constexpr int D = 2048, NB = 4, SEQ = 4096, CTX = 256, TPB = CTX + SEQ  , M = NB * TPB  , DFF = 5632, NMOD = 9, DEPTH = 2;
constexpr int NPAN = M / 256;
constexpr int RWKV_W = 1024, RW_IN = 3360, MLA_IN = 832, LRU_IN = 2048, GATE_IN = 6144, IN_COLS = 12384;
constexpr int FA = RW_IN + MLA_IN + LRU_IN  , FA_PAD = 6400;
constexpr int OFF_QLAT = 3360, OFF_KVLAT = 3872, OFF_KROPE = 4128, OFF_XR = 4192, OFF_GB = 5216;
constexpr int GB_TILE0 = 21, GB_ROW0 = GB_TILE0 * 256  ;
static_assert(GB_ROW0 + 1024 == FA_PAD && OFF_GB % 32 == 0, "gelu-branch tiles");
constexpr int LORA_K = 384, LORA_N = 5120;
constexpr int NHEAD = 16, QK_NOPE = 128, QK_ROPE = 64, QKD = 192, VD = 128;
constexpr float LN_EPS = 1e-6f, GN_EPS = 64e-5f, ALPHA = 1.41421356237309515f;

constexpr size_t al256(size_t x) { return (x + 255) & ~(size_t)255; }
constexpr size_t WS_CTL = 0, CTL_BYTES = 65536;
constexpr size_t WS_MOD = WS_CTL + CTL_BYTES;
constexpr size_t WS_ROPE = al256(WS_MOD + (size_t)2 * 5 * 18432 * 4);
constexpr size_t WS_LB = al256(WS_ROPE + (size_t)4096 * 32 * 2 * 4);
constexpr size_t WS_STATS = al256(WS_LB + (size_t)2 * 4096 * 4);
constexpr size_t WS_LNT = al256(WS_STATS + (size_t)M * 2 * 4);
constexpr size_t WS_W = al256(WS_LNT + (size_t)7 * 4096 * 4);
constexpr size_t W_GU0 = 0, W_GU1 = W_GU0 + (size_t)11264 * 2048 * 2, W_D0 = W_GU1 + (size_t)11264 * 2048 * 2, W_D1 = W_D0 + (size_t)2048 * 5632 * 2;
constexpr size_t W_INA = W_D1 + (size_t)2048 * 5632 * 2, W_ING = W_INA + (size_t)FA_PAD * 2048 * 2, W_UQ = W_ING + (size_t)6144 * 2048 * 2;
constexpr size_t W_UKV = W_UQ + (size_t)3072 * 512 * 2, W_LORA = W_UKV + (size_t)4096 * 256 * 2, W_LRU = W_LORA + (size_t)LORA_N * LORA_K * 2;
constexpr size_t W_PROJ = W_LRU + (size_t)8 * 512 * 256 * 2, W_OUT = W_PROJ + (size_t)2048 * 4096 * 2, W_END = W_OUT + (size_t)2048 * 2048 * 2;
constexpr size_t WS_X = al256(WS_W + W_END);
constexpr size_t WS_H = WS_X + (size_t)M * D * 4;
constexpr size_t WS_YCAT = WS_H + (size_t)M * D * 2;
constexpr size_t WS_R = WS_YCAT + (size_t)M * 4096 * 2;
constexpr size_t R_ACT = 0;
constexpr size_t R_MODP = 0;
constexpr size_t R_FA = 0;
constexpr size_t R_PREP = (size_t)M * FA_PAD * 2;
constexpr size_t R_LIN = R_PREP;
constexpr size_t R_RKV = R_LIN + (size_t)M * LORA_K * 2;
constexpr size_t R_XC = R_RKV + (size_t)M * 3072 * 2;
constexpr size_t R_GB = R_XC + (size_t)M * 1024 * 2;
constexpr size_t R_QL = R_GB + (size_t)M * 1024 * 2;
constexpr size_t R_KVC = R_QL + (size_t)M * 512 * 2;
constexpr size_t R_KR = R_KVC + (size_t)M * 256 * 2;
constexpr size_t R_KKN = R_KR + (size_t)M * 64 * 2;
constexpr size_t R_PREP_END = R_KKN + (size_t)M * 16 * 4;
constexpr size_t R_LO = 0;
constexpr size_t R_GT = R_PREP_END;
constexpr size_t R_YS = R_GT + (size_t)M * 4096 * 2;
constexpr size_t R_Q = 0;
constexpr size_t R_KN = R_Q + (size_t)M * 3072 * 2;
constexpr size_t R_V = R_KN + (size_t)M * 2048 * 2;
constexpr size_t R_GATE = R_PREP_END;
constexpr size_t R_Y2F = 0;
constexpr size_t R_Y2B = R_Y2F + (size_t)M * 2048 * 4;
constexpr size_t R_PART = (size_t)220 << 20;
constexpr size_t R_END = R_YS + (size_t)2 * M * 1024 * 2;
static_assert(R_LO + (size_t)M * LORA_N * 2 <= R_PREP, "LO fits the dead FA slot");
static_assert(R_V + (size_t)M * 2048 * 2 <= R_QL, "Q|K|V fit below the live QL/KVC/KR");
static_assert(R_GATE + (size_t)M * 6144 * 2 <= R_END, "GATE fits");
static_assert(R_Y2B + (size_t)M * 2048 * 2 <= R_GATE, "Y2 below GATE");
static_assert(R_PART >= R_ACT + (size_t)M * DFF * 2 && R_PART >= R_Y2B + (size_t)M * 2048 * 2 && R_PART + (size_t)4 * 1024 * 2048 * 4 <= R_GATE, "partials clear of ACT / Y2 / GATE");
constexpr size_t WS_END = WS_R + R_END;

constexpr int RING_BYTES = 145408;
constexpr int LDSCTL_OFF = RING_BYTES;
constexpr int LDS_BYTES = 147456;

#ifndef USE_F16
#define USE_F16 0
#endif
typedef __bf16 bf16x2_n __attribute__((ext_vector_type(2)));
typedef _Float16 f16x2_n __attribute__((ext_vector_type(2)));
typedef _Float16 f16x8_n __attribute__((ext_vector_type(8)));
__device__ __forceinline__ unsigned cvt_pk_bf16(float lo, float hi) { const f32x2 v = {lo, hi};
#if USE_F16
    const f16x2_n r = __builtin_convertvector(v, f16x2_n); return __builtin_bit_cast(unsigned, r);
#else
    const bf16x2_n r = __builtin_convertvector(v, bf16x2_n); return __builtin_bit_cast(unsigned, r);
#endif
}
#if USE_F16
__device__ __forceinline__ float bf_lo(unsigned w) { return (float)__builtin_bit_cast(f16x2_n, w)[0]; }
__device__ __forceinline__ float bf_hi(unsigned w) { return (float)__builtin_bit_cast(f16x2_n, w)[1]; }
__device__ __forceinline__ float bf2f(bf16_t b) { return (float)__builtin_bit_cast(_Float16, b); }
#define MFMA16(a, b, c) __builtin_amdgcn_mfma_f32_16x16x32_f16(__builtin_bit_cast(f16x8_n, a), __builtin_bit_cast(f16x8_n, b), c, 0, 0, 0)
#define MFMA32(a, b, c) __builtin_amdgcn_mfma_f32_32x32x16_f16(__builtin_bit_cast(f16x8_n, a), __builtin_bit_cast(f16x8_n, b), c, 0, 0, 0)
#else
__device__ __forceinline__ float bf_lo(unsigned w) { return __uint_as_float(w << 16); }
__device__ __forceinline__ float bf_hi(unsigned w) { return __uint_as_float(w & 0xffff0000u); }
__device__ __forceinline__ float bf2f(bf16_t b) { return __uint_as_float(((unsigned)b) << 16); }
#define MFMA16(a, b, c) __builtin_amdgcn_mfma_f32_16x16x32_bf16(a, b, c, 0, 0, 0)
#define MFMA32(a, b, c) __builtin_amdgcn_mfma_f32_32x32x16_bf16(a, b, c, 0, 0, 0)
#endif
__device__ __forceinline__ bf16_t f2bf(float f) { return (bf16_t)(cvt_pk_bf16(f, 0.f) & 0xffffu); }
__device__ __forceinline__ float wave_sum(float v) {
#pragma unroll
    for (int o = 1; o < 64; o <<= 1) v += __shfl_xor(v, o);
    return v;
}
__device__ __forceinline__ float sigmoidf_(float x) { return 1.0f / (1.0f + __expf(-x)); }
__device__ __forceinline__ float siluf_(float x) { return x / (1.0f + __expf(-x)); }
__device__ __forceinline__ float softplusf_(float x) { const float e = __expf(x); const float p = e * (1.0f - e * (0.5f - e * (0.33333334f - e * (0.25f - e * 0.2f)))); return x > 20.f ? x : (e < 0.125f ? p : __logf(1.0f + e)); }
__device__ __forceinline__ float gelu_tanh_(float x) { const float u = 0.7978845608028654f * (x + 0.044715f * x * x * x); return x * __builtin_amdgcn_rcpf(1.0f + __expf(-2.0f * u)); }
__device__ __forceinline__ u32x4 zero4() { unsigned z = 0u; asm volatile("" : "+v"(z)); return (u32x4){z, z, z, z}; }
__device__ __forceinline__ int modrow_of_panel(int pm) { return (pm % 17 == 0) ? 4 : pm / 17; }
#define MK_MULTI 0
namespace pg8 {
constexpr int BM = 256, BK = 64, HALF = 128, HTB = HALF * BK * 2  , STAGE_BYTES = 8 * HTB, NXCD = 8, WGM = 8;
__host__ __device__ __forceinline__ int lds_byte(int r, int c) { const int st = (r >> 4) * 2 + (c >> 5), rr = r & 15, cc = c & 31, ob = rr * 64 + cc * 2; return st * 1024 + (ob ^ (((ob >> 9) & 1) << 5)); }
__host__ __device__ __forceinline__ void stage_rc(int b, int& R, int& C) { const int st = b / 1024, sb = b % 1024, swz = sb ^ (((sb >> 9) & 1) << 5); R = (st >> 1) * 16 + swz / 64; C = (st & 1) * 32 + (swz % 64) / 2; }
__host__ __device__ __forceinline__ int perm32(int rho) { const int n = rho >> 4, i = rho & 15; return 8 * (i >> 2) + 4 * n + (i & 3); }

struct Unit { int pm, pn, g, ks; };
struct Gemm { const bf16_t* A; const bf16_t* Bt; int lda, ldb, K; int lru_groups; int ksplit; };
__device__ __forceinline__ size_t a_base(const Gemm& g, const Unit& u) { return (size_t)u.pm * 256 * g.lda * 2 + (g.lru_groups ? (size_t)(u.g >> 1) * 256 * 2 : 0) + (u.ks > 0 ? (size_t)u.ks * (g.K / g.ksplit) * 2 : 0); }
__device__ __forceinline__ size_t b_base(const Gemm& g, const Unit& u) { return (size_t)u.pn * 256 * g.ldb * 2 + (g.lru_groups ? (size_t)u.g * 512 * 256 * 2 : 0) + (u.ks > 0 ? (size_t)u.ks * (g.K / g.ksplit) * 2 : 0); }

struct Order {
    int nM, nN, nG, per, nwg, G, c, pmode, S;
    __device__ void init(int nM_, int nN_, int nG_, int G_, int c_, int pmode_, int S_ = 0) { nM = nM_; nN = nN_; nG = nG_; per = nM * nN; nwg = per * nG + (pmode_ == 2 ? 4 * nN_ * S_ : 0); G = G_; c = c_; pmode = pmode_; S = S_; }
    __device__ bool next(int i, Unit& u) const {
        const long L = (long)i * G + c; if (L >= nwg) return false;
        if (pmode == 2 && L >= per) { const int Lp = (int)(L - per); u.ks = Lp % S; const int t = Lp / S; u.pm = 17 * (t & 3); u.pn = t >> 2; u.g = 0; return true; }
        const int g = (int)(L / per); int wgid = (int)(L % per);
        { const int q = per / NXCD, r = per % NXCD, xcd = wgid % NXCD, off = wgid / NXCD; wgid = (xcd < r ? xcd * (q + 1) : r * (q + 1) + (xcd - r) * q) + off; }
        const int nig = WGM * nN, gid = wgid / nig, fm = gid * WGM, gsz = (nM - fm) < WGM ? (nM - fm) : WGM;
        int pm = fm + ((wgid % nig) % gsz); u.pn = (wgid % nig) / gsz; u.g = g; u.ks = -1;
        if (pmode >= 1) pm = (pm >> 4) * 17 + 1 + (pm & 15);
        u.pm = pm; return true;
    }
};

__device__ __forceinline__ void unpack8(const u32x4 w, float (&x)[8]) { x[0] = bf_lo(w.x); x[1] = bf_hi(w.x); x[2] = bf_lo(w.y); x[3] = bf_hi(w.y); x[4] = bf_lo(w.z); x[5] = bf_hi(w.z); x[6] = bf_lo(w.w); x[7] = bf_hi(w.w); }
typedef f32x4 Acc[2][2][4][2];

template <class Epi>
__device__ __forceinline__ void gemm_phase(LAS unsigned char* lds, const Gemm g, const Order S, const Epi E) {
    int tid_ = threadIdx.x; asm volatile("" : "+v"(tid_));
    const int tid = tid_, wid = __builtin_amdgcn_readfirstlane(tid >> 6), lane = tid & 63, wr = wid >> 2, wc = wid & 3, fr = lane & 15, fq = lane >> 4;
    const int ntf = g.K / BK, nts = g.ksplit > 0 ? g.K / g.ksplit / BK : ntf;
    unsigned voffA[2], voffB[2];
#pragma unroll
    for (int i = 0; i < 2; ++i) { int R, C; stage_rc(tid * 16 + i * 8192, R, C); const int Rb = Epi::PERM ? ((R & ~31) + perm32(R & 31)) : R;
        voffA[i] = (unsigned)(R * g.lda + C) * 2u; voffB[i] = (unsigned)(Rb * g.ldb + C) * 2u; }
    const size_t kstep = (size_t)(BK * 2);
    const size_t hstepA = (size_t)HALF * g.lda * 2, hstepB = (size_t)HALF * g.ldb * 2;
    const unsigned ldsw = (unsigned)wid * 1024u;
    const int aoff = lds_byte(wr * 64 + fr, fq * 8), boff = lds_byte(wc * 32 + fr, fq * 8);
#define PG8_SA(b, h) (((b) * 2 + (h)) * HTB)
#define PG8_SB(b, h) ((4 + (b) * 2 + (h)) * HTB)
#define PG8_STAGE(bufoff, gbase, voff) do { _Pragma("unroll") for (int _i = 0; _i < 2; ++_i) \
        __builtin_amdgcn_global_load_lds((const unsigned*)((const char*)(gbase) + (voff)[_i]), (LAS unsigned*)(lds + (bufoff) + ldsw + _i * 8192), 16, 0, 0); } while (0)
#define PG8_LDA(dst, b, h) do { _Pragma("unroll") for (int m = 0; m < 4; ++m) _Pragma("unroll") for (int k = 0; k < 2; ++k) dst[m][k] = *(const LAS bf16x8*)(lds + PG8_SA(b, h) + aoff + m * 2048 + k * 1024); } while (0)
#define PG8_LDB(dst, b, h) do { _Pragma("unroll") for (int n = 0; n < 2; ++n) _Pragma("unroll") for (int k = 0; k < 2; ++k) dst[n][k] = *(const LAS bf16x8*)(lds + PG8_SB(b, h) + boff + n * 2048 + k * 1024); } while (0)
#define PG8_MMA(ai, bj, At, Bt) do { __builtin_amdgcn_s_setprio(1); _Pragma("unroll") for (int m = 0; m < 4; ++m) _Pragma("unroll") for (int n = 0; n < 2; ++n) _Pragma("unroll") for (int k = 0; k < 2; ++k) \
        acc[ai][bj][m][n] = MFMA16(Bt[n][k], At[m][k], acc[ai][bj][m][n]); __builtin_amdgcn_s_setprio(0); } while (0)
#define PG8_WAIT_V(n) asm volatile("s_waitcnt vmcnt(" #n ")" ::: "memory")
#define PG8_WAIT_L(n) asm volatile("s_waitcnt lgkmcnt(" #n ")" ::: "memory")
#define PG8_BAR __builtin_amdgcn_s_barrier()
#define PG8_SCHED __builtin_amdgcn_sched_barrier(0)
    Unit cur, nxt; int ui = 0;
    if (!S.next(0, cur)) return;
    Acc acc;
#pragma unroll
    for (int a = 0; a < 2; ++a)
#pragma unroll
        for (int b = 0; b < 2; ++b)
#pragma unroll
            for (int m = 0; m < 4; ++m)
#pragma unroll
                for (int n = 0; n < 2; ++n) acc[a][b][m][n] = (f32x4){0.f, 0.f, 0.f, 0.f};
    bf16x8 At[4][2], B0[2][2], B1[2][2];
    const char* cA = (const char*)g.A + a_base(g, cur); const char* cB = (const char*)g.Bt + b_base(g, cur);
    PG8_STAGE(PG8_SB(0, 0), cB, voffB); PG8_STAGE(PG8_SB(0, 1), cB + hstepB, voffB); PG8_STAGE(PG8_SA(0, 0), cA, voffA); PG8_STAGE(PG8_SA(0, 1), cA + hstepA, voffA);
    if (wr == 1) PG8_BAR;
    PG8_WAIT_V(2); PG8_BAR;
    PG8_STAGE(PG8_SB(1, 0), cB + kstep, voffB); PG8_STAGE(PG8_SA(1, 0), cA + kstep, voffA); PG8_STAGE(PG8_SB(1, 1), cB + hstepB + kstep, voffB);
    PG8_WAIT_V(6); PG8_BAR;
    for (;;) {
        const bool has_next = S.next(ui + 1, nxt);
        const char* nA = has_next ? (const char*)g.A + a_base(g, nxt) : cA; const char* nB = has_next ? (const char*)g.Bt + b_base(g, nxt) : cB;
        const int nt = cur.ks >= 0 ? nts : ntf;
        for (int t = 0; t < nt; t += 2) {
            const bool last = (t == nt - 2);
            if constexpr (Epi::HOOK) { if (t == E.t1 || t == E.t2) E.mid(acc, cur, t == E.t2 ? 1 : 0, wr, wc, fr, fq); }
            const char* a1 = cA + (size_t)(t + 1) * kstep;
            const char* a2 = last ? nA : cA + (size_t)(t + 2) * kstep; const char* b2 = last ? nB : cB + (size_t)(t + 2) * kstep;
            const char* a3 = a2 + kstep; const char* b3 = b2 + kstep;
            PG8_LDB(B0, 0, 0); PG8_LDB(B1, 0, 1); PG8_SCHED; PG8_LDA(At, 0, 0); PG8_STAGE(PG8_SA(1, 1), a1 + hstepA, voffA);
            PG8_WAIT_V(8); PG8_WAIT_L(0); PG8_BAR; PG8_MMA(0, 0, At, B0); PG8_MMA(0, 1, At, B1); PG8_BAR; PG8_SCHED;
            PG8_LDA(At, 0, 1); PG8_STAGE(PG8_SB(0, 0), b2, voffB); PG8_STAGE(PG8_SB(0, 1), b2 + hstepB, voffB); PG8_STAGE(PG8_SA(0, 0), a2, voffA);
            PG8_WAIT_V(8); PG8_WAIT_L(0); PG8_BAR; PG8_MMA(1, 0, At, B0); PG8_MMA(1, 1, At, B1); PG8_BAR; PG8_SCHED;
            PG8_LDB(B0, 1, 0); PG8_LDB(B1, 1, 1); PG8_SCHED; PG8_LDA(At, 1, 0); PG8_STAGE(PG8_SA(0, 1), a2 + hstepA, voffA);
            PG8_WAIT_V(8); PG8_WAIT_L(0); PG8_BAR; PG8_MMA(0, 0, At, B0); PG8_MMA(0, 1, At, B1); PG8_BAR; PG8_SCHED;
            PG8_LDA(At, 1, 1); PG8_STAGE(PG8_SB(1, 0), b3, voffB); PG8_STAGE(PG8_SB(1, 1), b3 + hstepB, voffB); PG8_STAGE(PG8_SA(1, 0), a3, voffA);
            PG8_WAIT_V(8); PG8_WAIT_L(0); PG8_BAR; PG8_MMA(1, 0, At, B0); PG8_MMA(1, 1, At, B1); PG8_BAR; PG8_SCHED;
        }
        if (wr == 0) PG8_BAR;
        E(acc, cur, wr, wc, fr, fq);
        if (!has_next) break;
#pragma unroll
        for (int a = 0; a < 2; ++a)
#pragma unroll
            for (int b = 0; b < 2; ++b)
#pragma unroll
                for (int m = 0; m < 4; ++m)
#pragma unroll
                    for (int n = 0; n < 2; ++n) acc[a][b][m][n] = (f32x4){0.f, 0.f, 0.f, 0.f};
        cur = nxt; cA = nA; cB = nB; ++ui;
        if (wr == 1) PG8_BAR;
    }
    PG8_WAIT_V(0);
    PG8_BAR;
#undef PG8_SA
#undef PG8_SB
#undef PG8_STAGE
#undef PG8_LDA
#undef PG8_LDB
#undef PG8_MMA
#undef PG8_WAIT_V
#undef PG8_WAIT_L
#undef PG8_BAR
#undef PG8_SCHED
}

struct EpiBf16 {
    static constexpr bool PERM = true, HOOK = false;
    bf16_t* O; int ldc; int gcols;
    bf16_t* O2; int split_pn; int ldc2;
    __device__ __forceinline__ void operator()(const Acc& acc, const Unit& u, int wr, int wc, int fr, int fq) const {
        const bool second = u.pn >= split_pn; bf16_t* base = second ? O2 : O; const int ld = second ? ldc2 : ldc;
        const int row0 = u.pm * BM + wr * 64 + fr, col0 = u.g * gcols + (second ? u.pn - split_pn : u.pn) * BM + wc * 32 + 8 * fq;
#pragma unroll
        for (int ai = 0; ai < 2; ++ai)
#pragma unroll
            for (int m = 0; m < 4; ++m) { bf16_t* rowp = base + (size_t)(row0 + ai * HALF + m * 16) * ld + col0;
#pragma unroll
                for (int bj = 0; bj < 2; ++bj) { const f32x4 v0 = acc[ai][bj][m][0], v1 = acc[ai][bj][m][1];
                    u32x4 w; w.x = cvt_pk_bf16(v0[0], v0[1]); w.y = cvt_pk_bf16(v0[2], v0[3]); w.z = cvt_pk_bf16(v1[0], v1[1]); w.w = cvt_pk_bf16(v1[2], v1[3]);
                    *(u32x4*)(rowp + bj * HALF) = w; } }
    }
};
struct EpiSwiGLU {
    static constexpr bool PERM = true, HOOK = false;
    bf16_t* O; int ldc;
    __device__ __forceinline__ void operator()(const Acc& acc, const Unit& u, int wr, int wc, int fr, int fq) const {
        const int row0 = u.pm * BM + wr * 64 + fr, col0 = u.pn * HALF + wc * 32 + 8 * fq;
#pragma unroll
        for (int ai = 0; ai < 2; ++ai)
#pragma unroll
            for (int m = 0; m < 4; ++m) { bf16_t* rowp = O + (size_t)(row0 + ai * HALF + m * 16) * ldc + col0;
                float o[8];
#pragma unroll
                for (int n = 0; n < 2; ++n)
#pragma unroll
                    for (int j = 0; j < 4; ++j) { const float gg = acc[ai][0][m][n][j], uu = acc[ai][1][m][n][j]; o[n * 4 + j] = gg * uu * __builtin_amdgcn_rcpf(1.0f + __expf(-gg)); }
                u32x4 w; w.x = cvt_pk_bf16(o[0], o[1]); w.y = cvt_pk_bf16(o[2], o[3]); w.z = cvt_pk_bf16(o[4], o[5]); w.w = cvt_pk_bf16(o[6], o[7]);
                *(u32x4*)rowp = w; }
    }
};
struct EpiResid {
    static constexpr bool PERM = false, HOOK = false;
    float* X; const float* gvec; float coef; float alpha; int lnid; const float* xin;
    __device__ __forceinline__ void partial(const Acc& acc, const Unit& u, int wr, int wc, int fr, int fq) const {
        asm volatile("; K-split partial tile" ::: "memory");
        float* P = (float*)((char*)X + (WS_R + R_PART - WS_X));
        float* base = P + ((size_t)u.ks * 1024 + (u.pm / 17) * 256 + wr * 64 + fr) * D + u.pn * BM + wc * 32 + 4 * fq;
#pragma unroll
        for (int ai = 0; ai < 2; ++ai)
#pragma unroll
            for (int m = 0; m < 4; ++m) { float* rowp = base + (size_t)(ai * HALF + m * 16) * D;
#pragma unroll
                for (int bj = 0; bj < 2; ++bj)
#pragma unroll
                    for (int n = 0; n < 2; ++n) *(f32x4*)(rowp + bj * HALF + n * 16) = acc[ai][bj][m][n]; }
    }
    __device__ __forceinline__ void whole(const Acc& acc, const Unit& u, int wr, int wc, int fr, int fq) const {
        const int row0 = u.pm * BM + wr * 64 + fr, col0 = u.pn * BM + wc * 32 + 4 * fq;
        const float* gp = gvec + (size_t)modrow_of_panel(u.pm) * 18432 + col0;
        const f32x4 g00 = *(const f32x4*)(gp) * coef, g01 = *(const f32x4*)(gp + 16) * coef, g10 = *(const f32x4*)(gp + HALF) * coef, g11 = *(const f32x4*)(gp + HALF + 16) * coef;
        const float* lp = (const float*)((const char*)X + ((long)WS_LNT - (long)WS_X)) + lnid * 4096 + col0;
        const f32x4 ga00 = *(const f32x4*)(lp) * alpha, ga01 = *(const f32x4*)(lp + 16) * alpha, ga10 = *(const f32x4*)(lp + HALF) * alpha, ga11 = *(const f32x4*)(lp + HALF + 16) * alpha;
        const f32x4 be00 = *(const f32x4*)(lp + 2048) * alpha, be01 = *(const f32x4*)(lp + 2048 + 16) * alpha, be10 = *(const f32x4*)(lp + 2048 + HALF) * alpha, be11 = *(const f32x4*)(lp + 2048 + HALF + 16) * alpha;
        const float* st = (const float*)((const char*)X + ((long)WS_STATS - (long)WS_X)) + 2 * row0;
        const long dlt = xin ? (long)((const char*)(xin + ((size_t)(u.pm / 17) * SEQ + (size_t)(u.pm % 17 - 1) * BM) * D) - (const char*)(X + (size_t)u.pm * BM * D)) : 0l;
#pragma unroll
        for (int ai = 0; ai < 2; ++ai)
#pragma unroll
            for (int m2 = 0; m2 < 4; m2 += 2) {
                float* rp0 = X + (size_t)(row0 + ai * HALF + m2 * 16) * D + col0; float* rp1 = rp0 + (size_t)16 * D;
                const f32x4 xa0 = *(const f32x4*)((const char*)rp0 + dlt), xa1 = *(const f32x4*)((const char*)(rp0 + 16) + dlt), xa2 = *(const f32x4*)((const char*)(rp0 + HALF) + dlt), xa3 = *(const f32x4*)((const char*)(rp0 + HALF + 16) + dlt);
                const f32x4 xb0 = *(const f32x4*)((const char*)rp1 + dlt), xb1 = *(const f32x4*)((const char*)(rp1 + 16) + dlt), xb2 = *(const f32x4*)((const char*)(rp1 + HALF) + dlt), xb3 = *(const f32x4*)((const char*)(rp1 + HALF + 16) + dlt);
                { const int m = m2; const float mu = st[2 * (ai * HALF + m * 16)], rs = st[2 * (ai * HALF + m * 16) + 1]; const float nm = -mu * rs;
                  *(f32x4*)(rp0) = (xa0 * rs + nm) * ga00 + be00 + g00 * acc[ai][0][m][0]; *(f32x4*)(rp0 + 16) = (xa1 * rs + nm) * ga01 + be01 + g01 * acc[ai][0][m][1];
                  *(f32x4*)(rp0 + HALF) = (xa2 * rs + nm) * ga10 + be10 + g10 * acc[ai][1][m][0]; *(f32x4*)(rp0 + HALF + 16) = (xa3 * rs + nm) * ga11 + be11 + g11 * acc[ai][1][m][1]; }
                { const int m = m2 + 1; const float mu = st[2 * (ai * HALF + m * 16)], rs = st[2 * (ai * HALF + m * 16) + 1]; const float nm = -mu * rs;
                  *(f32x4*)(rp1) = (xb0 * rs + nm) * ga00 + be00 + g00 * acc[ai][0][m][0]; *(f32x4*)(rp1 + 16) = (xb1 * rs + nm) * ga01 + be01 + g01 * acc[ai][0][m][1];
                  *(f32x4*)(rp1 + HALF) = (xb2 * rs + nm) * ga10 + be10 + g10 * acc[ai][1][m][0]; *(f32x4*)(rp1 + HALF + 16) = (xb3 * rs + nm) * ga11 + be11 + g11 * acc[ai][1][m][1]; }
                asm volatile("" ::: "memory"); }
    }
    __device__ __forceinline__ void operator()(const Acc& acc, const Unit& u, int wr, int wc, int fr, int fq) const { if (u.ks >= 0) partial(acc, u, wr, wc, fr, fq); else whole(acc, u, wr, wc, fr, fq); }
};
struct EpiGate {
    static constexpr bool PERM = true, HOOK = false;
    bf16_t* O; const float* bias; int ldc;
    __device__ __forceinline__ void operator()(const Acc& acc, const Unit& u, int wr, int wc, int fr, int fq) const {
        const int row0 = u.pm * BM + wr * 64 + fr, col0 = u.pn * BM + wc * 32 + 8 * fq;
        f32x4 bv[2][2];
#pragma unroll
        for (int bj = 0; bj < 2; ++bj)
#pragma unroll
            for (int n = 0; n < 2; ++n) bv[bj][n] = *(const f32x4*)(bias + col0 + bj * HALF + 4 * n);
#pragma unroll
        for (int ai = 0; ai < 2; ++ai)
#pragma unroll
            for (int m = 0; m < 4; ++m) { bf16_t* rowp = O + (size_t)(row0 + ai * HALF + m * 16) * ldc + col0;
#pragma unroll
                for (int bj = 0; bj < 2; ++bj) { f32x4 v0 = acc[ai][bj][m][0] + bv[bj][0], v1 = acc[ai][bj][m][1] + bv[bj][1];
#pragma unroll
                    for (int j = 0; j < 4; ++j) { v0[j] = __builtin_amdgcn_rcpf(1.0f + __expf(-v0[j])); v1[j] = __builtin_amdgcn_rcpf(1.0f + __expf(-v1[j])); }
                    u32x4 w; w.x = cvt_pk_bf16(v0[0], v0[1]); w.y = cvt_pk_bf16(v0[2], v0[3]); w.z = cvt_pk_bf16(v1[0], v1[1]); w.w = cvt_pk_bf16(v1[2], v1[3]);
                    *(u32x4*)(rowp + bj * HALF) = w; } }
    }
};
template <int MODE> struct EpiMerge {
    static constexpr bool PERM = true, HOOK = false;
    const bf16_t* G; float* Yf; bf16_t* Yb; float gs;
    __device__ __forceinline__ void operator()(const Acc& acc, const Unit& u, int wr, int wc, int fr, int fq) const {
        const int row0 = u.pm * BM + wr * 64 + fr, col0 = u.pn * BM + wc * 32 + 8 * fq;
#pragma unroll
        for (int ai = 0; ai < 2; ++ai)
#pragma unroll
            for (int m = 0; m < 4; ++m) { const size_t r = (size_t)(row0 + ai * HALF + m * 16);
#pragma unroll
                for (int bj = 0; bj < 2; ++bj) { const int c = col0 + bj * HALF;
#ifdef DBG_GHALF
                    const u32x4 gw = (u32x4){0x3f003f00u, 0x3f003f00u, 0x3f003f00u, 0x3f003f00u};
#else
                    const u32x4 gw = *(const u32x4*)(G + r * GATE_IN + c);
#endif
                    f32x4 v0 = acc[ai][bj][m][0], v1 = acc[ai][bj][m][1];
                    v0[0] *= bf_lo(gw.x); v0[1] *= bf_hi(gw.x); v0[2] *= bf_lo(gw.y); v0[3] *= bf_hi(gw.y);
                    v1[0] *= bf_lo(gw.z); v1[1] *= bf_hi(gw.z); v1[2] *= bf_lo(gw.w); v1[3] *= bf_hi(gw.w); v0 *= gs; v1 *= gs;
                    float* yp = Yf + r * D + c;
                    if (MODE >= 1) { v0 += *(const f32x4*)yp; v1 += *(const f32x4*)(yp + 4); }
                    if (MODE <= 1) { *(f32x4*)yp = v0; *(f32x4*)(yp + 4) = v1; }
                    else { u32x4 w; w.x = cvt_pk_bf16(v0[0], v0[1]); w.y = cvt_pk_bf16(v0[2], v0[3]); w.z = cvt_pk_bf16(v1[0], v1[1]); w.w = cvt_pk_bf16(v1[2], v1[3]);
                        *(u32x4*)(Yb + r * D + c) = w; } }
                asm volatile("" ::: "memory"); }
    }
};
struct EpiMergeOne {
    static constexpr bool PERM = true, HOOK = true;
    const bf16_t* G; bf16_t* Yb; int t1, t2; LAS unsigned* flag;
    __device__ __forceinline__ void mid(Acc& acc, const Unit& u, int seg, int wr, int wc, int fr, int fq) const {
        const int row0 = u.pm * BM + wr * 64 + fr, col0 = u.pn * BM + wc * 32 + 8 * fq;
        const bf16_t* gp = G + (size_t)row0 * GATE_IN + seg * 2048 + col0;
#pragma unroll
        for (int ai = 0; ai < 2; ++ai)
#pragma unroll
            for (int m = 0; m < 4; ++m) { const bf16_t* rp = gp + (size_t)(ai * HALF + m * 16) * GATE_IN;
                const u32x4 a0 = *(const u32x4*)(rp), b0 = *(const u32x4*)(rp + 2048), a1 = *(const u32x4*)(rp + HALF), b1 = *(const u32x4*)(rp + 2048 + HALF);
                float ga[8], gb[8];
                unpack8(a0, ga); unpack8(b0, gb);
#pragma unroll
                for (int j = 0; j < 4; ++j) { acc[ai][0][m][0][j] *= ga[j] * __builtin_amdgcn_rcpf(gb[j]); acc[ai][0][m][1][j] *= ga[4 + j] * __builtin_amdgcn_rcpf(gb[4 + j]); }
                unpack8(a1, ga); unpack8(b1, gb);
#pragma unroll
                for (int j = 0; j < 4; ++j) { acc[ai][1][m][0][j] *= ga[j] * __builtin_amdgcn_rcpf(gb[j]); acc[ai][1][m][1][j] *= ga[4 + j] * __builtin_amdgcn_rcpf(gb[4 + j]); }
                asm volatile("" ::: "memory"); }
    }
    __device__ __forceinline__ void partial(const Acc& acc, const Unit& u, int wr, int wc, int fr, int fq) const {
        asm volatile("; K-split gated partial tile" ::: "memory");
        const int seg = (u.ks + 1) >> 1, bt = u.pm / 17;
        const int row0 = u.pm * BM + wr * 64 + fr, col0 = u.pn * BM + wc * 32 + 8 * fq;
        float* P = (float*)((char*)Yb + (R_PART - R_Y2B));
        { float* pb = P + ((size_t)u.ks * 1024 + bt * 256 + wr * 64 + fr) * D + col0;
#pragma unroll
        for (int ai = 0; ai < 2; ++ai)
#pragma unroll
            for (int m = 0; m < 4; ++m) { const size_t r = (size_t)(row0 + ai * HALF + m * 16);
#pragma unroll
                for (int bj = 0; bj < 2; ++bj) { const int c = col0 + bj * HALF; float g[8]; unpack8(*(const u32x4*)(G + r * GATE_IN + seg * 2048 + c), g);
                    const f32x4 v0 = acc[ai][bj][m][0], v1 = acc[ai][bj][m][1];
                    float* q = pb + (size_t)(ai * HALF + m * 16) * D + bj * HALF;
                    *(f32x4*)q = (f32x4){v0[0] * g[0], v0[1] * g[1], v0[2] * g[2], v0[3] * g[3]}; *(f32x4*)(q + 4) = (f32x4){v1[0] * g[4], v1[1] * g[5], v1[2] * g[6], v1[3] * g[7]}; }
                asm volatile("" ::: "memory"); } }
        asm volatile("s_waitcnt vmcnt(0)" ::: "memory");
        __builtin_amdgcn_s_barrier();
        const int tid = ((wr * 4 + wc) << 6) + (fq << 4) + fr;
        if (tid == 0) { unsigned* cnt = (unsigned*)((char*)Yb - (WS_R + R_Y2B - WS_CTL)) + 4096 + 16 * (bt + 4 * u.pn);
            __builtin_amdgcn_fence(__ATOMIC_RELEASE, "agent");
            const unsigned old = __hip_atomic_fetch_add(cnt, 1u, __ATOMIC_RELAXED, __HIP_MEMORY_SCOPE_AGENT);
            if (old == 3u) __builtin_amdgcn_fence(__ATOMIC_ACQUIRE, "agent");
            *(volatile LAS unsigned*)flag = old; asm volatile("s_waitcnt lgkmcnt(0)" ::: "memory"); }
        __builtin_amdgcn_s_barrier();
        if (*(volatile LAS unsigned*)flag == 3u) {
            const float* src = P + ((size_t)bt * 256 + (tid >> 5)) * D + u.pn * BM + (tid & 31) * 8;
            bf16_t* dst = Yb + ((size_t)u.pm * BM + (tid >> 5)) * D + u.pn * BM + (tid & 31) * 8;
#pragma unroll 4
            for (int it = 0; it < 16; ++it) { const float* sp = src + (size_t)it * 16 * D;
                f32x4 s0 = *(const f32x4*)sp, s1 = *(const f32x4*)(sp + 4);
#pragma unroll
                for (int k = 1; k < 4; ++k) { s0 += *(const f32x4*)(sp + (size_t)k * 1024 * D); s1 += *(const f32x4*)(sp + (size_t)k * 1024 * D + 4); }
                u32x4 w; w.x = cvt_pk_bf16(s0[0], s0[1]); w.y = cvt_pk_bf16(s0[2], s0[3]); w.z = cvt_pk_bf16(s1[0], s1[1]); w.w = cvt_pk_bf16(s1[2], s1[3]);
                *(u32x4*)(dst + (size_t)it * 16 * D) = w; }
        }
    }
    __device__ __forceinline__ void operator()(const Acc& acc, const Unit& u, int wr, int wc, int fr, int fq) const {
        if (u.ks >= 0) { partial(acc, u, wr, wc, fr, fq); return; }
        const int row0 = u.pm * BM + wr * 64 + fr, col0 = u.pn * BM + wc * 32 + 8 * fq;
#pragma unroll
        for (int ai = 0; ai < 2; ++ai)
#pragma unroll
            for (int m = 0; m < 4; ++m) { const size_t r = (size_t)(row0 + ai * HALF + m * 16);
#pragma unroll
                for (int bj = 0; bj < 2; ++bj) { const int c = col0 + bj * HALF; float g[8]; unpack8(*(const u32x4*)(G + r * GATE_IN + 4096 + c), g);
                    const f32x4 v0 = acc[ai][bj][m][0], v1 = acc[ai][bj][m][1];
                    u32x4 w; w.x = cvt_pk_bf16(v0[0] * g[0], v0[1] * g[1]); w.y = cvt_pk_bf16(v0[2] * g[2], v0[3] * g[3]); w.z = cvt_pk_bf16(v1[0] * g[4], v1[1] * g[5]); w.w = cvt_pk_bf16(v1[2] * g[6], v1[3] * g[7]);
                    *(u32x4*)(Yb + r * D + c) = w; }
                asm volatile("" ::: "memory"); }
    }
};
}
namespace att {
constexpr int NW = 8, QBLK = 32, KVBLK = 64;
constexpr float SCALE = 0.072168783648703216f;
constexpr float THR = 8.f;
constexpr int SDEPTH = 1;
constexpr int LDQ = 3072, LDK = 2048, LDR = 64, LDV = 2048, LDO = 4096;
constexpr int NQREG = 6;
constexpr int SHM_V = KVBLK * VD * 2, SHM_K = KVBLK * QKD * 2, SHM_QS = 2 * SHM_V + 2 * SHM_K + NW * 64 * 4, SHM_ATTN = SHM_QS + (12 - NQREG) * 8192;
#define KSWZ(row, colB) ((row) * 384 + ((colB) ^ ((((row) >> 1) & 7) << 4)))
#define SBAR() __builtin_amdgcn_sched_barrier(0)
__device__ __forceinline__ int crow(int r, int hi) { return (r & 3) + 8 * (r >> 2) + 4 * hi; }

__device__ __forceinline__ void partialSM(f32x16& p0, f32x16& p1, float& m_reg, float& mn, float& alpha) {
  constexpr float C = SCALE * 1.4426950408889634f;
  float pmax = p0[0];
#pragma unroll
  for (int r = 1; r < 16; ++r) pmax = fmaxf(pmax, p0[r]);
#pragma unroll
  for (int r = 0; r < 16; ++r) pmax = fmaxf(pmax, p1[r]);
  { auto rr = __builtin_amdgcn_permlane32_swap(__float_as_uint(pmax), __float_as_uint(pmax), false, false);
    pmax = fmaxf(__uint_as_float(rr[0]), __uint_as_float(rr[1])); }
  if (__builtin_expect(__all(pmax - m_reg <= THR / SCALE), 1)) { mn = m_reg; alpha = 1.f; }
  else { mn = fmaxf(m_reg, pmax); alpha = __builtin_amdgcn_exp2f((m_reg - mn) * C); m_reg = mn; }
  float mnC = -mn * C;
#pragma unroll
  for (int r = 0; r < 16; ++r) p0[r] = fmaf(p0[r], C, mnC);
#pragma unroll
  for (int r = 0; r < 16; ++r) p1[r] = fmaf(p1[r], C, mnC);
#pragma unroll
  for (int r = 0; r < 16; ++r) p0[r] = __builtin_amdgcn_exp2f(p0[r]);
}
__device__ __forceinline__ void finishSM(f32x16& p0, f32x16& p1, float alpha, float& l_reg, bf16x8& pa0, bf16x8& pa1, bf16x8& pa2, bf16x8& pa3) {
#pragma unroll
  for (int r = 0; r < 16; ++r) p1[r] = __builtin_amdgcn_exp2f(p1[r]);
  float ps = 0;
#pragma unroll
  for (int r = 0; r < 16; ++r) ps += p0[r];
#pragma unroll
  for (int r = 0; r < 16; ++r) ps += p1[r];
  { auto rr = __builtin_amdgcn_permlane32_swap(__float_as_uint(ps), __float_as_uint(ps), false, false);
    ps = __uint_as_float(rr[0]) + __uint_as_float(rr[1]); }
  l_reg = l_reg * alpha + ps;
#define PK4(P, BASE, OUT) do { unsigned a0 = cvt_pk_bf16(P[BASE + 0], P[BASE + 1]), a1 = cvt_pk_bf16(P[BASE + 2], P[BASE + 3]);   \
    unsigned b0 = cvt_pk_bf16(P[BASE + 4], P[BASE + 5]), b1 = cvt_pk_bf16(P[BASE + 6], P[BASE + 7]);                              \
    auto r0 = __builtin_amdgcn_permlane32_swap(a0, b0, false, false); auto r1 = __builtin_amdgcn_permlane32_swap(a1, b1, false, false); \
    u32x4 w = {r0[0], r1[0], r0[1], r1[1]}; OUT = *reinterpret_cast<bf16x8*>(&w); } while (0)
  PK4(p0, 0, pa0); PK4(p0, 8, pa1); PK4(p1, 0, pa2); PK4(p1, 8, pa3);
#undef PK4
}
__device__ __forceinline__ void qkt(f32x16& p0, f32x16& p1, const char* Ks, const bf16x8* qr, const char* qsp, int r32, int hi) {
  p0 = f32x16{}; p1 = f32x16{};
#pragma unroll
  for (int d0 = 0; d0 < 12; ++d0) { const int cb = (d0 * 16 + hi * 8) * 2;
    bf16x8 b0 = *reinterpret_cast<const bf16x8*>(Ks + KSWZ(r32, cb));
    bf16x8 b1 = *reinterpret_cast<const bf16x8*>(Ks + KSWZ(32 + r32, cb));
    bf16x8 qv; if (d0 < NQREG) qv = qr[d0]; else qv = *reinterpret_cast<const bf16x8*>(qsp + (d0 - NQREG) * 8192);
    p0 = MFMA32(b0, qv, p0);
    p1 = MFMA32(b1, qv, p1);
    if (d0 == 5) SBAR(); }
}
__device__ __forceinline__ int v_st(int k, int c) { const int kk = (k & ~0xC) | ((k & 4) << 1) | ((k & 8) >> 1); return ((kk >> 3) * 4 + (c >> 5)) * 512 + ((kk & 7) * 32 + (c & 31)) * 2; }
__device__ __forceinline__ int v_rd_base(int lane) { return ((lane & 3) << 3) | (((lane >> 2) & 3) << 6) | (((lane >> 4) & 1) << 5) | (((lane >> 5) & 1) << 8); }
constexpr int v_rd_off(int d0, int ks, int half) { return d0 * 512 + ks * 4096 + half * 2048; }
template <int OFF> __device__ __forceinline__ s16x4 tr_read(int vb) {
  s16x4 r; asm volatile("ds_read_b64_tr_b16 %0, %1 offset:%2" : "=&v"(r) : "v"(vb), "i"(OFF) : "memory"); return r;
}
template <int D0> __device__ __forceinline__ void pv_one(f32x16& od, int vb, bf16x8 pa0, bf16x8 pa1, bf16x8 pa2, bf16x8 pa3) {
  const s16x4 l0 = tr_read<v_rd_off(D0, 0, 0)>(vb), h0 = tr_read<v_rd_off(D0, 0, 1)>(vb), l1 = tr_read<v_rd_off(D0, 1, 0)>(vb), h1 = tr_read<v_rd_off(D0, 1, 1)>(vb);
  const s16x4 l2 = tr_read<v_rd_off(D0, 2, 0)>(vb), h2 = tr_read<v_rd_off(D0, 2, 1)>(vb), l3 = tr_read<v_rd_off(D0, 3, 0)>(vb), h3 = tr_read<v_rd_off(D0, 3, 1)>(vb);
  asm volatile("s_waitcnt lgkmcnt(0)" ::: "memory"); SBAR();
#define PK(L, H) (bf16x8){L[0], L[1], L[2], L[3], H[0], H[1], H[2], H[3]}
  od = MFMA32(pa0, PK(l0, h0), od);
  od = MFMA32(pa1, PK(l1, h1), od);
  od = MFMA32(pa2, PK(l2, h2), od);
  od = MFMA32(pa3, PK(l3, h3), od);
#undef PK
}
__device__ __forceinline__ void pv_d0(f32x16* o, int vb, bf16x8 pa0, bf16x8 pa1, bf16x8 pa2, bf16x8 pa3) {
  pv_one<0>(o[0], vb, pa0, pa1, pa2, pa3); pv_one<1>(o[1], vb, pa0, pa1, pa2, pa3); pv_one<2>(o[2], vb, pa0, pa1, pa2, pa3); pv_one<3>(o[3], vb, pa0, pa1, pa2, pa3);
}
__device__ __forceinline__ void attn_body(const bf16_t* __restrict__ Qb, const bf16_t* __restrict__ Kh, const bf16_t* __restrict__ Rh, const bf16_t* __restrict__ Vh, bf16_t* __restrict__ Ob, int seq, const float* __restrict__ rope  , char* lds) {
  int tid_ = threadIdx.x; asm volatile("" : "+v"(tid_));
  const int tid = tid_, wid = tid >> 6, lane = tid & 63, r32 = lane & 31, hi = lane >> 5;
  char* V_lds = lds; char* K_lds = lds + 2 * SHM_V;
  float* ws = (float*)(lds + 2 * SHM_V + 2 * SHM_K) + wid * 64; float* li_l = ws; float* al_l = ws + 32;
  float m_reg = -1e30f, l_reg = 0; f32x16 o[4] = {}; bf16x8 qr[NQREG];
  const bf16_t* Qw = Qb + (long)(wid * QBLK + r32) * LDQ + hi * 8;
  char* qsp = lds + SHM_QS + tid * 16;
#pragma unroll
  for (int d0 = 0; d0 < 12; ++d0) { bf16x8 qv = *reinterpret_cast<const bf16x8*>(Qw + d0 * 16);
    if (d0 >= 8 && rope) {
      const f32x4* cs = reinterpret_cast<const f32x4*>(rope + ((long)(wid * QBLK + r32) * 32 + (d0 - 8) * 8 + hi * 4) * 2); const f32x4 c0 = cs[0], c1 = cs[1];
      const u32x4 w = *reinterpret_cast<const u32x4*>(&qv);
      const float x0 = bf_lo(w.x), x1 = bf_hi(w.x), x2 = bf_lo(w.y), x3 = bf_hi(w.y), x4 = bf_lo(w.z), x5 = bf_hi(w.z), x6 = bf_lo(w.w), x7 = bf_hi(w.w);
      u32x4 o; o.x = cvt_pk_bf16(x0 * c0[0] - x1 * c0[1], x0 * c0[1] + x1 * c0[0]); o.y = cvt_pk_bf16(x2 * c0[2] - x3 * c0[3], x2 * c0[3] + x3 * c0[2]);
      o.z = cvt_pk_bf16(x4 * c1[0] - x5 * c1[1], x4 * c1[1] + x5 * c1[0]); o.w = cvt_pk_bf16(x6 * c1[2] - x7 * c1[3], x6 * c1[3] + x7 * c1[2]);
      qv = *reinterpret_cast<const bf16x8*>(&o); }
    if (d0 < NQREG) qr[d0] = qv; else *reinterpret_cast<bf16x8*>(qsp + (d0 - NQREG) * 8192) = qv; }
  const int sr = tid >> 4, sc = (tid & 15) * 8, vst0 = v_st(sr, sc);
  const int krow = tid >> 3, kc = tid & 7, kst = krow * 384 + ((kc * 16) ^ (((krow >> 1) & 7) << 4));
  const bf16_t* Vg = Vh + (long)sr * LDV + sc; const bf16_t* Kg = Kh + (long)krow * LDK + kc * 8; const bf16_t* Rg = Rh + (long)krow * LDR + kc * 8;
  const int vb0 = (int)(uintptr_t)V_lds + v_rd_base(lane);
  struct { bf16x8 vs0, vs1, ks0, ks1, ks2; } sr_[SDEPTH];
#define SLOAD(i, k0) do { sr_[i].vs0 = *reinterpret_cast<const bf16x8*>(Vg + (long)(k0) * LDV); sr_[i].vs1 = *reinterpret_cast<const bf16x8*>(Vg + (long)((k0) + 32) * LDV); \
    sr_[i].ks0 = *reinterpret_cast<const bf16x8*>(Kg + (long)(k0) * LDK); sr_[i].ks1 = *reinterpret_cast<const bf16x8*>(Kg + (long)(k0) * LDK + 64); \
    sr_[i].ks2 = *reinterpret_cast<const bf16x8*>(Rg + (long)(k0) * LDR); } while (0)
#define SWRITE(b, i) do { *(bf16x8*)(V_lds + (b) * SHM_V + vst0) = sr_[i].vs0; *(bf16x8*)(V_lds + (b) * SHM_V + vst0 + 8192) = sr_[i].vs1; \
    *(bf16x8*)(K_lds + (b) * SHM_K + kst) = sr_[i].ks0; *(bf16x8*)(K_lds + (b) * SHM_K + kst + 128) = sr_[i].ks1; *(bf16x8*)(K_lds + (b) * SHM_K + kst + 256) = sr_[i].ks2; } while (0)
#define SWAIT() do { if constexpr (SDEPTH == 2) asm volatile("s_waitcnt vmcnt(5)" ::: "memory"); else asm volatile("s_waitcnt vmcnt(0)" ::: "memory"); } while (0)
#define RESC(a) do { if (__any((a) < 1.f)) { if (hi == 0) al_l[r32] = (a); asm volatile("s_waitcnt lgkmcnt(0)" ::: "memory"); \
    _Pragma("unroll") for (int d = 0; d < 4; ++d) _Pragma("unroll") for (int r = 0; r < 16; ++r) o[d][r] *= al_l[crow(r, hi)]; } } while (0)
  f32x16 pA0, pA1, pB0, pB1; float mnA, mnB, alA, alB; bf16x8 pa0, pa1, pa2, pa3; const int NT = seq / KVBLK;
  constexpr int SE = 0, SO = SDEPTH - 1;
  SLOAD(SE, 0); asm volatile("s_waitcnt vmcnt(0)" ::: "memory"); SWRITE(0, SE); __syncthreads();
  qkt(pA0, pA1, K_lds, qr, qsp, r32, hi); partialSM(pA0, pA1, m_reg, mnA, alA);
  SLOAD(SO, KVBLK); if constexpr (SDEPTH == 2) { if (2 < NT) SLOAD(SE, 2 * KVBLK); }
  SWAIT(); SWRITE(1, SO); __syncthreads();
  for (int j = 1; j + 1 < NT; j += 2) {
    SBAR(); qkt(pB0, pB1, K_lds + SHM_K, qr, qsp, r32, hi);
    finishSM(pA0, pA1, alA, l_reg, pa0, pa1, pa2, pa3); SBAR();
    SLOAD(SO, (j + SDEPTH) * KVBLK); SBAR();
    pv_d0(o, vb0, pa0, pa1, pa2, pa3); partialSM(pB0, pB1, m_reg, mnB, alB);
    __syncthreads(); SWAIT(); SWRITE(0, SE);
    RESC(alB); __syncthreads();
    SBAR(); qkt(pA0, pA1, K_lds, qr, qsp, r32, hi);
    finishSM(pB0, pB1, alB, l_reg, pa0, pa1, pa2, pa3); SBAR();
    if (SDEPTH == 1 || j + 3 < NT) SLOAD(SE, (j + 1 + SDEPTH) * KVBLK); SBAR();
    pv_d0(o, vb0 + (int)SHM_V, pa0, pa1, pa2, pa3); partialSM(pA0, pA1, m_reg, mnA, alA);
    __syncthreads(); SWAIT(); SWRITE(1, SO);
    RESC(alA); __syncthreads();
  }
  SBAR(); qkt(pB0, pB1, K_lds + SHM_K, qr, qsp, r32, hi);
  finishSM(pA0, pA1, alA, l_reg, pa0, pa1, pa2, pa3); SBAR();
  pv_d0(o, vb0, pa0, pa1, pa2, pa3); partialSM(pB0, pB1, m_reg, mnB, alB);
  __syncthreads(); RESC(alB);
  finishSM(pB0, pB1, alB, l_reg, pa0, pa1, pa2, pa3); SBAR();
  pv_d0(o, vb0 + (int)SHM_V, pa0, pa1, pa2, pa3);
  if (hi == 0) li_l[r32] = l_reg; asm volatile("s_waitcnt lgkmcnt(0)" ::: "memory");
  float rli[16];
#pragma unroll
  for (int r = 0; r < 16; ++r) rli[r] = __builtin_amdgcn_rcpf(li_l[crow(r, hi)]);
  bf16_t* Ow = Ob + (long)(wid * QBLK) * LDO;
#pragma unroll
  for (int r = 0; r < 16; ++r) { const int orow = crow(r, hi);
#pragma unroll
    for (int d0 = 0; d0 < 4; ++d0) Ow[(long)orow * LDO + d0 * 32 + r32] = f2bf(o[d0][r] * rli[r]); }
#undef SLOAD
#undef SWRITE
#undef SWAIT
#undef RESC
}
}
#define RLX_AGENT __ATOMIC_RELAXED, __HIP_MEMORY_SCOPE_AGENT
#define LDS_WAIT() asm volatile("s_waitcnt lgkmcnt(0)" ::: "memory")
#define VM_WAIT() asm volatile("s_waitcnt vmcnt(0)" ::: "memory")

#define XB_TMO      128
#define XB_XCNT(j)  (256  + 64 * (j))
#define XB_XSUB(j)  (1280 + 64 * (j))
#define XB_XGEN(j)  (2304 + 64 * (j))
#define XB_TOP      3328
#define XB_TOPGEN   3392
#define XCD_BAR_WORDS 3456
#define XB_SPIN_CAP (1u << 22)
__device__ __forceinline__ unsigned xb_ld(unsigned* p)              { return __hip_atomic_load(p, __ATOMIC_RELAXED, __HIP_MEMORY_SCOPE_AGENT); }
__device__ __forceinline__ unsigned xb_add(unsigned* p, unsigned v) { return __hip_atomic_fetch_add(p, v, __ATOMIC_RELAXED, __HIP_MEMORY_SCOPE_AGENT); }
__device__ __forceinline__ unsigned xb_xcc_id() { return (unsigned)__builtin_amdgcn_s_getreg((3 << 11) | 20) & 0xFu; }
#define XB_SPIN(cond, bar) do { unsigned _sp = 0; while (cond) { __builtin_amdgcn_s_sleep(1); \
    if ((++_sp & 255u) == 0u) { if (xb_ld(&(bar)[XB_TMO])) break; if (_sp > XB_SPIN_CAP) { atomicAdd(&(bar)[XB_TMO], 1u); break; } } } } while (0)
struct XcdBarrier { unsigned* bar; unsigned x; volatile LAS unsigned* st; };
__device__ __forceinline__ XcdBarrier xcd_barrier_post(unsigned* bar, volatile LAS unsigned* st) {
    XcdBarrier b; b.bar = bar; b.x = xb_xcc_id(); b.st = st;
    if (threadIdx.x == 0) (void)xb_add(&bar[XB_XCNT(b.x)], 1u);
    return b;
}
__device__ __forceinline__ void xcd_barrier_complete(unsigned* bar, unsigned x, unsigned& nloc, unsigned& nx) {
    const unsigned G = gridDim.x * gridDim.y * gridDim.z;
    unsigned sum, cnt, mine, sp = 0u;
    for (;;) {
        sum = 0u; cnt = 0u; mine = 0u;
#pragma unroll
        for (unsigned j = 0; j < 16; ++j) { const unsigned c = xb_ld(&bar[XB_XCNT(j)]); sum += c; cnt += (c > 0u) ? 1u : 0u; mine = (j == x) ? c : mine; }
        if (sum == G) break;
        __builtin_amdgcn_s_sleep(1);
        if ((++sp & 255u) == 0u) { if (xb_ld(&bar[XB_TMO])) break; if (sp > XB_SPIN_CAP) { atomicAdd(&bar[XB_TMO], 1u); break; } }
    }
    nloc = mine > 0u ? mine : 1u; nx = cnt > 0u ? cnt : 1u;
}
__device__ __forceinline__ void xcd_barrier(const XcdBarrier& b) {
    asm volatile("s_waitcnt vmcnt(0)" ::: "memory");
    __syncthreads();
    if (threadIdx.x == 0) {
        unsigned* bar = b.bar;
        __builtin_amdgcn_s_waitcnt(0);
        unsigned nloc = b.st[0], nx = b.st[1];
        if (nloc == 0u) { xcd_barrier_complete(bar, b.x, nloc, nx); b.st[0] = nloc; b.st[1] = nx; }
        const unsigned old = xb_add(&bar[XB_XSUB(b.x)], 1u);
        const unsigned gen = old / nloc;
        if (old + 1u == (gen + 1u) * nloc) {
            __builtin_amdgcn_fence(__ATOMIC_RELEASE, "agent");
            asm volatile("s_waitcnt vmcnt(0)" ::: "memory");
            const unsigned og = xb_add(&bar[XB_TOP], 1u);
            const unsigned tg = og / nx;
            if (og + 1u == (tg + 1u) * nx) xb_add(&bar[XB_TOPGEN], 1u);
            else XB_SPIN(xb_ld(&bar[XB_TOPGEN]) == tg, bar);
            __builtin_amdgcn_fence(__ATOMIC_ACQUIRE, "agent");
            xb_add(&bar[XB_XGEN(b.x)], 1u);
            asm volatile("s_waitcnt vmcnt(0)" ::: "memory");
        } else {
            XB_SPIN(xb_ld(&bar[XB_XGEN(b.x)]) == gen, bar);
            __builtin_amdgcn_fence(__ATOMIC_ACQUIRE, "agent");
            asm volatile("s_waitcnt vmcnt(0)" ::: "memory");
        }
    }
    __syncthreads();
}

enum { I_X = 0, I_C, I_CTX, I_CCTX, I_ADAW, I_ADAB, I_LNG, I_LNB, I_WGATE, I_WUP, I_WDOWN, I_WIN, I_GATEB, I_MU, I_W0, I_WUPL, I_A0, I_AUP, I_GUP, I_KK, I_KA, I_RK, I_LNXG, I_LNXB,
       I_QNORM, I_KVNORM, I_WUQ, I_WUK, I_WUV, I_CONVW, I_CONVB, I_LRUWA, I_LRUBA, I_LRUWX, I_LRUBX, I_LAMBDA, I_PRWKV, I_PMLA, I_PLRU, I_WOUT };

struct Ctx {
    LAS unsigned char* lds; unsigned char* ws; const float* const __attribute__((address_space(4)))* in; float* out;
    int tid, lane, wave, G, vcu, gw, NGW;
};

constexpr int MODP_KC = 14;
__device__ __forceinline__ void ph_modp(Ctx& F) {
    LAS float* sl = (LAS float*)F.lds;
    for (int i = F.tid; i < 5 * 2048; i += 512) { const int r = i >> 11, k = i & 2047; const float v = r < 4 ? F.in[I_C][r * 2048 + k] : F.in[I_CCTX][k]; sl[i] = siluf_(v); }
    __syncthreads();
    float* modp = (float*)(F.ws + WS_R + R_MODP);
    const int NIT = MODP_KC * 9216;
    for (int it = blockIdx.x * 512 + F.tid; it < NIT; it += F.G * 512) {
        const int kc = it / 9216, c4 = it % 9216, cc = c4 * 4, l = cc / 18432, c = cc % 18432; const int k0 = kc * 2048 / MODP_KC, k1 = (kc + 1) * 2048 / MODP_KC;
        const float* w = F.in[I_ADAW] + ((size_t)l * 2048 + k0) * 18432 + c;
        f32x4 a0 = {0, 0, 0, 0}, a1 = a0, a2 = a0, a3 = a0, a4 = a0;
#pragma unroll 16
        for (int k = k0; k < k1; ++k) { const f32x4 wv = *(const f32x4*)(w + (size_t)(k - k0) * 18432);
            a0 += wv * sl[k]; a1 += wv * sl[2048 + k]; a2 += wv * sl[4096 + k]; a3 += wv * sl[6144 + k]; a4 += wv * sl[8192 + k]; }
        float* o = modp + (size_t)kc * 5 * 36864 + cc;
        *(f32x4*)(o) = a0; *(f32x4*)(o + 36864) = a1; *(f32x4*)(o + 2 * 36864) = a2; *(f32x4*)(o + 3 * 36864) = a3; *(f32x4*)(o + 4 * 36864) = a4;
    }
    __syncthreads();
}
__device__ __forceinline__ void ph_rope(Ctx& F) {
    float* rope = (float*)(F.ws + WS_ROPE);
    for (int i = blockIdx.x * 512 + F.tid; i < 4096 * 32; i += F.G * 512) { const int t = i >> 5, p = i & 31;
        const float inv = powf(10000.0f, -(float)(p & 15) / 16.0f); const float pos = (float)(p < 16 ? (t >> 6) : (t & 63)); const float ang = pos * inv;
        rope[2 * i] = cosf(ang); rope[2 * i + 1] = sinf(ang); }
}
__device__ __forceinline__ void ph_xasm(Ctx& F) {
    f32x4* X = (f32x4*)(F.ws + WS_X); float* LB = (float*)(F.ws + WS_LB);
    for (int i = blockIdx.x * 512 + F.tid; i < 2 * 4096; i += F.G * 512) { const int l = i >> 12, c = i & 4095; LB[i] = c < 2048 ? F.in[I_W0][l * 2048 + c] : F.in[I_A0][l * 2048 + c - 2048]; }
    { float* ST = (float*)(F.ws + WS_STATS); float* LT = (float*)(F.ws + WS_LNT);
      for (int i = blockIdx.x * 512 + F.tid; i < M; i += F.G * 512) { ST[2 * i] = 0.f; ST[2 * i + 1] = 1.f; }
      for (int i = blockIdx.x * 512 + F.tid; i < 7 * 4096; i += F.G * 512) { const int e = i >> 12, c = i & 4095;
          LT[i] = e == 0 ? (c < 2048 ? 1.f : 0.f) : (c < 2048 ? F.in[I_LNG][(e - 1) * 2048 + c] : F.in[I_LNB][(e - 1) * 2048 + c - 2048]); } }
}
struct CvtJob { const float* src; int sld, K, N, n0;  bf16_t* dst; int dld, kd0, rgrp, rstride, roff; };
__device__ __forceinline__ void cvt_item2(const CvtJob& J, int ia, int ib, LAS float* scr, int lane) {
    const int nblk = J.N / 32;
    float va[32], vb[32];
    { const int kb = ia / nblk, nb = ia % nblk, k0 = 64 * kb, n0 = 32 * nb;
#pragma unroll
      for (int i = 0; i < 32; ++i) { const int kk = 2 * i + (lane >> 5); va[i] = (k0 + kk < J.K) ? J.src[(size_t)(k0 + kk) * J.sld + J.n0 + n0 + (lane & 31)] : 0.f; } }
    if (ib >= 0) { const int kb = ib / nblk, nb = ib % nblk, k0 = 64 * kb, n0 = 32 * nb;
#pragma unroll
      for (int i = 0; i < 32; ++i) { const int kk = 2 * i + (lane >> 5); vb[i] = (k0 + kk < J.K) ? J.src[(size_t)(k0 + kk) * J.sld + J.n0 + n0 + (lane & 31)] : 0.f; } }
#pragma unroll
    for (int i = 0; i < 32; ++i) { const int kk = 2 * i + (lane >> 5); scr[kk * 33 + (lane & 31)] = va[i]; }
    if (ib >= 0) {
#pragma unroll
      for (int i = 0; i < 32; ++i) { const int kk = 2 * i + (lane >> 5); scr[64 * 33 + kk * 33 + (lane & 31)] = vb[i]; } }
    LDS_WAIT(); asm volatile("" ::: "memory");
    const int c = lane & 7;
#pragma unroll
    for (int h = 0; h < 2; ++h) { const int item = h ? ib : ia; if (item < 0) continue;
        const int kb = item / nblk, nb = item % nblk, k0 = 64 * kb, n0 = 32 * nb;
        if (k0 + 8 * c < J.K) {
#pragma unroll
        for (int j = 0; j < 4; ++j) { const int n = (lane >> 3) + 8 * j; const LAS float* s = scr + h * 64 * 33 + (8 * c) * 33 + n;
            u32x4 o; o.x = cvt_pk_bf16(s[0 * 33], s[1 * 33]); o.y = cvt_pk_bf16(s[2 * 33], s[3 * 33]); o.z = cvt_pk_bf16(s[4 * 33], s[5 * 33]); o.w = cvt_pk_bf16(s[6 * 33], s[7 * 33]);
            const int nn = n0 + n; const int row = (nn / J.rgrp) * J.rstride + nn % J.rgrp + J.roff;
            *(u32x4*)(J.dst + (size_t)row * J.dld + J.kd0 + k0 + 8 * c) = o; }
        } }
    LDS_WAIT(); asm volatile("" ::: "memory");
}
constexpr int NCVT = 20 + 32;
__device__ __forceinline__ CvtJob cvt_job(Ctx& F, int l, int j) {
    unsigned char* W = F.ws + WS_W; CvtJob J; const int BIG = 1 << 30;
    J.n0 = 0; J.kd0 = 0; J.rgrp = BIG; J.rstride = 0; J.roff = 0;
    switch (j) {
    case 0: case 1: case 2: case 3: { const int ff = j >> 1, up = j & 1;
        J.src = F.in[up ? I_WUP : I_WGATE] + ((size_t)l * 2 + ff) * 2048 * DFF; J.sld = DFF; J.K = 2048; J.N = DFF; J.dst = (bf16_t*)(W + (ff ? W_GU1 : W_GU0)); J.dld = 2048; J.rgrp = 128; J.rstride = 256; J.roff = up * 128; break; }
    case 4: case 5: { const int ff = j - 4; J.src = F.in[I_WDOWN] + ((size_t)l * 2 + ff) * DFF * 2048; J.sld = 2048; J.K = DFF; J.N = 2048; J.dst = (bf16_t*)(W + (ff ? W_D1 : W_D0)); J.dld = DFF; break; }
    case 6: J.src = F.in[I_WIN] + (size_t)l * 2048 * IN_COLS; J.sld = IN_COLS; J.K = 2048; J.N = FA; J.dst = (bf16_t*)(W + W_INA); J.dld = 2048; J.rgrp = OFF_GB; J.rstride = GB_ROW0; break;
    case 7: J.src = F.in[I_WIN] + (size_t)l * 2048 * IN_COLS; J.sld = IN_COLS; J.K = 2048; J.N = GATE_IN; J.n0 = FA; J.dst = (bf16_t*)(W + W_ING); J.dld = 2048; break;
    case 8: J.src = F.in[I_WUQ] + (size_t)l * 512 * 3072; J.sld = 3072; J.K = 512; J.N = 3072; J.dst = (bf16_t*)(W + W_UQ); J.dld = 512; break;
    case 9: J.src = F.in[I_WUK] + (size_t)l * 256 * 2048; J.sld = 2048; J.K = 256; J.N = 2048; J.dst = (bf16_t*)(W + W_UKV); J.dld = 256; break;
    case 10: J.src = F.in[I_WUV] + (size_t)l * 256 * 2048; J.sld = 2048; J.K = 256; J.N = 2048; J.dst = (bf16_t*)(W + W_UKV); J.dld = 256; J.roff = 2048; break;
    case 11: case 12: { const int d = j - 11; J.src = F.in[I_WUPL] + ((size_t)l * 2 + d) * 64 * 1024; J.sld = 1024; J.K = 64; J.N = 1024; J.dst = (bf16_t*)(W + W_LORA); J.dld = LORA_K; J.roff = d * 1024; break; }
    case 13: case 14: { const int d = j - 13; J.src = F.in[I_AUP] + ((size_t)l * 2 + d) * 64 * 1024; J.sld = 1024; J.K = 64; J.N = 1024; J.dst = (bf16_t*)(W + W_LORA); J.dld = LORA_K; J.roff = 2048 + d * 1024; J.kd0 = 64; break; }
    case 15: J.src = F.in[I_GUP] + (size_t)l * 160 * 1024; J.sld = 1024; J.K = 160; J.N = 1024; J.dst = (bf16_t*)(W + W_LORA); J.dld = LORA_K; J.roff = 4096; J.kd0 = 128; break;
    case 16: J.src = F.in[I_PRWKV] + (size_t)l * 1024 * 2048; J.sld = 2048; J.K = 1024; J.N = 2048; J.dst = (bf16_t*)(W + W_PROJ); J.dld = 4096; J.kd0 = 0; break;
    case 17: J.src = F.in[I_PMLA] + (size_t)l * 2048 * 2048; J.sld = 2048; J.K = 2048; J.N = 2048; J.dst = (bf16_t*)(W + W_PROJ); J.dld = 4096; J.kd0 = 1024; break;
    case 18: J.src = F.in[I_PLRU] + (size_t)l * 1024 * 2048; J.sld = 2048; J.K = 1024; J.N = 2048; J.dst = (bf16_t*)(W + W_PROJ); J.dld = 4096; J.kd0 = 3072; break;
    case 19: J.src = F.in[I_WOUT] + (size_t)l * 2048 * 2048; J.sld = 2048; J.K = 2048; J.N = 2048; J.dst = (bf16_t*)(W + W_OUT); J.dld = 2048; break;
    default: { const int q = j - 20, x = q >> 4, d = (q >> 3) & 1, nb = q & 7;
        J.src = F.in[x ? I_LRUWX : I_LRUWA] + (((size_t)l * 2 + d) * 8 + nb) * 128 * 128; J.sld = 128; J.K = 128; J.N = 128; J.dst = (bf16_t*)(W + W_LRU) + (size_t)nb * 512 * 256; J.dld = 256; J.roff = d * 256 + x * 128; J.kd0 = (nb & 1) * 128; break; }
    }
    return J;
}
__device__ __forceinline__ int cvt_items(const CvtJob& J) { return ((J.K + 63) / 64) * (J.N / 32); }
__device__ __forceinline__ void zero_rect(Ctx& F, bf16_t* dst, int ld, int row0, int nrows, int k0, int nk) {
    const int per = nk / 8; const long tot = (long)nrows * per;
    for (long i = (long)blockIdx.x * 512 + F.tid; i < tot; i += (long)F.G * 512) { const int r = (int)(i / per), c = (int)(i % per);
        *(u32x4*)(dst + (size_t)(row0 + r) * ld + k0 + c * 8) = zero4(); }
}
__device__ __forceinline__ void ph_cvt_m(Ctx& F, int l, unsigned long long mask, int me = -2, int nw = -1, bool zf = true) {
    LAS float* scr = (LAS float*)(F.lds + F.wave * 18176);
    if (nw < 0) nw = F.NGW;
    if (me == -2) me = F.gw;
    if (me >= 0 && me < nw) { int base = 0;
        for (int j = 0; j < NCVT; ++j) { if (!((mask >> j) & 1ull)) continue;
            const CvtJob J = cvt_job(F, l, j); const int ni = cvt_items(J);
            int first = (me - base % nw + nw) % nw;
            for (int it = first; it < ni; it += 2 * nw) cvt_item2(J, it, it + nw < ni ? it + nw : -1, scr, F.lane);
            base += ni; } }
    if (!zf) return;
    unsigned char* W = F.ws + WS_W;
    zero_rect(F, (bf16_t*)(W + W_INA), 2048, OFF_GB, GB_ROW0 - OFF_GB, 0, 2048);
    zero_rect(F, (bf16_t*)(W + W_LORA), LORA_K, 0, 2048, 64, LORA_K - 64);
    zero_rect(F, (bf16_t*)(W + W_LORA), LORA_K, 2048, 2048, 0, 64);
    zero_rect(F, (bf16_t*)(W + W_LORA), LORA_K, 2048, 2048, 128, LORA_K - 128);
    zero_rect(F, (bf16_t*)(W + W_LORA), LORA_K, 4096, 1024, 0, 128);
    zero_rect(F, (bf16_t*)(W + W_LORA), LORA_K, 4096, 1024, 288, LORA_K - 288);
    for (int nb = 0; nb < 8; ++nb) zero_rect(F, (bf16_t*)(W + W_LRU) + (size_t)nb * 512 * 256, 256, 0, 512, (1 - (nb & 1)) * 128, 128);
}
__device__ __forceinline__ void ph_cvt(Ctx& F, int l, int j0 = 0, int j1 = NCVT, int me = -2, int nw = -1, bool zf = true) { ph_cvt_m(F, l, ((1ull << j1) - 1ull) & ~((1ull << j0) - 1ull), me, nw, zf); }
constexpr unsigned long long CVT_ALL = (1ull << NCVT) - 1ull;
#ifndef CVT_SPLIT
#define CVT_SPLIT 1
#endif
constexpr unsigned long long CVT_FFN0 = (1ull << 0) | (1ull << 1) | (1ull << 4);
constexpr unsigned long long CVT_EARLY = CVT_ALL & ~((1ull << 2) | (1ull << 3) | (1ull << 5) | (0xFull << 16)) & ~(CVT_SPLIT ? CVT_FFN0 : 0ull);
constexpr unsigned long long CVT_MID = (1ull << 2) | (1ull << 3) | (CVT_SPLIT ? (1ull << 0) | (1ull << 1) : 0ull);
constexpr unsigned long long CVT_LATE = (1ull << 5) | (0xFull << 16) | (CVT_SPLIT ? (1ull << 4) : 0ull);
__device__ __forceinline__ void ph_modr(Ctx& F) {
    const float* modp = (const float*)(F.ws + WS_R + R_MODP); float* mod = (float*)(F.ws + WS_MOD);
    for (int i = blockIdx.x * 512 + F.tid; i < 5 * 36864; i += F.G * 512) { const int r = i / 36864, cc = i % 36864, l = cc / 18432, c = cc % 18432;
        float s = F.in[I_ADAB][cc];
#pragma unroll
        for (int kc = 0; kc < MODP_KC; ++kc) s += modp[(size_t)kc * 5 * 36864 + i];
        mod[((size_t)l * 5 + r) * 18432 + c] = s; }
}
__device__ __forceinline__ void ph_h0(Ctx& F) {
    bf16_t* H = (bf16_t*)(F.ws + WS_H); const float* mod = (const float*)(F.ws + WS_MOD);
    LAS float* ptab_ = (LAS float*)F.lds;
    { for (int i = F.tid; i < 5 * 512; i += 512) { const int mr_ = i >> 9, c_ = i & 511;
          ((LAS f32x4*)ptab_)[i] = ((const f32x4*)(mod + (size_t)mr_ * 18432 + 2048))[c_] + 1.0f; ((LAS f32x4*)ptab_)[2560 + i] = ((const f32x4*)(mod + (size_t)mr_ * 18432))[c_]; }
      __syncthreads(); }
    for (int n0 = F.gw; n0 < M; n0 += 3 * F.NGW) { f32x4 v[3][8];
#pragma unroll
        for (int u = 0; u < 3; ++u) { const int n = n0 + u * F.NGW < M ? n0 + u * F.NGW : n0; const int b_ = n / TPB, j_ = n % TPB;
            const float* src = j_ < CTX ? F.in[I_CTX] + ((size_t)b_ * CTX + j_) * D : F.in[I_X] + ((size_t)b_ * SEQ + (j_ - CTX)) * D;
#pragma unroll
            for (int j = 0; j < 8; ++j) v[u][j] = *(const f32x4*)(src + 4 * F.lane + 256 * j); }
#pragma unroll
        for (int u = 0; u < 3; ++u) { const int n = n0 + u * F.NGW; if (n >= M) break; const int mr = (n % TPB) < CTX ? 4 : n / TPB;
            int lo_ = 0; asm volatile("" : "+v"(lo_)); LAS const float* psc = ptab_ + lo_ + 4 * F.lane + mr * 2048; LAS const float* psh = psc + 5 * 2048;
#pragma unroll
            for (int j = 0; j < 8; ++j) { const int c = 4 * F.lane + 256 * j; const f32x4 y = v[u][j] * *(LAS const f32x4*)(psc + 256 * j) + *(LAS const f32x4*)(psh + 256 * j);
                u32x2 w; w.x = cvt_pk_bf16(y[0], y[1]); w.y = cvt_pk_bf16(y[2], y[3]); *(u32x2*)(H + (size_t)n * D + c) = w; } } }
}
#ifndef LN_NR
#define LN_NR 3
#endif
template <bool final_>
__device__ __forceinline__ void ph_ln_t(Ctx& F, const float* g, const float* b, const float* modl  , int sh_chunk, int sc_chunk, bool skip_ctx,
                                      const float* part, const float* pg, float pcoef, int previd) {
    float* X = (float*)(F.ws + WS_X); bf16_t* H = (bf16_t*)(F.ws + WS_H); float* ST = (float*)(F.ws + WS_STATS); const float* PL = (const float*)(F.ws + WS_LNT) + previd * 4096;
    LAS float* ptab_ = (LAS float*)F.lds;
    { for (int i = F.tid; i < 512; i += 512) { ((LAS f32x4*)ptab_)[i] = ((const f32x4*)g)[i]; ((LAS f32x4*)ptab_)[512 + i] = ((const f32x4*)b)[i]; }
      if (!final_) for (int i = F.tid; i < 5 * 512; i += 512) { const int mr_ = i >> 9, c_ = i & 511;
          ((LAS f32x4*)ptab_)[1024 + i] = ((const f32x4*)(modl + (size_t)mr_ * 18432 + sc_chunk * 2048))[c_] + 1.0f; ((LAS f32x4*)ptab_)[1024 + 2560 + i] = ((const f32x4*)(modl + (size_t)mr_ * 18432 + sh_chunk * 2048))[c_]; }
      __syncthreads(); }
    if (!final_ && part) {
        for (int n = F.gw; n < M; n += F.NGW) { const int bb = n / TPB, j0 = n % TPB; if (j0 >= CTX) continue;
            const float* pr = part + ((size_t)bb * 256 + j0) * D + 4 * F.lane; const float pmu = ST[2 * n], prs = ST[2 * n + 1]; const float pnm = -pmu * prs;
            const float* xs = previd == 0 ? F.in[I_CTX] + ((size_t)bb * CTX + j0) * D : X + (size_t)n * D;
#pragma unroll
            for (int j = 0; j < 8; ++j) { const int c = 4 * F.lane + 256 * j; f32x4 a = *(const f32x4*)(pr + 256 * j); const f32x4 x = *(const f32x4*)(xs + c);
#pragma unroll
                for (int sidx = 1; sidx < 4; ++sidx) a += *(const f32x4*)(pr + (size_t)sidx * 1024 * D + 256 * j);
                *(f32x4*)(X + (size_t)n * D + c) = ((x * prs + pnm) * *(const f32x4*)(PL + c) + *(const f32x4*)(PL + 2048 + c)) * ALPHA + a * (*(const f32x4*)(pg + 4 * 18432 + c) * pcoef); } }
        VM_WAIT(); }
    auto load2 = [&](f32x4 (&vv)[LN_NR][8], int n0) {
#pragma unroll
        for (int u = 0; u < LN_NR; ++u) { const int n = n0 + u * F.NGW; const int j0 = n % TPB; const bool on = n < M && !((final_ || skip_ctx) && j0 < CTX); const int nc = on ? n : n0 % M;
#pragma unroll
            for (int j = 0; j < 8; ++j) vv[u][j] = *(const f32x4*)(X + (size_t)nc * D + 4 * F.lane + 256 * j); } };
    auto proc2 = [&](f32x4 (&vv)[LN_NR][8], int n0) {
#pragma unroll
        for (int u = 0; u < LN_NR; ++u) { const int n = n0 + u * F.NGW; if (n >= M) continue; const int bb = n / TPB, j0 = n % TPB; if ((final_ || skip_ctx) && j0 < CTX) continue; const int mr = j0 < CTX ? 4 : bb;
        f32x4 (&v)[8] = vv[u]; float s = 0.f;
#pragma unroll
        for (int j = 0; j < 8; ++j) s += (v[j][0] + v[j][1]) + (v[j][2] + v[j][3]);
        const float mean = wave_sum(s) * (1.f / D); float s2 = 0.f;
#pragma unroll
        for (int j = 0; j < 8; ++j) { v[j] = v[j] - mean; s2 += (v[j][0] * v[j][0] + v[j][1] * v[j][1]) + (v[j][2] * v[j][2] + v[j][3] * v[j][3]); }
        const float rstd = __builtin_amdgcn_rsqf(wave_sum(s2) * (1.f / D) + LN_EPS);
        if (!final_ && F.lane == 0) { ST[2 * n] = mean; ST[2 * n + 1] = rstd; }
        int lo_ = 0; asm volatile("" : "+v"(lo_)); LAS const float* pt = ptab_ + lo_ + 4 * F.lane;
        LAS const float* psc = pt + 4096 + mr * 2048; LAS const float* psh = psc + 5 * 2048;
#pragma unroll
        for (int j = 0; j < 8; ++j) { const int c = 4 * F.lane + 256 * j; const f32x4 y = v[j] * rstd * *(LAS const f32x4*)(pt + 256 * j) + *(LAS const f32x4*)(pt + 2048 + 256 * j);
            if (final_) { *(f32x4*)(F.out + ((size_t)bb * SEQ + (j0 - CTX)) * D + c) = y; }
            else { const f32x4 h = y * *(LAS const f32x4*)(psc + 256 * j) + *(LAS const f32x4*)(psh + 256 * j);
                u32x2 w; w.x = cvt_pk_bf16(h[0], h[1]); w.y = cvt_pk_bf16(h[2], h[3]); *(u32x2*)(H + (size_t)n * D + c) = w; } } } };
    const int step = LN_NR * F.NGW; int n0 = F.gw;
    if (n0 < M) { f32x4 va[LN_NR][8], vb[LN_NR][8];
        load2(va, n0);
        for (;;) {
            const int n1 = n0 + step; if (n1 < M) load2(vb, n1);
            proc2(va, n0); if (n1 >= M) break;
            const int n2 = n1 + step; if (n2 < M) load2(va, n2);
            proc2(vb, n1); if (n2 >= M) break;
            n0 = n2; } }
}
__device__ __forceinline__ void ph_ln(Ctx& F, const float* g, const float* b, const float* modl, int sh_chunk, int sc_chunk, bool final_, bool skip_ctx = false,
                                      const float* part = nullptr, const float* pg = nullptr, float pcoef = 0.f, int previd = 0) {
    if (final_) ph_ln_t<true>(F, g, b, modl, sh_chunk, sc_chunk, skip_ctx, nullptr, pg, pcoef, previd);
    else ph_ln_t<false>(F, g, b, modl, sh_chunk, sc_chunk, skip_ctx, part, pg, pcoef, previd);
}
#ifndef DBG_RW_D0
#define DBG_RW_D0 1.0f
#endif
#ifndef DBG_RW_D1
#define DBG_RW_D1 1.0f
#endif
#ifndef DBG_LRU_D0
#define DBG_LRU_D0 1.0f
#endif
#ifndef DBG_LRU_D1
#define DBG_LRU_D1 1.0f
#endif
__device__ __forceinline__ void unpack8(const u32x4 w, float (&x)[8]) { x[0] = bf_lo(w.x); x[1] = bf_hi(w.x); x[2] = bf_lo(w.y); x[3] = bf_hi(w.y); x[4] = bf_lo(w.z); x[5] = bf_hi(w.z); x[6] = bf_lo(w.w); x[7] = bf_hi(w.w); }
__device__ __forceinline__ u32x4 pack8(const float (&x)[8]) { u32x4 w; w.x = cvt_pk_bf16(x[0], x[1]); w.y = cvt_pk_bf16(x[2], x[3]); w.z = cvt_pk_bf16(x[4], x[5]); w.w = cvt_pk_bf16(x[6], x[7]); return w; }
__device__ __forceinline__ int seq_j(int dir, int p) { return dir == 0 ? p : (p < CTX ? (CTX - 1 - p) : (TPB + CTX - 1 - p)); }

__device__ __forceinline__ float dpp_red8(float x) {
    x += __builtin_bit_cast(float, __builtin_amdgcn_update_dpp(0, __builtin_bit_cast(int, x), 0xB1, 0xF, 0xF, true));
    x += __builtin_bit_cast(float, __builtin_amdgcn_update_dpp(0, __builtin_bit_cast(int, x), 0x4E, 0xF, 0xF, true));
    x += __builtin_bit_cast(float, __builtin_amdgcn_update_dpp(0, __builtin_bit_cast(int, x), 0x141, 0xF, 0xF, true));
    return x;
}
__device__ __forceinline__ void ph_prep(Ctx& F, int l) {
    const bf16_t* FAp = (const bf16_t*)(F.ws + WS_R + R_FA);
    bf16_t* LIN = (bf16_t*)(F.ws + WS_R + R_LIN); bf16_t* RKV = (bf16_t*)(F.ws + WS_R + R_RKV); bf16_t* XC = (bf16_t*)(F.ws + WS_R + R_XC);
    bf16_t* QL = (bf16_t*)(F.ws + WS_R + R_QL); bf16_t* KVC = (bf16_t*)(F.ws + WS_R + R_KVC); bf16_t* KR = (bf16_t*)(F.ws + WS_R + R_KR);
    const float* mu = F.in[I_MU] + (size_t)l * RW_IN; const float* qn = F.in[I_QNORM] + (size_t)l * 512; const float* kvn = F.in[I_KVNORM] + (size_t)l * 256;
    float* KKN = (float*)(F.ws + WS_R + R_KKN); const float* kkp = F.in[I_KK] + (size_t)l * 1024;
    const float* cw = F.in[I_CONVW] + (size_t)l * 4 * 1024; const float* cb = F.in[I_CONVB] + (size_t)l * 1024; const float* rope = (const float*)(F.ws + WS_ROPE);
    const int lane = F.lane;
    {
        f32x4 mreg[7][2];
#pragma unroll
        for (int it = 0; it < 7; ++it) { const int ch = lane + 64 * it; const int chc = ch < 420 ? ch : 0; mreg[it][0] = *(const f32x4*)(mu + chc * 8); mreg[it][1] = *(const f32x4*)(mu + chc * 8 + 4); }
        f32x4 kkr[2][2];
#pragma unroll
        for (int it = 0; it < 2; ++it) { kkr[it][0] = *(const f32x4*)(kkp + (lane + 64 * it) * 8); kkr[it][1] = *(const f32x4*)(kkp + (lane + 64 * it) * 8 + 4); }
        for (int n = F.gw; n < M; n += F.NGW) {
            const int j = n % TPB; const bool isctx = j < CTX; const int t = j - CTX;
            int nb0, nb1, nb2, nb3;
            if (isctx) { nb0 = j > 0 ? n - 1 : -1; nb1 = j < CTX - 1 ? n + 1 : -1; nb2 = nb0; nb3 = nb1; }
            else { const int gc = t & 63, gr = t >> 6; nb0 = gc > 0 ? n - 1 : -1; nb1 = gc < 63 ? n + 1 : -1; nb2 = gr > 0 ? n - 64 : -1; nb3 = gr < 63 ? n + 64 : -1; }
            const bf16_t* Fr = FAp + (size_t)n * FA_PAD;
            u32x4 ow[7], sw[7];
#pragma unroll
            for (int it = 0; it < 7; ++it) { const int ch = lane + 64 * it; const int chc = ch < 420 ? ch : 0; const int q = chc / 105; const int nb = q == 0 ? nb0 : (q == 1 ? nb1 : (q == 2 ? nb2 : nb3));
                ow[it] = *(const u32x4*)(Fr + chc * 8); sw[it] = *(const u32x4*)(FAp + (size_t)(nb >= 0 ? nb : n) * FA_PAD + chc * 8); { const unsigned mk = nb >= 0 ? 0xffffffffu : 0u; sw[it].x &= mk; sw[it].y &= mk; sw[it].z &= mk; sw[it].w &= mk; } }
#pragma unroll
            for (int it = 0; it < 7; ++it) { const int ch = lane + 64 * it; if (ch >= 420) break;
                float own[8], sh[8], f[8]; unpack8(ow[it], own); unpack8(sw[it], sh);
#pragma unroll
                for (int i = 0; i < 8; ++i) { const float mm = i < 4 ? mreg[it][0][i] : mreg[it][1][i - 4]; f[i] = own[i] + (sh[i] - own[i]) * mm; }
                if (it == 2 || it == 3) { float ss = 0.f;
#pragma unroll
                    for (int i = 0; i < 8; ++i) { const float kv = f[i] * (i < 4 ? kkr[it - 2][0][i] : kkr[it - 2][1][i - 4]); ss += kv * kv; }
                    ss = dpp_red8(ss); if ((lane & 7) == 0) KKN[(size_t)n * 16 + ((ch - 128) >> 3)] = fminf(__builtin_amdgcn_rsqf(ss), 1e12f); }
                if (ch < 384) { *(u32x4*)(RKV + (size_t)n * 3072 + ch * 8) = pack8(f); }
                else if (ch < 392) {
#pragma unroll
                    for (int i = 0; i < 8; ++i) { const float e2 = __expf(2.0f * f[i]); f[i] = 1.0f - 2.0f * __builtin_amdgcn_rcpf(e2 + 1.0f); }
                    *(u32x4*)(LIN + (size_t)n * LORA_K + (ch - 384) * 8) = pack8(f); }
                else if (ch < 400) { *(u32x4*)(LIN + (size_t)n * LORA_K + 64 + (ch - 392) * 8) = pack8(f); }
                else {
#pragma unroll
                    for (int i = 0; i < 8; ++i) f[i] = __builtin_amdgcn_rcpf(1.0f + __expf(-f[i]));
                    *(u32x4*)(LIN + (size_t)n * LORA_K + 128 + (ch - 400) * 8) = pack8(f); }
            }
            if (lane < 12) *(u32x4*)(LIN + (size_t)n * LORA_K + 288 + lane * 8) = zero4();
        }
    }
    {
        const int ll = lane & 31;
        f32x4 qg[2], kg[2], cwr[2][4][2], cbr[2][2];
        qg[0] = *(const f32x4*)(qn + lane * 8); qg[1] = *(const f32x4*)(qn + lane * 8 + 4); kg[0] = *(const f32x4*)(kvn + ll * 8); kg[1] = *(const f32x4*)(kvn + ll * 8 + 4);
#pragma unroll
        for (int it = 0; it < 2; ++it) { const int c0 = (lane + 64 * it) * 8; cbr[it][0] = *(const f32x4*)(cb + c0); cbr[it][1] = *(const f32x4*)(cb + c0 + 4);
#pragma unroll
            for (int jj = 0; jj < 4; ++jj) { cwr[it][jj][0] = *(const f32x4*)(cw + jj * 1024 + c0); cwr[it][jj][1] = *(const f32x4*)(cw + jj * 1024 + c0 + 4); } }
        for (int n = F.gw; n < M; n += F.NGW) {
            const int j = n % TPB; const bool isctx = j < CTX; const int t = j - CTX; const bf16_t* Fr = FAp + (size_t)n * FA_PAD;
            const int spos = isctx ? j : t, slen = isctx ? CTX : SEQ;
            const u32x4 qw = *(const u32x4*)(Fr + OFF_QLAT + lane * 8), kw = *(const u32x4*)(Fr + OFF_KVLAT + ll * 8), rw = *(const u32x4*)(Fr + OFF_KROPE + (lane & 7) * 8);
            u32x4 xw[2][4];
#pragma unroll
            for (int it = 0; it < 2; ++it) { const int c0 = (lane + 64 * it) * 8;
#pragma unroll
                for (int jj = 0; jj < 4; ++jj) { const int pos = spos - 2 + jj; const bool ok = pos >= 0 && pos < slen; xw[it][jj] = *(const u32x4*)(FAp + (size_t)(ok ? n - 2 + jj : n) * FA_PAD + OFF_XR + c0); { const unsigned mk = ok ? 0xffffffffu : 0u; xw[it][jj].x &= mk; xw[it][jj].y &= mk; xw[it][jj].z &= mk; xw[it][jj].w &= mk; } } }
            f32x4 cs0 = {1.f, 0.f, 1.f, 0.f}, cs1 = cs0;
            if (!isctx) { const f32x4* cs = (const f32x4*)(rope + ((size_t)t * 32 + (lane & 7) * 4) * 2); cs0 = cs[0]; cs1 = cs[1]; }
            { float x[8]; unpack8(qw, x); float ss = 0.f;
#pragma unroll
              for (int i = 0; i < 8; ++i) ss += x[i] * x[i];
              const float r = __builtin_amdgcn_rsqf(wave_sum(ss) * (1.f / 512.f) + LN_EPS);
#pragma unroll
              for (int i = 0; i < 8; ++i) x[i] = x[i] * r * (i < 4 ? qg[0][i] : qg[1][i - 4]);
              *(u32x4*)(QL + (size_t)n * 512 + lane * 8) = pack8(x); }
            { float x[8]; unpack8(kw, x); float ss = 0.f;
#pragma unroll
              for (int i = 0; i < 8; ++i) ss += x[i] * x[i];
              if (lane >= 32) ss = 0.f;
              const float r = __builtin_amdgcn_rsqf(wave_sum(ss) * (1.f / 256.f) + LN_EPS);
#pragma unroll
              for (int i = 0; i < 8; ++i) x[i] = x[i] * r * (i < 4 ? kg[0][i] : kg[1][i - 4]);
              if (lane < 32) *(u32x4*)(KVC + (size_t)n * 256 + ll * 8) = pack8(x); }
            if (lane < 8) { float x[8], y[8]; unpack8(rw, x);
                y[0] = x[0] * cs0[0] - x[1] * cs0[1]; y[1] = x[0] * cs0[1] + x[1] * cs0[0]; y[2] = x[2] * cs0[2] - x[3] * cs0[3]; y[3] = x[2] * cs0[3] + x[3] * cs0[2];
                y[4] = x[4] * cs1[0] - x[5] * cs1[1]; y[5] = x[4] * cs1[1] + x[5] * cs1[0]; y[6] = x[6] * cs1[2] - x[7] * cs1[3]; y[7] = x[6] * cs1[3] + x[7] * cs1[2];
                *(u32x4*)(KR + (size_t)n * 64 + lane * 8) = pack8(y); }
#pragma unroll
            for (int it = 0; it < 2; ++it) { const int c0 = (lane + 64 * it) * 8; float acc[8];
#pragma unroll
                for (int i = 0; i < 8; ++i) acc[i] = i < 4 ? cbr[it][0][i] : cbr[it][1][i - 4];
#pragma unroll
                for (int jj = 0; jj < 4; ++jj) { float x[8]; unpack8(xw[it][jj], x);
#pragma unroll
                    for (int i = 0; i < 8; ++i) acc[i] += x[i] * (i < 4 ? cwr[it][jj][0][i] : cwr[it][jj][1][i - 4]); }
                *(u32x4*)(XC + (size_t)n * 1024 + c0) = pack8(acc); }
        }
    }
}
constexpr int SC_T = 32, SC_STEP = 352  , SC_BUF = SC_T * SC_STEP, SC_NCH = TPB / SC_T;
__device__ __forceinline__ float wave_sum_fast(float x) {
    x = dpp_red8(x);
    x += __builtin_bit_cast(float, __builtin_amdgcn_update_dpp(0, __builtin_bit_cast(int, x), 0x140, 0xF, 0xF, true));
    { auto r = __builtin_amdgcn_permlane16_swap(__float_as_uint(x), __float_as_uint(x), false, false); x = __uint_as_float(r[0]) + __uint_as_float(r[1]); }
    { auto r = __builtin_amdgcn_permlane32_swap(__float_as_uint(x), __float_as_uint(x), false, false); x = __uint_as_float(r[0]) + __uint_as_float(r[1]); }
    return x;
}
struct ScOps { f32x4 d0, d1, k0, k1, a0, a1, m0, m1, r0, r1; float vv; };
__device__ __forceinline__ void sc_load(ScOps& o, const LAS float* p, const LAS float* pv) {
    o.d0 = *(const LAS f32x4*)(p); o.d1 = *(const LAS f32x4*)(p + 4); o.k0 = *(const LAS f32x4*)(p + 64); o.k1 = *(const LAS f32x4*)(p + 68);
    o.a0 = *(const LAS f32x4*)(p + 128); o.a1 = *(const LAS f32x4*)(p + 132); o.m0 = *(const LAS f32x4*)(p + 192); o.m1 = *(const LAS f32x4*)(p + 196);
    o.r0 = *(const LAS f32x4*)(p + 256); o.r1 = *(const LAS f32x4*)(p + 260); o.vv = *pv;
}
__device__ __forceinline__ float sc_step(const ScOps& o, f32x2& s0, f32x2& s1, f32x2& s2, f32x2& s3) {
    const f32x2 p0 = s0 * (f32x2){o.k0[0], o.k0[1]} + s1 * (f32x2){o.k0[2], o.k0[3]}, p1 = s2 * (f32x2){o.k1[0], o.k1[1]} + s3 * (f32x2){o.k1[2], o.k1[3]};
    const f32x2 acc = p0 + p1; const float sa = dpp_red8(acc[0] + acc[1]);
    s0 = s0 * (f32x2){o.d0[0], o.d0[1]} - sa * (f32x2){o.a0[0], o.a0[1]} + o.vv * (f32x2){o.m0[0], o.m0[1]};
    s1 = s1 * (f32x2){o.d0[2], o.d0[3]} - sa * (f32x2){o.a0[2], o.a0[3]} + o.vv * (f32x2){o.m0[2], o.m0[3]};
    s2 = s2 * (f32x2){o.d1[0], o.d1[1]} - sa * (f32x2){o.a1[0], o.a1[1]} + o.vv * (f32x2){o.m1[0], o.m1[1]};
    s3 = s3 * (f32x2){o.d1[2], o.d1[3]} - sa * (f32x2){o.a1[2], o.a1[3]} + o.vv * (f32x2){o.m1[2], o.m1[3]};
    const f32x2 y0 = s0 * (f32x2){o.r0[0], o.r0[1]} + s1 * (f32x2){o.r0[2], o.r0[3]}, y1 = s2 * (f32x2){o.r1[0], o.r1[1]} + s3 * (f32x2){o.r1[2], o.r1[3]};
    const f32x2 ya = y0 + y1; return ya[0] + ya[1];
}
__device__ __forceinline__ void ph_rwkv_scan(Ctx& F, int l) {
    const bf16_t* RKV = (const bf16_t*)(F.ws + WS_R + R_RKV); const bf16_t* LO = (const bf16_t*)(F.ws + WS_R + R_LO); bf16_t* YS = (bf16_t*)(F.ws + WS_R + R_YS);
    LAS float* OP = (LAS float*)F.lds; LAS float* YB = (LAS float*)(F.lds + 2 * SC_BUF * 4);
    const int lane = F.lane, wave = F.wave;
    for (int item = F.vcu; item < 256; item += F.G) {
        const int vhalf = item & 1, dir = (item >> 1) & 1, h = (item >> 2) & 15, b = item >> 6;
        const int ch = h * 64 + lane; const size_t nb0 = (size_t)b * TPB;
        if (wave >= 4) {
            const float kkc = F.in[I_KK][(size_t)l * 1024 + ch], kac = F.in[I_KA][(size_t)l * 1024 + ch];
            const int sw = wave - 4, st = F.tid - 256; const float* KKN = (const float*)(F.ws + WS_R + R_KKN);
            bf16_t vr[8], vk[8], vv[8], vw[8], va[8]; float vn[8];
#define SC_FETCH(cn) do { _Pragma("unroll") for (int q = 0; q < 8; ++q) { const size_t n = nb0 + seq_j(dir, (cn) * SC_T + sw * 8 + q); \
                vr[q] = RKV[n * 3072 + ch]; vk[q] = RKV[n * 3072 + 1024 + ch]; vv[q] = RKV[n * 3072 + 2048 + ch]; vw[q] = LO[n * LORA_N + dir * 1024 + ch]; va[q] = LO[n * LORA_N + 2048 + dir * 1024 + ch]; vn[q] = KKN[n * 16 + h]; } } while (0)
            SC_FETCH(0);
            for (int ci = -1; ci < SC_NCH; ++ci) {
                if (ci + 1 < SC_NCH) { const int cn = ci + 1; LAS float* ob = OP + (cn & 1) * SC_BUF;
                    float fr[8], fk[8], fv[8], fw[8], fa[8], fn[8];
#pragma unroll
                    for (int q = 0; q < 8; ++q) { fr[q] = bf2f(vr[q]); fk[q] = bf2f(vk[q]); fv[q] = bf2f(vv[q]); fw[q] = bf2f(vw[q]); fa[q] = bf2f(va[q]); fn[q] = vn[q]; }
                    if (cn + 1 < SC_NCH) SC_FETCH(cn + 1);
#pragma unroll
                    for (int q = 0; q < 8; ++q) { const int s = sw * 8 + q; LAS float* o = ob + s * SC_STEP;
                        const float kx = fk[q]; const float kk = kx * kkc * fn[q];
                        const float dec = __expf(-0.60653065971263342f * fw[q]);
                        const float a = fa[q]; const float km = kx * (1.0f + (a - 1.0f) * kac);
                        o[lane] = dec; o[64 + lane] = kk; o[128 + lane] = a * kk; o[192 + lane] = km; o[256 + lane] = fr[q];
                        if ((lane >> 5) == vhalf) o[320 + (lane & 31)] = fv[q]; } }
                if (ci >= 1) { const int cp = ci - 1; const LAS float* yb = YB + (cp & 1) * (SC_T * 32); const int s = st >> 3, i0 = (st & 7) * 4;
                    const size_t n = nb0 + seq_j(dir, cp * SC_T + s); const f32x4 y = *(const LAS f32x4*)(yb + s * 32 + i0);
                    u32x2 w; w.x = cvt_pk_bf16(y[0], y[1]); w.y = cvt_pk_bf16(y[2], y[3]);
                    *(u32x2*)(YS + ((size_t)dir * M + n) * 1024 + h * 64 + vhalf * 32 + i0) = w; }
                LDS_WAIT(); __builtin_amdgcn_s_barrier(); asm volatile("" ::: "memory");
            }
#undef SC_FETCH
            { const int cp = SC_NCH - 1; const LAS float* yb = YB + (cp & 1) * (SC_T * 32); const int s = st >> 3, i0 = (st & 7) * 4;
                const size_t n = nb0 + seq_j(dir, cp * SC_T + s); const f32x4 y = *(const LAS f32x4*)(yb + s * 32 + i0);
                u32x2 w; w.x = cvt_pk_bf16(y[0], y[1]); w.y = cvt_pk_bf16(y[2], y[3]);
                *(u32x2*)(YS + ((size_t)dir * M + n) * 1024 + h * 64 + vhalf * 32 + i0) = w; }
        } else {
            const int rl = lane >> 3, c = lane & 7, rowl = wave * 8 + rl;
            f32x2 s0 = {0.f, 0.f}, s1 = s0, s2 = s0, s3 = s0;
            __builtin_amdgcn_s_barrier(); asm volatile("" ::: "memory");
            for (int ci = 0; ci < SC_NCH; ++ci) { const LAS float* ob = OP + (ci & 1) * SC_BUF + 8 * c; const LAS float* vb = OP + (ci & 1) * SC_BUF + 320 + rowl; LAS float* yb = YB + (ci & 1) * (SC_T * 32) + rowl;
                ScOps A, B; sc_load(A, ob, vb);
#pragma unroll 1
                for (int s8 = 0; s8 < SC_T; s8 += 8) { float ys[8];
#pragma unroll
                    for (int q = 0; q < 8; q += 2) { const int s = s8 + q;
                        sc_load(B, ob + (s + 1) * SC_STEP, vb + (s + 1) * SC_STEP);
                        ys[q] = sc_step(A, s0, s1, s2, s3);
                        if (s + 2 < SC_T) sc_load(A, ob + (s + 2) * SC_STEP, vb + (s + 2) * SC_STEP);
                        ys[q + 1] = sc_step(B, s0, s1, s2, s3); }
#pragma unroll
                    for (int q = 0; q < 8; ++q) ys[q] = dpp_red8(ys[q]);
                    if (c == 0) {
#pragma unroll
                        for (int q = 0; q < 8; ++q) yb[(s8 + q) * 32] = ys[q]; } }
                LDS_WAIT(); __builtin_amdgcn_s_barrier(); asm volatile("" ::: "memory");
            }
        }
        __syncthreads();
    }
}
__device__ __forceinline__ void rwkv_readout_half(const u32x4 y0w, const u32x4 y1w, const u32x4 rw, const u32x4 kw, const u32x4 vw, const u32x4 a0w, const u32x4 a1w, const u32x4 gw_,
                                                  const float (&lg)[8], const float (&lb)[8], const float (&rk)[8], const float (&ka)[8], const float (&a00)[8], const float (&a01)[8], bf16_t* dst) {
    float y0[8], y1[8], r[8], k[8], v[8], al0[8], al1[8], g[8], y[8], o[8];
    unpack8(y0w, y0); unpack8(y1w, y1); unpack8(rw, r); unpack8(kw, k); unpack8(vw, v); unpack8(a0w, al0); unpack8(a1w, al1); unpack8(gw_, g);
    float s = 0.f;
#pragma unroll
    for (int i = 0; i < 8; ++i) { y[i] = DBG_RW_D0 * y0[i] + DBG_RW_D1 * y1[i]; s += y[i]; }
    const float mu_ = dpp_red8(s) * (1.f / 64.f); float q = 0.f, bp = 0.f;
#pragma unroll
    for (int i = 0; i < 8; ++i) { y[i] -= mu_; q += y[i] * y[i];
        const float a_0 = al0[i], a_1 = al1[i];
        const float kb = k[i] * (1.0f + (0.5f * (a_0 + a_1) - 1.0f) * ka[i]); bp += r[i] * kb * rk[i]; }
    const float rstd = __builtin_amdgcn_rsqf(dpp_red8(q) * (1.f / 64.f) + GN_EPS); const float bonus = dpp_red8(bp);
#pragma unroll
    for (int i = 0; i < 8; ++i) o[i] = (y[i] * rstd * lg[i] + lb[i] + bonus * v[i]) * g[i];
    *(u32x4*)dst = pack8(o);
}
__device__ __forceinline__ void ph_rwkv_readout(Ctx& F, int l) {
    const bf16_t* RKV = (const bf16_t*)(F.ws + WS_R + R_RKV); const bf16_t* LO = (const bf16_t*)(F.ws + WS_R + R_LO); const bf16_t* YS = (const bf16_t*)(F.ws + WS_R + R_YS);
    bf16_t* YC = (bf16_t*)(F.ws + WS_YCAT);
    const int half = F.gw & 1, c0 = half * 512 + F.lane * 8;
    float lg[8], lb[8], rk[8], ka[8], a00[8], a01[8];
#pragma unroll
    for (int i = 0; i < 8; ++i) { lg[i] = F.in[I_LNXG][(size_t)l * 1024 + c0 + i]; lb[i] = F.in[I_LNXB][(size_t)l * 1024 + c0 + i]; rk[i] = F.in[I_RK][(size_t)l * 1024 + c0 + i];
        ka[i] = F.in[I_KA][(size_t)l * 1024 + c0 + i]; a00[i] = F.in[I_A0][(size_t)l * 2048 + c0 + i]; a01[i] = F.in[I_A0][(size_t)l * 2048 + 1024 + c0 + i]; }
    const int NW2 = F.NGW >> 1;
    for (int n = F.gw >> 1; n < M; n += 2 * NW2) { const int n2 = n + NW2; const bool two = n2 < M; const size_t m2 = two ? n2 : n;
        const u32x4 y0a = *(const u32x4*)(YS + (size_t)n * 1024 + c0), y1a = *(const u32x4*)(YS + ((size_t)M + n) * 1024 + c0), ra = *(const u32x4*)(RKV + (size_t)n * 3072 + c0), ka_ = *(const u32x4*)(RKV + (size_t)n * 3072 + 1024 + c0),
                    va = *(const u32x4*)(RKV + (size_t)n * 3072 + 2048 + c0), a0a = *(const u32x4*)(LO + (size_t)n * LORA_N + 2048 + c0), a1a = *(const u32x4*)(LO + (size_t)n * LORA_N + 3072 + c0), ga = *(const u32x4*)(LO + (size_t)n * LORA_N + 4096 + c0);
        const u32x4 y0b = *(const u32x4*)(YS + m2 * 1024 + c0), y1b = *(const u32x4*)(YS + ((size_t)M + m2) * 1024 + c0), rb = *(const u32x4*)(RKV + m2 * 3072 + c0), kb_ = *(const u32x4*)(RKV + m2 * 3072 + 1024 + c0),
                    vb = *(const u32x4*)(RKV + m2 * 3072 + 2048 + c0), a0b = *(const u32x4*)(LO + m2 * LORA_N + 2048 + c0), a1b = *(const u32x4*)(LO + m2 * LORA_N + 3072 + c0), gb = *(const u32x4*)(LO + m2 * LORA_N + 4096 + c0);
        rwkv_readout_half(y0a, y1a, ra, ka_, va, a0a, a1a, ga, lg, lb, rk, ka, a00, a01, YC + (size_t)n * 4096 + c0);
        if (two) rwkv_readout_half(y0b, y1b, rb, kb_, vb, a0b, a1b, gb, lg, lb, rk, ka, a00, a01, YC + m2 * 4096 + c0);
    }
}
constexpr int LR_CL = 34, LR_NC = TPB / LR_CL;
__device__ __forceinline__ float one_minus_exp(float x) {
    const float p = -x * (1.0f + x * (0.5f + x * (0.16666667f + x * 0.041666668f))); const float e = 1.0f - __expf(x); return x > -0.06f ? p : e;
}
template <int NB, bool PASS2>
__device__ __forceinline__ void lru_batch(bf16_t* GT, const bf16_t* XC, size_t nb0, int dir, int p0, int gcol, int c0, const float (&sp8)[8], const float (&ba)[8], const float (&bx)[8], float (&A)[8], float (&hh)[8], bool store) {
    u32x4 gr[NB], gi[NB], xx[NB];
#pragma unroll
    for (int q = 0; q < NB; ++q) { const size_t n = nb0 + seq_j(dir, p0 + q); gr[q] = *(const u32x4*)(GT + n * 4096 + gcol); gi[q] = *(const u32x4*)(GT + n * 4096 + gcol + 128); xx[q] = *(const u32x4*)(XC + n * 1024 + c0); }
#pragma unroll
    for (int q = 0; q < NB; ++q) { float r[8], ii[8], x[8], o[8]; unpack8(gr[q], r); unpack8(gi[q], ii); unpack8(xx[q], x);
#pragma unroll
        for (int i = 0; i < 8; ++i) {
            const float dr = 1.0f + __expf(fminf(-(r[i] + ba[i]), 40.f)), di = 1.0f + __expf(fminf(-(ii[i] + bx[i]), 40.f)); const float rc = __builtin_amdgcn_rcpf(dr * di);
            const float g_r = di * rc, g_i = dr * rc;
            const float la = sp8[i] * g_r; const float a = __expf(la); const float x2 = 2.0f * la;
            const float om = x2 > -0.06f ? -x2 * (1.0f + x2 * (0.5f + x2 * (0.16666667f + x2 * 0.041666668f))) : 1.0f - a * a;
            const float bb = __builtin_amdgcn_sqrtf(om) * g_i * x[i];
            if (!PASS2) A[i] *= a; hh[i] = a * hh[i] + bb; o[i] = hh[i]; }
        if (PASS2 && store) *(u32x4*)(GT + (nb0 + seq_j(dir, p0 + q)) * 4096 + gcol) = pack8(o);
        __builtin_amdgcn_sched_barrier(0); }
}
__device__ __forceinline__ void ph_lru_scan(Ctx& F, int l, bool store = true) {
    bf16_t* GT = (bf16_t*)(F.ws + WS_R + R_GT); const bf16_t* XC = (const bf16_t*)(F.ws + WS_R + R_XC);
    LAS float* agg = (LAS float*)F.lds;
    for (int item = F.vcu; item < 256; item += F.G) {
        const int cg = item & 31, dir = (item >> 5) & 1, b = item >> 6; const int tc = F.tid >> 2, o = F.tid & 3, c0 = cg * 32 + o * 8, blk = c0 >> 7, e0 = c0 & 127;
        float sp8[8], ba[8], bx[8];
#pragma unroll
        for (int i = 0; i < 8; ++i) { sp8[i] = -8.0f * softplusf_(-F.in[I_LAMBDA][((size_t)l * 2 + dir) * 1024 + c0 + i]); ba[i] = F.in[I_LRUBA][((size_t)l * 2 + dir) * 1024 + c0 + i]; bx[i] = F.in[I_LRUBX][((size_t)l * 2 + dir) * 1024 + c0 + i]; }
        const size_t nb0 = (size_t)b * TPB; const int gcol = blk * 512 + dir * 256 + e0; const int p0 = tc * LR_CL;
        float A[8], hh[8];
#pragma unroll
        for (int i = 0; i < 8; ++i) { A[i] = 1.f; hh[i] = 0.f; }
#pragma unroll 1
        for (int bb = 0; bb < 8; ++bb) lru_batch<4, false>(GT, XC, nb0, dir, p0 + 4 * bb, gcol, c0, sp8, ba, bx, A, hh, false);
        lru_batch<2, false>(GT, XC, nb0, dir, p0 + 32, gcol, c0, sp8, ba, bx, A, hh, false);
        { LAS float* ag = agg + (size_t)(tc * 4 + o) * 16;
          *(LAS f32x4*)(ag) = (f32x4){A[0], A[1], A[2], A[3]}; *(LAS f32x4*)(ag + 4) = (f32x4){A[4], A[5], A[6], A[7]}; *(LAS f32x4*)(ag + 8) = (f32x4){hh[0], hh[1], hh[2], hh[3]}; *(LAS f32x4*)(ag + 12) = (f32x4){hh[4], hh[5], hh[6], hh[7]}; }
        __syncthreads();
#pragma unroll
        for (int i = 0; i < 8; ++i) hh[i] = 0.f;
        for (int i = 0; i < tc; ++i) { const LAS float* ag = agg + (size_t)(i * 4 + o) * 16; const f32x4 a0 = *(const LAS f32x4*)(ag), a1 = *(const LAS f32x4*)(ag + 4), h0 = *(const LAS f32x4*)(ag + 8), h1 = *(const LAS f32x4*)(ag + 12);
#pragma unroll
            for (int j = 0; j < 4; ++j) { hh[j] = a0[j] * hh[j] + h0[j]; hh[4 + j] = a1[j] * hh[4 + j] + h1[j]; } }
#pragma unroll 1
        for (int bb = 0; bb < 8; ++bb) lru_batch<4, true>(GT, XC, nb0, dir, p0 + 4 * bb, gcol, c0, sp8, ba, bx, A, hh, store);
        lru_batch<2, true>(GT, XC, nb0, dir, p0 + 32, gcol, c0, sp8, ba, bx, A, hh, store);
        if (!store && hh[0] == 12345.678f) GT[0] = 0;
        __syncthreads();
    }
}
__device__ __forceinline__ void ph_lru_readout(Ctx& F) {
    const bf16_t* GT = (const bf16_t*)(F.ws + WS_R + R_GT); const bf16_t* GB = (const bf16_t*)(F.ws + WS_R + R_GB); bf16_t* YC = (bf16_t*)(F.ws + WS_YCAT);
    const int NIT = 2 * M;
    for (int it0 = F.gw; it0 < NIT; it0 += 4 * F.NGW) { u32x4 h0w[4], h1w[4], gw_[4];
#pragma unroll
        for (int u = 0; u < 4; ++u) { const int it = it0 + u * F.NGW; const int itc = it < NIT ? it : it0; const int n = itc >> 1, c0 = (itc & 1) * 512 + F.lane * 8, blk = c0 >> 7, e0 = c0 & 127;
            h0w[u] = *(const u32x4*)(GT + (size_t)n * 4096 + blk * 512 + e0); h1w[u] = *(const u32x4*)(GT + (size_t)n * 4096 + blk * 512 + 256 + e0); gw_[u] = *(const u32x4*)(GB + (size_t)n * 1024 + c0); }
#pragma unroll
        for (int u = 0; u < 4; ++u) { const int it = it0 + u * F.NGW; if (it >= NIT) break; const int n = it >> 1, c0 = (it & 1) * 512 + F.lane * 8; float h0[8], h1[8], g[8], o[8];
            unpack8(h0w[u], h0); unpack8(h1w[u], h1); unpack8(gw_[u], g);
#pragma unroll
            for (int i = 0; i < 8; ++i) o[i] = (DBG_LRU_D0 * h0[i] + DBG_LRU_D1 * h1[i]) * gelu_tanh_(g[i]);
            *(u32x4*)(YC + (size_t)n * 4096 + 3072 + c0) = pack8(o); } }
}
__device__ __forceinline__ void ph_attn(Ctx& F, bool with_ctx, char* lds_gen) {
    const bf16_t* Q = (const bf16_t*)(F.ws + WS_R + R_Q); const bf16_t* KN = (const bf16_t*)(F.ws + WS_R + R_KN); const bf16_t* KR = (const bf16_t*)(F.ws + WS_R + R_KR); const bf16_t* V = (const bf16_t*)(F.ws + WS_R + R_V); bf16_t* YC = (bf16_t*)(F.ws + WS_YCAT);
    const int NU = 1024 + (with_ctx ? 64 : 0);
    for (int u = F.vcu; u < NU; u += F.G) {
        int b, h, seq; size_t q0; const float* rp = nullptr;
        if (u < 1024) { b = u >> 8; h = (u >> 4) & 15; q0 = (size_t)b * TPB + CTX + (size_t)(u & 15) * 256; seq = TPB; rp = (const float*)(F.ws + WS_ROPE) + (size_t)(u & 15) * 256 * 64; }
        else { const int uu = u - 1024; b = uu >> 4; h = uu & 15; q0 = (size_t)b * TPB; seq = CTX; }
        att::attn_body(Q + q0 * 3072 + h * QKD, KN + (size_t)b * TPB * 2048 + h * QK_NOPE, KR + (size_t)b * TPB * 64, V + (size_t)b * TPB * 2048 + h * VD, YC + q0 * 4096 + 1024 + h * VD, seq, rp, lds_gen);
        __syncthreads();
    }
}
namespace sc2 {
constexpr int BS = 8, NBLK = TPB / BS  , RB = 8, NSTG = 6;
constexpr int SL_X = 0, SL_W2T = 4096, SL_QT = 8192, SL_VT = 9216, SL_G = 10240, SLOT = 10496;
constexpr int ST_PM = 0, ST_GM = 4096, ST_T = 5120, ST_TG = 5376, STG = 5632;
constexpr int OFF_STG = RB * SLOT, OFF_FLAG = OFF_STG + NSTG * STG;
__device__ __forceinline__ unsigned lds_ld(volatile LAS unsigned* p) { return *p; }
__device__ __forceinline__ int keyperm(int ks, int q) { return 16 * (ks >> 2) + 4 * q + (ks & 3); }
}
#ifndef SC2_VARIANT
#define SC2_VARIANT 0
#endif
__device__ __forceinline__ void ph_rwkv_scan2(Ctx& F, int l, int pass = 0) {
    const int variant = pass ? SC2_VARIANT : 0;
    using namespace sc2;
    const bf16_t* RKV = (const bf16_t*)(F.ws + WS_R + R_RKV); const bf16_t* LO = (const bf16_t*)(F.ws + WS_R + R_LO); bf16_t* YS = (bf16_t*)(F.ws + WS_R + R_YS); const float* KKN = (const float*)(F.ws + WS_R + R_KKN);
    const int lane = F.lane, wave = F.wave;
    volatile LAS unsigned* flags = (volatile LAS unsigned*)(F.lds + OFF_FLAG);
    for (int item = F.vcu; item < 256; item += F.G) {
        const int vhalf = item & 1, dir = (item >> 1) & 1, h = (item >> 2) & 15, b = item >> 6; const size_t nb0 = (size_t)b * TPB;
        __syncthreads();
        if (F.tid < 16) flags[F.tid] = 0u;
        for (int i = F.tid; i < RB * 256; i += 512) { const int s = i >> 8, e = i & 255; if (e >= 128) ((LAS float*)(F.lds + s * SLOT + SL_QT))[e] = 0.f; }
        __syncthreads();
        if (wave < 2) {
            const int n = lane & 15, q = lane >> 4; const int rowg = h * 64 + vhalf * 32 + wave * 16 + n;
            f32x4 S[4]; S[0] = S[1] = S[2] = S[3] = (f32x4){0.f, 0.f, 0.f, 0.f};
            for (int blk = 0; blk < NBLK; ++blk) { const int slot = blk & (RB - 1); const LAS unsigned char* sp = F.lds + slot * SLOT;
                { unsigned spin = 0; while (lds_ld(flags + slot) != (unsigned)(blk + 1)) { __builtin_amdgcn_s_sleep(1); if (++spin > (1u << 24)) break; } }
                asm volatile("" ::: "memory");
                f32x4 xa[4];
#pragma unroll
                for (int mb = 0; mb < 4; ++mb) xa[mb] = *(const LAS f32x4*)(sp + SL_X + (n * 64 + 16 * mb + 4 * q) * 4);
                const f32x4 vt = *(const LAS f32x4*)(sp + SL_VT + ((wave * 16 + n) * 8 + 4 * (q & 1)) * 4);
                f32x4 w2[4];
#pragma unroll
                for (int mb = 0; mb < 4; ++mb) w2[mb] = *(const LAS f32x4*)(sp + SL_W2T + ((16 * mb + n) * 16 + 4 * q) * 4);
                const f32x4 qt = *(const LAS f32x4*)(sp + SL_QT + (n * 16 + 4 * q) * 4);
                f32x4 gm[4];
#pragma unroll
                for (int mb = 0; mb < 4; ++mb) gm[mb] = *(const LAS f32x4*)(sp + SL_G + (16 * mb + 4 * q) * 4);
                if (variant == 1) { asm volatile("s_waitcnt lgkmcnt(0)" ::: "memory"); if (lane == 0) flags[8 + wave] = (unsigned)(blk + 1); continue; }
                f32x4 D1 = {0.f, 0.f, 0.f, 0.f}, D1b = D1;
#pragma unroll
                for (int mb = 0; mb < 4; mb += 2)
#pragma unroll
                    for (int i = 0; i < 4; ++i) { D1 = __builtin_amdgcn_mfma_f32_16x16x4f32(xa[mb][i], S[mb][i], D1, 0, 0, 0); D1b = __builtin_amdgcn_mfma_f32_16x16x4f32(xa[mb + 1][i], S[mb + 1][i], D1b, 0, 0, 0); }
                f32x4 Sg[4];
#pragma unroll
                for (int mb = 0; mb < 4; ++mb) Sg[mb] = S[mb] * gm[mb];
                D1 += D1b;
                f32x4 bop;
#pragma unroll
                for (int i = 0; i < 4; ++i) bop[i] = q < 2 ? vt[i] : D1[i];
                f32x4 Dy;
#pragma unroll
                for (int i = 0; i < 4; ++i) Dy[i] = q < 2 ? D1[i] : 0.f;
#pragma unroll
                for (int i = 0; i < 4; ++i) Dy = __builtin_amdgcn_mfma_f32_16x16x4f32(qt[i], bop[i], Dy, 0, 0, 0);
                { f32x4 Dm0 = Sg[0], Dm1 = Sg[1], Dm2 = Sg[2], Dm3 = Sg[3];
#pragma unroll
                  for (int i = 0; i < 4; ++i) { Dm0 = __builtin_amdgcn_mfma_f32_16x16x4f32(w2[0][i], bop[i], Dm0, 0, 0, 0); Dm1 = __builtin_amdgcn_mfma_f32_16x16x4f32(w2[1][i], bop[i], Dm1, 0, 0, 0);
                      Dm2 = __builtin_amdgcn_mfma_f32_16x16x4f32(w2[2][i], bop[i], Dm2, 0, 0, 0); Dm3 = __builtin_amdgcn_mfma_f32_16x16x4f32(w2[3][i], bop[i], Dm3, 0, 0, 0); }
                  S[0] = Dm0; S[1] = Dm1; S[2] = Dm2; S[3] = Dm3; }
                asm volatile("s_waitcnt lgkmcnt(0)" ::: "memory");
                if (lane == 0) flags[8 + wave] = (unsigned)(blk + 1);
                if (q < 2 && !pass) {
#pragma unroll
                    for (int i = 0; i < 4; ++i) { const size_t nt = nb0 + seq_j(dir, blk * BS + 4 * q + i); YS[((size_t)dir * M + nt) * 1024 + rowg] = f2bf(Dy[i]); } }
            }
        } else {
            const int sw = wave - 2; const int ch = h * 64 + lane;
            LAS unsigned char* sc = F.lds + OFF_STG + sw * STG;
            const float kkc = F.in[I_KK][(size_t)l * 1024 + ch], kac = F.in[I_KA][(size_t)l * 1024 + ch];
            bf16_t pr[8], pk[8], pv[8], pw[8], pa_[8]; float pn[8];
#define SC2_FETCH(bk) do { _Pragma("unroll") for (int t = 0; t < 8; ++t) { const size_t nt = nb0 + seq_j(dir, (bk) * BS + t); \
                pr[t] = RKV[nt * 3072 + ch]; pk[t] = RKV[nt * 3072 + 1024 + ch]; pv[t] = RKV[nt * 3072 + 2048 + h * 64 + vhalf * 32 + (lane & 31)]; \
                pw[t] = LO[nt * LORA_N + dir * 1024 + ch]; pa_[t] = LO[nt * LORA_N + 2048 + dir * 1024 + ch]; pn[t] = KKN[nt * 16 + h]; } } while (0)
#ifndef SC2_WEIGHTED
#define SC2_WEIGHTED 1
#endif
            const int pA = sw == 0 ? 0 : sw == 1 ? 1 : sw == 4 ? 2 : sw == 5 ? 3 : sw == 2 ? 8 : 9; const bool two = !(sw == 2 || sw == 3);
#define SC2_BLK(it) (SC2_WEIGHTED == 2 ? (two ? (it) * 4 + pA : NBLK) : SC2_WEIGHTED ? (two ? ((it) >> 1) * 10 + pA + 4 * ((it) & 1) : (it) * 10 + pA) : sw + (it) * NSTG)
            SC2_FETCH(SC2_BLK(0));
            for (int it_ = 0;; ++it_) { const int blk = SC2_BLK(it_); if (blk >= NBLK) break; const int nblk_ = SC2_BLK(it_ + 1);
                const int slot = blk & (RB - 1); LAS unsigned char* sp = F.lds + slot * SLOT;
                float fr[8], fk[8], fv[8], fw[8], fa[8], fn[8];
#pragma unroll
                for (int t = 0; t < 8; ++t) { fr[t] = bf2f(pr[t]); fk[t] = bf2f(pk[t]); fv[t] = bf2f(pv[t]); fw[t] = bf2f(pw[t]); fa[t] = bf2f(pa_[t]); fn[t] = pn[t]; }
                if (nblk_ < NBLK) SC2_FETCH(nblk_);
                if (blk >= RB) { unsigned spin = 0; while (lds_ld(flags + 8) < (unsigned)(blk - RB + 1) || lds_ld(flags + 9) < (unsigned)(blk - RB + 1)) { __builtin_amdgcn_s_sleep(2); if (++spin > (1u << 24)) break; } }
                asm volatile("" ::: "memory");
                if (variant == 2) { if (lane == 0) flags[slot] = (unsigned)(blk + 1); continue; }
                float bt[8], km[8]; float g = 1.f;
#pragma unroll
                for (int t = 0; t < 8; ++t) { const float dec = __expf(-0.60653065971263342f * fw[t]); const float kk = fk[t] * kkc * fn[t]; const float gp = g; g *= dec; const float ig = __builtin_amdgcn_rcpf(g);
                    const float a = fa[t]; bt[t] = a * kk * ig; km[t] = fk[t] * (1.0f + (a - 1.0f) * kac) * ig;
                    ((LAS float*)(sp + SL_X))[t * 64 + lane] = g * fr[t]; ((LAS float*)(sp + SL_X))[(8 + t) * 64 + lane] = gp * kk;
                    ((LAS float*)(sc + ST_PM))[t * 64 + lane] = bt[t]; ((LAS float*)(sc + ST_PM))[(8 + t) * 64 + lane] = km[t];
                    if (lane < 32) ((LAS float*)(sp + SL_VT))[lane * 8 + t] = fv[t]; }
                ((LAS float*)(sp + SL_G))[lane] = g;
                asm volatile("s_waitcnt lgkmcnt(0)" ::: "memory");
                { const int n = lane & 15, q = lane >> 4; f32x4 Gp[4], pa[4], xb[4];
#pragma unroll
                  for (int mb = 0; mb < 4; ++mb) { pa[mb] = *(const LAS f32x4*)(sc + ST_PM + (n * 64 + 16 * mb + 4 * q) * 4); xb[mb] = *(const LAS f32x4*)(sp + SL_X + (n * 64 + 16 * mb + 4 * q) * 4); Gp[mb] = (f32x4){0.f, 0.f, 0.f, 0.f}; }
#pragma unroll
                  for (int i = 0; i < 4; ++i)
#pragma unroll
                      for (int mb = 0; mb < 4; ++mb) Gp[mb] = __builtin_amdgcn_mfma_f32_16x16x4f32(pa[mb][i], xb[mb][i], Gp[mb], 0, 0, 0);
                  const f32x4 Gd = (Gp[0] + Gp[1]) + (Gp[2] + Gp[3]);
#pragma unroll
                  for (int i = 0; i < 4; ++i) ((LAS float*)(sc + ST_GM))[(4 * q + i) * 16 + n] = Gd[i]; }
                asm volatile("s_waitcnt lgkmcnt(0)" ::: "memory");
                const LAS float* GM = (const LAS float*)(sc + ST_GM); LAS float* Tm = (LAS float*)(sc + ST_T); LAS float* TG = (LAS float*)(sc + ST_TG);
                const int p = lane & 7;
                { f32x4 g0[8][4];
#pragma unroll
                  for (int i = 0; i < 8; ++i)
#pragma unroll
                      for (int c4 = 0; c4 < 4; ++c4) g0[i][c4] = *(const LAS f32x4*)(GM + i * 16 + 4 * c4);
                  float Tr[8], Q1r[8];
#pragma unroll
                  for (int c = 0; c < 8; ++c) { float acc = (c == p) ? 1.f : 0.f;
#pragma unroll
                      for (int i = 0; i < 8; ++i) if (i < c) acc -= Tr[i] * g0[i][2 + (c >> 2)][c & 3];
                      Tr[c] = acc; }
#pragma unroll
                  for (int t = 0; t < 8; ++t) { float acc = 0.f;
#pragma unroll
                      for (int j = 0; j < 8; ++j) if (j <= t) acc += Tr[j] * g0[j][t >> 2][t & 3];
                      Q1r[t] = acc; }
                  if (lane < 8) { *(LAS f32x4*)(Tm + p * 8) = (f32x4){Tr[0], Tr[1], Tr[2], Tr[3]}; *(LAS f32x4*)(Tm + p * 8 + 4) = (f32x4){Tr[4], Tr[5], Tr[6], Tr[7]};
                                  *(LAS f32x4*)(TG + p * 8) = (f32x4){Q1r[0], Q1r[1], Q1r[2], Q1r[3]}; *(LAS f32x4*)(TG + p * 8 + 4) = (f32x4){Q1r[4], Q1r[5], Q1r[6], Q1r[7]}; }
                  asm volatile("s_waitcnt lgkmcnt(0)" ::: "memory");
                  f32x4 tg[8][2], gr[4];
#pragma unroll
                  for (int j = 0; j < 8; ++j) { tg[j][0] = *(const LAS f32x4*)(TG + j * 8); tg[j][1] = *(const LAS f32x4*)(TG + j * 8 + 4); }
#pragma unroll
                  for (int c4 = 0; c4 < 4; ++c4) gr[c4] = *(const LAS f32x4*)(GM + (8 + p) * 16 + 4 * c4);
                  float q2[8];
#pragma unroll
                  for (int t = 0; t < 8; ++t) { float acc = (p <= t) ? gr[t >> 2][t & 3] : 0.f;
#pragma unroll
                      for (int j = 1; j < 8; ++j) { const float cj = (j > p) ? gr[2 + (j >> 2)][j & 3] : 0.f; acc -= cj * tg[j][t >> 2][t & 3]; }
                      q2[t] = acc; }
                  if (lane < 8) { LAS float* QT = (LAS float*)(sp + SL_QT);
#pragma unroll
                      for (int t = 0; t < 8; ++t) { QT[t * 16 + p] = q2[t]; QT[t * 16 + 8 + p] = -Q1r[t]; } }
                }
                { float M1[8];
#pragma unroll
                  for (int i = 0; i < 8; ++i) { float acc = 0.f;
#pragma unroll
                      for (int j = 0; j < 8; ++j) if (j >= i) acc += Tm[i * 8 + j] * bt[j];
                      M1[i] = acc; }
                  float K2[8];
#pragma unroll
                  for (int i = 0; i < 8; ++i) { float acc = km[i];
#pragma unroll
                      for (int j = 0; j < 8; ++j) if (j > i) acc -= GM[(8 + i) * 16 + 8 + j] * M1[j];
                      K2[i] = acc; }
                  LAS f32x4* wo = (LAS f32x4*)(sp + SL_W2T + lane * 64); const float ng = -g;
                  wo[0] = (f32x4){K2[0], K2[1], K2[2], K2[3]} * g; wo[1] = (f32x4){K2[4], K2[5], K2[6], K2[7]} * g; wo[2] = (f32x4){M1[0], M1[1], M1[2], M1[3]} * ng; wo[3] = (f32x4){M1[4], M1[5], M1[6], M1[7]} * ng; }
                asm volatile("s_waitcnt lgkmcnt(0)" ::: "memory");
                if (lane == 0) flags[slot] = (unsigned)(blk + 1);
            }
#undef SC2_FETCH
#undef SC2_BLK
        }
    }
    __syncthreads();
}
#ifndef MK_MULTI
#define MK_MULTI 0
#endif
constexpr int NPL = 16, NPH = 3 + DEPTH * NPL;
#ifndef DBG_MIX
#define DBG_MIX 1.0f
#endif
#ifndef DBG_FFN
#define DBG_FFN 1.0f
#endif
#ifndef DBG_RW
#define DBG_RW 1.0f
#endif
#ifndef DBG_MLA
#define DBG_MLA 1.0f
#endif
#ifndef DBG_LRU
#define DBG_LRU 1.0f
#endif
struct Args { const float* in[40]; float* out; unsigned char* ws; int ph_lo, ph_hi; };
#define CAS __attribute__((address_space(4)))
#define GEMM(EPI, e, Aptr, Bptr, lda_, ldb_, K_, nM_, nN_, nG_, pmode_, lrug_) do { pg8::Gemm g_{(const bf16_t*)(Aptr), (const bf16_t*)(Bptr), lda_, ldb_, K_, lrug_, (pmode_) == 2 ? 4 : 0}; pg8::Order S_; \
        S_.init(nM_, nN_, nG_, G, (bx + G - rot) % G, pmode_, 4); pg8::gemm_phase<EPI>(F.lds, g_, S_, e); rot = (rot + (nM_) * (nN_) * (nG_)) % G; } while (0)
__device__ __forceinline__ void make_ctx(Ctx& F, const CAS Args& args, unsigned char* lds_) {
    unsigned char* ws = args.ws;
    int tid = threadIdx.x; asm volatile("" : "+v"(tid));
    F.lds = (LAS unsigned char*)lds_; F.ws = ws; F.in = args.in; F.out = args.out;
    F.tid = tid; F.lane = F.tid & 63; F.wave = __builtin_amdgcn_readfirstlane(F.tid >> 6);
    F.G = gridDim.x; { int bx = blockIdx.x; asm volatile("" : "+s"(bx)); F.vcu = (F.G % 8 == 0) ? (bx % 8) * (F.G / 8) + bx / 8 : bx; }
    F.gw = F.vcu * 8 + F.wave; F.NGW = F.G * 8;
}
template <int KIND> __device__ __forceinline__ void run_phase(const Args& args_, int l_, unsigned char* lds_, int pass = 0) {
    int l = l_; asm volatile("" : "+s"(l));
    unsigned long long kp_ = (unsigned long long)__builtin_amdgcn_kernarg_segment_ptr(); asm volatile("" : "+s"(kp_));
    const CAS Args& args = *(const CAS Args*)kp_; (void)args_;
    Ctx F; make_ctx(F, args, lds_); char* lds_gen = (char*)lds_;
    unsigned char* W = F.ws + WS_W; unsigned char* R = F.ws + WS_R;
    bf16_t* H = (bf16_t*)(F.ws + WS_H); float* X = (float*)(F.ws + WS_X); bf16_t* YC = (bf16_t*)(F.ws + WS_YCAT);
    int bx = blockIdx.x; asm volatile("" : "+s"(bx)); const int G = F.G; int rot = 0;
    const float* modl = (const float*)(F.ws + WS_MOD) + (size_t)l * 5 * 18432;
    const bool lastl = (l + 1 == DEPTH); const int PM = lastl ? 1 : 0, NP = lastl ? 64 : NPAN;
    float* PART = (float*)(R + R_PART); const int PMS = lastl ? 1 : 2;
    const float* lng = F.in[I_LNG] + (size_t)l * 3 * D; const float* lnb = F.in[I_LNB] + (size_t)l * 3 * D;
    if constexpr (KIND == 0) { ph_modp(F); ph_rope(F); ph_xasm(F); ph_cvt(F, 0); }
    if constexpr (KIND == 1) { ph_modr(F); }
    if constexpr (KIND == 2) { ph_h0(F); }
    if constexpr (KIND == 3) { pg8::EpiSwiGLU e{(bf16_t*)(R + R_ACT), DFF}; GEMM(pg8::EpiSwiGLU, e, H, W + W_GU0, D, D, D, NPAN, 44, 1, 0, 0); }
    if constexpr (KIND == 4) { pg8::EpiResid e{X, modl + 2 * 2048, pass ? 0.f : 0.5f * DBG_FFN, pass ? 1.f : ALPHA, 3 * l, l == 0 ? F.in[I_X] : nullptr}; GEMM(pg8::EpiResid, e, R + R_ACT, W + W_D0, DFF, DFF, DFF, 64, 8, 1, 2, 0); }
    if constexpr (KIND == 5) { ph_ln(F, lng, lnb, modl, 3, 4, false, false, pass ? nullptr : PART, modl + 2 * 2048, 0.5f * DBG_FFN, 3 * l); }
    if constexpr (KIND == 6) { pg8::EpiBf16 e{(bf16_t*)(R + R_FA), FA_PAD, 0, (bf16_t*)(R + R_GB), GB_TILE0, 1024};     GEMM(pg8::EpiBf16, e, H, W + W_INA, D, D, D, NPAN, FA_PAD / 256, 1, 0, 0); }
    if constexpr (KIND == 7) { ph_prep(F, l); }
    if constexpr (KIND == 8) { { pg8::EpiGate e{(bf16_t*)(R + R_LO), (const float*)(F.ws + WS_LB) + (size_t)l * 4096, LORA_N}; GEMM(pg8::EpiGate, e, R + R_LIN, W + W_LORA, LORA_K, LORA_K, LORA_K, NPAN, 16, 1, 0, 0); }
                               { pg8::EpiBf16 e{(bf16_t*)(R + R_LO) + 4096, LORA_N, 0, nullptr, 1 << 30, 0}; GEMM(pg8::EpiBf16, e, R + R_LIN, (bf16_t*)(W + W_LORA) + (size_t)4096 * LORA_K, LORA_K, LORA_K, LORA_K, NPAN, 4, 1, 0, 0); }
                               { pg8::EpiBf16 e{(bf16_t*)(R + R_GT), 4096, 512, nullptr, 1 << 30, 0}; GEMM(pg8::EpiBf16, e, R + R_XC, W + W_LRU, 1024, 256, 256, NPAN, 2, 8, 0, 1); } }
#ifndef MERGE_KSPLIT
#define MERGE_KSPLIT 1
#endif
#ifndef CVT_IN_MERGE
#define CVT_IN_MERGE 0
#endif
#ifndef SCAN_V
#define SCAN_V 2
#endif
    if constexpr (KIND == 9) { if (pass < 2) { if (SCAN_V == 2) ph_rwkv_scan2(F, l, pass); else ph_rwkv_scan(F, l); } if (pass != 1) ph_lru_scan(F, l, pass == 0); }
    if constexpr (KIND == 10) { ph_rwkv_readout(F, l); ph_lru_readout(F); }
    if constexpr (KIND == 11) { { pg8::EpiBf16 e{(bf16_t*)(R + R_Q), 3072, 0, nullptr, 1 << 30, 0}; GEMM(pg8::EpiBf16, e, R + R_QL, W + W_UQ, 512, 512, 512, NP, 12, 1, PM, 0); }
                                { pg8::EpiBf16 e{(bf16_t*)(R + R_KN), 2048, 0, (bf16_t*)(R + R_V), 8, 2048}; GEMM(pg8::EpiBf16, e, R + R_KVC, W + W_UKV, 256, 256, 256, NPAN, 16, 1, 0, 0); } }
    if constexpr (KIND == 12) { ph_attn(F, l + 1 < DEPTH, lds_gen);
                                { pg8::EpiGate e{(bf16_t*)(R + R_GATE), F.in[I_GATEB] + (size_t)l * GATE_IN, GATE_IN}; GEMM(pg8::EpiGate, e, H, W + W_ING, D, D, D, NP, 24, 1, PM, 0); } }
    if constexpr (KIND == 13) { pg8::EpiMergeOne e{(const bf16_t*)(R + R_GATE), (bf16_t*)(R + R_Y2B), 16, 48, (LAS unsigned*)(F.lds + LDSCTL_OFF + 64)}; GEMM(pg8::EpiMergeOne, e, YC, W + W_PROJ, 4096, 4096, 4096, 64, 8, 1, MERGE_KSPLIT ? PMS : PM, 0);
#if CVT_IN_MERGE
                                if (!lastl && !pass) { const int nwg = NP * 8, nlast = nwg - ((nwg - 1) / G) * G, i0 = (2 * nlast < G) ? nlast : 0;
                                    __syncthreads(); if (bx >= i0) ph_cvt_m(F, l + 1, CVT_EARLY, (bx - i0) * 8 + F.wave, (G - i0) * 8, false); }
#endif
                              }
    if constexpr (KIND == 14) { pg8::EpiResid e{X, modl + 5 * 2048, pass ? 0.f : 1.0f * DBG_MIX, pass ? 1.f : ALPHA, 3 * l + 1, nullptr}; GEMM(pg8::EpiResid, e, R + R_Y2B, W + W_OUT, D, D, D, 64, 8, 1, PMS, 0); }
    if constexpr (KIND == 15) { ph_ln(F, lng + D, lnb + D, modl, 6, 7, false, lastl, (lastl || pass) ? nullptr : PART, modl + 5 * 2048, 1.0f * DBG_MIX, 3 * l + 1); }
    if constexpr (KIND == 16) { pg8::EpiSwiGLU e{(bf16_t*)(R + R_ACT), DFF}; GEMM(pg8::EpiSwiGLU, e, H, W + W_GU1, D, D, D, NP, 44, 1, PM, 0); }
    if constexpr (KIND == 17) { pg8::EpiResid e{X, modl + 8 * 2048, pass ? 0.f : 0.5f * DBG_FFN, pass ? 1.f : ALPHA, 3 * l + 2, nullptr}; GEMM(pg8::EpiResid, e, R + R_ACT, W + W_D1, DFF, DFF, DFF, 64, 8, 1, PMS, 0);
                                if (!lastl && !pass) { __syncthreads(); ph_cvt_m(F, l + 1, CVT_IN_MERGE ? CVT_MID : 0xFull, bx * 8 + F.wave, G * 8, false); } }
    if constexpr (KIND == 18) { ph_ln(F, lng + 2 * D, lnb + 2 * D, modl + 5 * 18432, 0, 1, l + 1 == DEPTH, false, lastl ? nullptr : PART, modl + 8 * 2048, 0.5f * DBG_FFN, 3 * l + 2); if (l + 1 < DEPTH) { __syncthreads(); ph_cvt_m(F, l + 1, CVT_IN_MERGE ? CVT_LATE : (CVT_ALL & ~0xFull)); } }
}
#if MK_MULTI
template <int KIND> __global__ void __launch_bounds__(512, 2) k_one(Args args, int l) {
    extern __shared__ __attribute__((aligned(16))) unsigned char lds_[];
    run_phase<KIND>(args, l, lds_);
}
#else
__device__ __forceinline__ void grid_bar(const Args& args, unsigned char* lds_) {
    XcdBarrier bar; bar.bar = (unsigned*)(args.ws + WS_CTL); bar.x = xb_xcc_id(); bar.st = (volatile LAS unsigned*)((LAS unsigned char*)lds_ + LDSCTL_OFF) + 8;
    xcd_barrier(bar);
}
__global__ void __launch_bounds__(512, 2) fwd(Args args) {
    extern __shared__ __attribute__((aligned(16))) unsigned char lds_[];
    { volatile LAS unsigned* MISC = (volatile LAS unsigned*)((LAS unsigned char*)lds_ + LDSCTL_OFF);
      for (int u = threadIdx.x; u < 256; u += 512) MISC[u] = 0u;
      __syncthreads();
      (void)xcd_barrier_post((unsigned*)(args.ws + WS_CTL), MISC + 8); }
#ifndef REP3
#define REP3 1
#endif
#ifndef REP4
#define REP4 1
#endif
#ifndef REP6
#define REP6 1
#endif
#ifndef REP7
#define REP7 1
#endif
#ifndef REP8
#define REP8 1
#endif
#ifndef REP9
#define REP9 1
#endif
#ifndef REP10
#define REP10 1
#endif
#ifndef REP11
#define REP11 1
#endif
#ifndef REP12
#define REP12 1
#endif
#ifndef REP19
#define REP19 1
#endif
#ifndef REP13
#define REP13 1
#endif
#ifndef REP14
#define REP14 1
#endif
#ifndef REP16
#define REP16 1
#endif
#ifndef REP17
#define REP17 1
#endif
#define PH(K, l) run_phase<K>(args, l, lds_); grid_bar(args, lds_);
#define PHR(K, l, REP) for (int rep_ = 0; rep_ < (REP); ++rep_) { run_phase<K>(args, l, lds_, rep_); grid_bar(args, lds_); }
#ifndef REP0
#define REP0 1
#endif
#ifndef REP9L
#define REP9L 0
#endif
#ifndef REPLN
#define REPLN 1
#endif
#ifndef REPBAR
#define REPBAR 0
#endif
#ifndef REP2
#define REP2 1
#endif
    PHR(0, 0, REP0) PH(1, 0) PHR(2, 0, REP2)
    for (int rb_ = 0; rb_ < REPBAR; ++rb_) grid_bar(args, lds_);
    for (int l = 0; l < DEPTH; ++l) {
        PHR(3, l, REP3) PHR(4, l, REP4) PHR(5, l, REPLN) PHR(6, l, REP6) PHR(7, l, REP7) PHR(8, l, REP8) PHR(9, l, REP9) if (REP9L) { run_phase<9>(args, l, lds_, 2); grid_bar(args, lds_); } PHR(10, l, REP10) PHR(11, l, REP11) PHR(12, l, REP12) PHR(13, l, REP13) PHR(14, l, REP14) PHR(15, l, REPLN) PHR(16, l, REP16) PHR(17, l, REP17)
        run_phase<18>(args, l, lds_); if (l + 1 < DEPTH) grid_bar(args, lds_);
    }
#undef PHR
#undef PH
}
#endif


#if MK_MULTI
template <int K> static void launch_kind(int grid, hipStream_t stream, const Args& a, int l) {
    static bool attr = false;
    if (!attr) { (void)hipFuncSetAttribute((const void*)k_one<K>, hipFuncAttributeMaxDynamicSharedMemorySize, LDS_BYTES); attr = true; }
    hipLaunchKernelGGL(k_one<K>, dim3(grid), dim3(512), LDS_BYTES, stream, a, l);
}
template <int K> static void launch_layer(int grid, hipStream_t stream, const Args& a, int l) { if constexpr (K <= 18) { launch_kind<K>(grid, stream, a, l); if (K == 12) {
#if defined(DBG_PROBE)
        if (DBG_PROBE == 1 && l == 0) hipLaunchKernelGGL(k_dbg_gate, dim3(32), dim3(256), 0, stream, a, l);
        if (DBG_PROBE >= 6 && DBG_PROBE <= 11 && l == 0) { (void)hipMemsetAsync((char*)a.ws + WS_CTL + 8201 * 4, 0xff, 4, stream); hipLaunchKernelGGL(k_dbg_gate_tiles, dim3(68 * 24), dim3(256), 0, stream, a); hipLaunchKernelGGL(k_dbg_tiles_fin, dim3(1), dim3(64), 0, stream, a, DBG_PROBE); }
        if (DBG_PROBE >= 3 && DBG_PROBE <= 5 && l == 0) { (void)hipMemsetAsync((char*)a.ws + WS_CTL + 8201 * 4, 0xff, 4, stream); hipLaunchKernelGGL(k_dbg_gate_range, dim3(1024), dim3(256), 0, stream, a, DBG_PROBE); hipLaunchKernelGGL(k_dbg_range_fin, dim3(1), dim3(64), 0, stream, a, DBG_PROBE); }
#endif
        }
#if defined(DBG_PROBE)
        if (K == 6 && DBG_PROBE == 2 && l == 0) hipLaunchKernelGGL(k_dbg_fa, dim3(32), dim3(256), 0, stream, a, l);
        if (K == 4 && DBG_PROBE == 21 && l == 0) hipLaunchKernelGGL(k_dbg_ffn, dim3(96), dim3(256), 0, stream, a);
        if (K == 7 && DBG_PROBE == 24 && l == 0) hipLaunchKernelGGL(k_dbg_prep, dim3(16), dim3(256), 0, stream, a, l);
        if (K == 3 && DBG_PROBE == 23 && l == 0) hipLaunchKernelGGL(k_dbg_mod, dim3(8), dim3(256), 0, stream, a);
        if (K == 10 && DBG_PROBE == 22 && l == 0) hipLaunchKernelGGL(k_dbg_rwkv, dim3(32), dim3(64), 0, stream, a, l);
        if (K == 10 && DBG_PROBE == 20 && l == 0) hipLaunchKernelGGL(k_dbg_lru, dim3(4), dim3(64), 0, stream, a, l);
#endif
        launch_layer<K + 1>(grid, stream, a, l); } }
#endif
extern "C" void kernel_launch(void* const* d_in, const int* in_sizes, int n_in, void* d_out, int out_size, void* d_ws, size_t ws_size, hipStream_t stream) {
    static int grid = 0;
    if (grid == 0) {
        if (n_in != 40 || in_sizes[0] != NB * SEQ * D || out_size != NB * SEQ * D || ws_size < WS_END) {
            fprintf(stderr, "kernel_launch: shape mismatch: n_in %d in0 %d out %d ws %zu (need %zu); nothing launched\n", n_in, n_in > 0 ? in_sizes[0] : -1, out_size, ws_size, (size_t)WS_END); grid = -1; return; }
        int dev = 0, cus = 0;
        if (hipGetDevice(&dev) != hipSuccess || hipDeviceGetAttribute(&cus, hipDeviceAttributeMultiprocessorCount, dev) != hipSuccess) { grid = -1; return; }
#if !MK_MULTI
        int per_cu = 0;
        if (hipFuncSetAttribute((const void*)fwd, hipFuncAttributeMaxDynamicSharedMemorySize, LDS_BYTES) != hipSuccess) { fprintf(stderr, "kernel_launch: hipFuncSetAttribute failed\n"); grid = -1; return; }
        if (hipOccupancyMaxActiveBlocksPerMultiprocessor(&per_cu, (const void*)fwd, 512, LDS_BYTES) != hipSuccess || per_cu < 1) { fprintf(stderr, "kernel_launch: occupancy query says %d blocks per CU\n", per_cu); }
        (void)hipGetLastError();
#endif
        grid = cus;
    }
    if (grid < 0) return;
    if (hipMemsetAsync((char*)d_ws + WS_CTL, 0, CTL_BYTES, stream) != hipSuccess) return;
    Args a{};
    for (int i = 0; i < 40; ++i) a.in[i] = (const float*)d_in[i];
    a.out = (float*)d_out; a.ws = (unsigned char*)d_ws; a.ph_lo = 0; a.ph_hi = NPH;
#if MK_MULTI
    launch_kind<0>(grid, stream, a, 0); launch_kind<1>(grid, stream, a, 0); launch_kind<2>(grid, stream, a, 0);
    for (int l = 0; l < DEPTH; ++l) launch_layer<3>(grid, stream, a, l);
#if defined(DBG_PROBE)
    hipLaunchKernelGGL(k_dbg_final, dim3(1), dim3(64), 0, stream, a);
#endif
#else
    hipLaunchKernelGGL(fwd, dim3(grid), dim3(512), LDS_BYTES, stream, a);
#endif
    const hipError_t le = hipPeekAtLastError();
    if (le != hipSuccess) fprintf(stderr, "kernel_launch: launch failed: %s\n", hipGetErrorName(le));
}
```

```cpp
#include <hip/hip_runtime.h>
#include <cstdio>
#include <cstdint>

#define LAS __attribute__((address_space(3)))
#define GAS __attribute__((address_space(1)))
typedef unsigned short bf16_t;
typedef short bf16x8 __attribute__((ext_vector_type(8)));
typedef short s16x4 __attribute__((ext_vector_type(4)));
typedef float f32x2 __attribute__((ext_vector_type(2)));
typedef float f32x4 __attribute__((ext_vector_type(4)));
typedef float f32x8 __attribute__((ext_vector_type(8)));
typedef float f32x16 __attribute__((ext_vector_type(16)));
typedef unsigned u32x2 __attribute__((ext_vector_type(2)));
typedef unsigned u32x4 __attribute__((ext_vector_type(4)));

constexpr int D = 2048, NB = 4, SEQ = 4096, CTX = 256, TPB = CTX + SEQ  , M = NB * TPB  , DFF = 5632, NMOD = 9, DEPTH = 2;
constexpr int NPAN = M / 256;
constexpr int RWKV_W = 1024, RW_IN = 3360, MLA_IN = 832, LRU_IN = 2048, GATE_IN = 6144, IN_COLS = 12384;
constexpr int FA = RW_IN + MLA_IN + LRU_IN  , FA_PAD = 6400;
constexpr int OFF_QLAT = 3360, OFF_KVLAT = 3872, OFF_KROPE = 4128, OFF_XR = 4192, OFF_GB = 5216;
constexpr int GB_TILE0 = 21, GB_ROW0 = GB_TILE0 * 256  ;
static_assert(GB_ROW0 + 1024 == FA_PAD && OFF_GB % 32 == 0, "gelu-branch tiles");
constexpr int LORA_K = 384, LORA_N = 5120;
constexpr int NHEAD = 16, QK_NOPE = 128, QK_ROPE = 64, QKD = 192, VD = 128;
constexpr float LN_EPS = 1e-6f, GN_EPS = 64e-5f, ALPHA = 1.41421356237309515f;

constexpr size_t al256(size_t x) { return (x + 255) & ~(size_t)255; }
constexpr size_t WS_CTL = 0, CTL_BYTES = 65536;
constexpr size_t WS_MOD = WS_CTL + CTL_BYTES;
constexpr size_t WS_ROPE = al256(WS_MOD + (size_t)2 * 5 * 18432 * 4);
constexpr size_t WS_LB = al256(WS_ROPE + (size_t)4096 * 32 * 2 * 4);
constexpr size_t WS_STATS = al256(WS_LB + (size_t)2 * 4096 * 4);
constexpr size_t WS_LNT = al256(WS_STATS + (size_t)M * 2 * 4);
constexpr size_t WS_W = al256(WS_LNT + (size_t)7 * 4096 * 4);
constexpr size_t W_GU0 = 0, W_GU1 = W_GU0 + (size_t)11264 * 2048 * 2, W_D0 = W_GU1 + (size_t)11264 * 2048 * 2, W_D1 = W_D0 + (size_t)2048 * 5632 * 2;
constexpr size_t W_INA = W_D1 + (size_t)2048 * 5632 * 2, W_ING = W_INA + (size_t)FA_PAD * 2048 * 2, W_UQ = W_ING + (size_t)6144 * 2048 * 2;
constexpr size_t W_UKV = W_UQ + (size_t)3072 * 512 * 2, W_LORA = W_UKV + (size_t)4096 * 256 * 2, W_LRU = W_LORA + (size_t)LORA_N * LORA_K * 2;
constexpr size_t W_PROJ = W_LRU + (size_t)8 * 512 * 256 * 2, W_OUT = W_PROJ + (size_t)2048 * 4096 * 2, W_END = W_OUT + (size_t)2048 * 2048 * 2;
constexpr size_t WS_X = al256(WS_W + W_END);
constexpr size_t WS_H = WS_X + (size_t)M * D * 4;
constexpr size_t WS_YCAT = WS_H + (size_t)M * D * 2;
constexpr size_t WS_R = WS_YCAT + (size_t)M * 4096 * 2;
constexpr size_t R_ACT = 0;
constexpr size_t R_MODP = 0;
constexpr size_t R_FA = 0;
constexpr size_t R_PREP = (size_t)M * FA_PAD * 2;
constexpr size_t R_LIN = R_PREP;
constexpr size_t R_RKV = R_LIN + (size_t)M * LORA_K * 2;
constexpr size_t R_XC = R_RKV + (size_t)M * 3072 * 2;
constexpr size_t R_GB = R_XC + (size_t)M * 1024 * 2;
constexpr size_t R_QL = R_GB + (size_t)M * 1024 * 2;
constexpr size_t R_KVC = R_QL + (size_t)M * 512 * 2;
constexpr size_t R_KR = R_KVC + (size_t)M * 256 * 2;
constexpr size_t R_KKN = R_KR + (size_t)M * 64 * 2;
constexpr size_t R_PREP_END = R_KKN + (size_t)M * 16 * 4;
constexpr size_t R_LO = 0;
constexpr size_t R_GT = R_PREP_END;
constexpr size_t R_YS = R_GT + (size_t)M * 4096 * 2;
constexpr size_t R_Q = 0;
constexpr size_t R_KN = R_Q + (size_t)M * 3072 * 2;
constexpr size_t R_V = R_KN + (size_t)M * 2048 * 2;
constexpr size_t R_GATE = R_PREP_END;
constexpr size_t R_Y2F = 0;
constexpr size_t R_Y2B = R_Y2F + (size_t)M * 2048 * 4;
constexpr size_t R_PART = (size_t)220 << 20;
constexpr size_t R_END = R_YS + (size_t)2 * M * 1024 * 2;
static_assert(R_LO + (size_t)M * LORA_N * 2 <= R_PREP, "LO fits the dead FA slot");
static_assert(R_V + (size_t)M * 2048 * 2 <= R_QL, "Q|K|V fit below the live QL/KVC/KR");
static_assert(R_GATE + (size_t)M * 6144 * 2 <= R_END, "GATE fits");
static_assert(R_Y2B + (size_t)M * 2048 * 2 <= R_GATE, "Y2 below GATE");
static_assert(R_PART >= R_ACT + (size_t)M * DFF * 2 && R_PART >= R_Y2B + (size_t)M * 2048 * 2 && R_PART + (size_t)4 * 1024 * 2048 * 4 <= R_GATE, "partials clear of ACT / Y2 / GATE");
constexpr size_t WS_END = WS_R + R_END;

constexpr int RING_BYTES = 145408;
constexpr int LDSCTL_OFF = RING_BYTES;
constexpr int LDS_BYTES = 147456;

#ifndef USE_F16
#define USE_F16 0
#endif
typedef __bf16 bf16x2_n __attribute__((ext_vector_type(2)));
typedef _Float16 f16x2_n __attribute__((ext_vector_type(2)));
typedef _Float16 f16x8_n __attribute__((ext_vector_type(8)));
__device__ __forceinline__ unsigned cvt_pk_bf16(float lo, float hi) { const f32x2 v = {lo, hi};
#if USE_F16
    const f16x2_n r = __builtin_convertvector(v, f16x2_n); return __builtin_bit_cast(unsigned, r);
#else
    const bf16x2_n r = __builtin_convertvector(v, bf16x2_n); return __builtin_bit_cast(unsigned, r);
#endif
}
#if USE_F16
__device__ __forceinline__ float bf_lo(unsigned w) { return (float)__builtin_bit_cast(f16x2_n, w)[0]; }
__device__ __forceinline__ float bf_hi(unsigned w) { return (float)__builtin_bit_cast(f16x2_n, w)[1]; }
__device__ __forceinline__ float bf2f(bf16_t b) { return (float)__builtin_bit_cast(_Float16, b); }
#define MFMA16(a, b, c) __builtin_amdgcn_mfma_f32_16x16x32_f16(__builtin_bit_cast(f16x8_n, a), __builtin_bit_cast(f16x8_n, b), c, 0, 0, 0)
#define MFMA32(a, b, c) __builtin_amdgcn_mfma_f32_32x32x16_f16(__builtin_bit_cast(f16x8_n, a), __builtin_bit_cast(f16x8_n, b), c, 0, 0, 0)
#else
__device__ __forceinline__ float bf_lo(unsigned w) { return __uint_as_float(w << 16); }
__device__ __forceinline__ float bf_hi(unsigned w) { return __uint_as_float(w & 0xffff0000u); }
__device__ __forceinline__ float bf2f(bf16_t b) { return __uint_as_float(((unsigned)b) << 16); }
#define MFMA16(a, b, c) __builtin_amdgcn_mfma_f32_16x16x32_bf16(a, b, c, 0, 0, 0)
#define MFMA32(a, b, c) __builtin_amdgcn_mfma_f32_32x32x16_bf16(a, b, c, 0, 0, 0)
#endif
__device__ __forceinline__ bf16_t f2bf(float f) { return (bf16_t)(cvt_pk_bf16(f, 0.f) & 0xffffu); }
__device__ __forceinline__ float wave_sum(float v) {
#pragma unroll
    for (int o = 1; o < 64; o <<= 1) v += __shfl_xor(v, o);
    return v;
}
__device__ __forceinline__ float sigmoidf_(float x) { return 1.0f / (1.0f + __expf(-x)); }
__device__ __forceinline__ float siluf_(float x) { return x / (1.0f + __expf(-x)); }
__device__ __forceinline__ float softplusf_(float x) { const float e = __expf(x); const float p = e * (1.0f - e * (0.5f - e * (0.33333334f - e * (0.25f - e * 0.2f)))); return x > 20.f ? x : (e < 0.125f ? p : __logf(1.0f + e)); }
__device__ __forceinline__ float gelu_tanh_(float x) { const float u = 0.7978845608028654f * (x + 0.044715f * x * x * x); return x * __builtin_amdgcn_rcpf(1.0f + __expf(-2.0f * u)); }
__device__ __forceinline__ u32x4 zero4() { unsigned z = 0u; asm volatile("" : "+v"(z)); return (u32x4){z, z, z, z}; }
__device__ __forceinline__ int modrow_of_panel(int pm) { return (pm % 17 == 0) ? 4 : pm / 17; }
#define MK_MULTI 0
namespace pg8 {
constexpr int BM = 256, BK = 64, HALF = 128, HTB = HALF * BK * 2  , STAGE_BYTES = 8 * HTB, NXCD = 8, WGM = 8;
__host__ __device__ __forceinline__ int lds_byte(int r, int c) { const int st = (r >> 4) * 2 + (c >> 5), rr = r & 15, cc = c & 31, ob = rr * 64 + cc * 2; return st * 1024 + (ob ^ (((ob >> 9) & 1) << 5)); }
__host__ __device__ __forceinline__ void stage_rc(int b, int& R, int& C) { const int st = b / 1024, sb = b % 1024, swz = sb ^ (((sb >> 9) & 1) << 5); R = (st >> 1) * 16 + swz / 64; C = (st & 1) * 32 + (swz % 64) / 2; }
__host__ __device__ __forceinline__ int perm32(int rho) { const int n = rho >> 4, i = rho & 15; return 8 * (i >> 2) + 4 * n + (i & 3); }

struct Unit { int pm, pn, g, ks; };
struct Gemm { const bf16_t* A; const bf16_t* Bt; int lda, ldb, K; int lru_groups; int ksplit; };
__device__ __forceinline__ size_t a_base(const Gemm& g, const Unit& u) { return (size_t)u.pm * 256 * g.lda * 2 + (g.lru_groups ? (size_t)(u.g >> 1) * 256 * 2 : 0) + (u.ks > 0 ? (size_t)u.ks * (g.K / g.ksplit) * 2 : 0); }
__device__ __forceinline__ size_t b_base(const Gemm& g, const Unit& u) { return (size_t)u.pn * 256 * g.ldb * 2 + (g.lru_groups ? (size_t)u.g * 512 * 256 * 2 : 0) + (u.ks > 0 ? (size_t)u.ks * (g.K / g.ksplit) * 2 : 0); }

struct Order {
    int nM, nN, nG, per, nwg, G, c, pmode, S;
    __device__ void init(int nM_, int nN_, int nG_, int G_, int c_, int pmode_, int S_ = 0) { nM = nM_; nN = nN_; nG = nG_; per = nM * nN; nwg = per * nG + (pmode_ == 2 ? 4 * nN_ * S_ : 0); G = G_; c = c_; pmode = pmode_; S = S_; }
    __device__ bool next(int i, Unit& u) const {
        const long L = (long)i * G + c; if (L >= nwg) return false;
        if (pmode == 2 && L >= per) { const int Lp = (int)(L - per); u.ks = Lp % S; const int t = Lp / S; u.pm = 17 * (t & 3); u.pn = t >> 2; u.g = 0; return true; }
        const int g = (int)(L / per); int wgid = (int)(L % per);
        { const int q = per / NXCD, r = per % NXCD, xcd = wgid % NXCD, off = wgid / NXCD; wgid = (xcd < r ? xcd * (q + 1) : r * (q + 1) + (xcd - r) * q) + off; }
        const int nig = WGM * nN, gid = wgid / nig, fm = gid * WGM, gsz = (nM - fm) < WGM ? (nM - fm) : WGM;
        int pm = fm + ((wgid % nig) % gsz); u.pn = (wgid % nig) / gsz; u.g = g; u.ks = -1;
        if (pmode >= 1) pm = (pm >> 4) * 17 + 1 + (pm & 15);
        u.pm = pm; return true;
    }
};

__device__ __forceinline__ void unpack8(const u32x4 w, float (&x)[8]) { x[0] = bf_lo(w.x); x[1] = bf_hi(w.x); x[2] = bf_lo(w.y); x[3] = bf_hi(w.y); x[4] = bf_lo(w.z); x[5] = bf_hi(w.z); x[6] = bf_lo(w.w); x[7] = bf_hi(w.w); }
typedef f32x4 Acc[2][2][4][2];

template <class Epi>
__device__ __forceinline__ void gemm_phase(LAS unsigned char* lds, const Gemm g, const Order S, const Epi E) {
    int tid_ = threadIdx.x; asm volatile("" : "+v"(tid_));
    const int tid = tid_, wid = __builtin_amdgcn_readfirstlane(tid >> 6), lane = tid & 63, wr = wid >> 2, wc = wid & 3, fr = lane & 15, fq = lane >> 4;
    const int ntf = g.K / BK, nts = g.ksplit > 0 ? g.K / g.ksplit / BK : ntf;
    unsigned voffA[2], voffB[2];
#pragma unroll
    for (int i = 0; i < 2; ++i) { int R, C; stage_rc(tid * 16 + i * 8192, R, C); const int Rb = Epi::PERM ? ((R & ~31) + perm32(R & 31)) : R;
        voffA[i] = (unsigned)(R * g.lda + C) * 2u; voffB[i] = (unsigned)(Rb * g.ldb + C) * 2u; }
    const size_t kstep = (size_t)(BK * 2);
    const size_t hstepA = (size_t)HALF * g.lda * 2, hstepB = (size_t)HALF * g.ldb * 2;
    const unsigned ldsw = (unsigned)wid * 1024u;
    const int aoff = lds_byte(wr * 64 + fr, fq * 8), boff = lds_byte(wc * 32 + fr, fq * 8);
#define PG8_SA(b, h) (((b) * 2 + (h)) * HTB)
#define PG8_SB(b, h) ((4 + (b) * 2 + (h)) * HTB)
#define PG8_STAGE(bufoff, gbase, voff) do { _Pragma("unroll") for (int _i = 0; _i < 2; ++_i) \
        __builtin_amdgcn_global_load_lds((const unsigned*)((const char*)(gbase) + (voff)[_i]), (LAS unsigned*)(lds + (bufoff) + ldsw + _i * 8192), 16, 0, 0); } while (0)
#define PG8_LDA(dst, b, h) do { _Pragma("unroll") for (int m = 0; m < 4; ++m) _Pragma("unroll") for (int k = 0; k < 2; ++k) dst[m][k] = *(const LAS bf16x8*)(lds + PG8_SA(b, h) + aoff + m * 2048 + k * 1024); } while (0)
#define PG8_LDB(dst, b, h) do { _Pragma("unroll") for (int n = 0; n < 2; ++n) _Pragma("unroll") for (int k = 0; k < 2; ++k) dst[n][k] = *(const LAS bf16x8*)(lds + PG8_SB(b, h) + boff + n * 2048 + k * 1024); } while (0)
#define PG8_MMA(ai, bj, At, Bt) do { __builtin_amdgcn_s_setprio(1); _Pragma("unroll") for (int m = 0; m < 4; ++m) _Pragma("unroll") for (int n = 0; n < 2; ++n) _Pragma("unroll") for (int k = 0; k < 2; ++k) \
        acc[ai][bj][m][n] = MFMA16(Bt[n][k], At[m][k], acc[ai][bj][m][n]); __builtin_amdgcn_s_setprio(0); } while (0)
#define PG8_WAIT_V(n) asm volatile("s_waitcnt vmcnt(" #n ")" ::: "memory")
#define PG8_WAIT_L(n) asm volatile("s_waitcnt lgkmcnt(" #n ")" ::: "memory")
#define PG8_BAR __builtin_amdgcn_s_barrier()
#define PG8_SCHED __builtin_amdgcn_sched_barrier(0)
    Unit cur, nxt; int ui = 0;
    if (!S.next(0, cur)) return;
    Acc acc;
#pragma unroll
    for (int a = 0; a < 2; ++a)
#pragma unroll
        for (int b = 0; b < 2; ++b)
#pragma unroll
            for (int m = 0; m < 4; ++m)
#pragma unroll
                for (int n = 0; n < 2; ++n) acc[a][b][m][n] = (f32x4){0.f, 0.f, 0.f, 0.f};
    bf16x8 At[4][2], B0[2][2], B1[2][2];
    const char* cA = (const char*)g.A + a_base(g, cur); const char* cB = (const char*)g.Bt + b_base(g, cur);
    PG8_STAGE(PG8_SB(0, 0), cB, voffB); PG8_STAGE(PG8_SB(0, 1), cB + hstepB, voffB); PG8_STAGE(PG8_SA(0, 0), cA, voffA); PG8_STAGE(PG8_SA(0, 1), cA + hstepA, voffA);
    PG8_STAGE(PG8_SB(1, 0), cB + kstep, voffB); PG8_STAGE(PG8_SA(1, 0), cA + kstep, voffA); PG8_STAGE(PG8_SB(1, 1), cB + hstepB + kstep, voffB);
    if (wr == 1) PG8_BAR;
    PG8_WAIT_V(8); PG8_BAR;
    PG8_WAIT_V(6); PG8_BAR;
    for (;;) {
        const bool has_next = S.next(ui + 1, nxt);
        const char* nA = has_next ? (const char*)g.A + a_base(g, nxt) : cA; const char* nB = has_next ? (const char*)g.Bt + b_base(g, nxt) : cB;
        const int nt = cur.ks >= 0 ? nts : ntf;
        for (int t = 0; t < nt; t += 2) {
            const bool last = (t == nt - 2);
            if constexpr (Epi::HOOK) { if (t == E.t1 || t == E.t2) E.mid(acc, cur, t == E.t2 ? 1 : 0, wr, wc, fr, fq); }
            const char* a1 = cA + (size_t)(t + 1) * kstep;
            const char* a2 = last ? nA : cA + (size_t)(t + 2) * kstep; const char* b2 = last ? nB : cB + (size_t)(t + 2) * kstep;
            const char* a3 = a2 + kstep; const char* b3 = b2 + kstep;
            PG8_LDB(B0, 0, 0); PG8_LDB(B1, 0, 1); PG8_SCHED; PG8_LDA(At, 0, 0); PG8_STAGE(PG8_SA(1, 1), a1 + hstepA, voffA);
            PG8_WAIT_V(8); PG8_WAIT_L(0); PG8_BAR; PG8_MMA(0, 0, At, B0); PG8_MMA(0, 1, At, B1); PG8_BAR; PG8_SCHED;
            PG8_LDA(At, 0, 1); PG8_STAGE(PG8_SB(0, 0), b2, voffB); PG8_STAGE(PG8_SB(0, 1), b2 + hstepB, voffB); PG8_STAGE(PG8_SA(0, 0), a2, voffA);
            PG8_WAIT_V(8); PG8_WAIT_L(0); PG8_BAR; PG8_MMA(1, 0, At, B0); PG8_MMA(1, 1, At, B1); PG8_BAR; PG8_SCHED;
            PG8_LDB(B0, 1, 0); PG8_LDB(B1, 1, 1); PG8_SCHED; PG8_LDA(At, 1, 0); PG8_STAGE(PG8_SA(0, 1), a2 + hstepA, voffA);
            PG8_WAIT_V(8); PG8_WAIT_L(0); PG8_BAR; PG8_MMA(0, 0, At, B0); PG8_MMA(0, 1, At, B1); PG8_BAR; PG8_SCHED;
            PG8_LDA(At, 1, 1); PG8_STAGE(PG8_SB(1, 0), b3, voffB); PG8_STAGE(PG8_SB(1, 1), b3 + hstepB, voffB); PG8_STAGE(PG8_SA(1, 0), a3, voffA);
            PG8_WAIT_V(8); PG8_WAIT_L(0); PG8_BAR; PG8_MMA(1, 0, At, B0); PG8_MMA(1, 1, At, B1); PG8_BAR; PG8_SCHED;
        }
        if (wr == 0) PG8_BAR;
        E(acc, cur, wr, wc, fr, fq);
        if (!has_next) break;
#pragma unroll
        for (int a = 0; a < 2; ++a)
#pragma unroll
            for (int b = 0; b < 2; ++b)
#pragma unroll
                for (int m = 0; m < 4; ++m)
#pragma unroll
                    for (int n = 0; n < 2; ++n) acc[a][b][m][n] = (f32x4){0.f, 0.f, 0.f, 0.f};
        cur = nxt; cA = nA; cB = nB; ++ui;
        if (wr == 1) PG8_BAR;
    }
    PG8_WAIT_V(0);
    PG8_BAR;
#undef PG8_SA
#undef PG8_SB
#undef PG8_STAGE
#undef PG8_LDA
#undef PG8_LDB
#undef PG8_MMA
#undef PG8_WAIT_V
#undef PG8_WAIT_L
#undef PG8_BAR
#undef PG8_SCHED
}

struct EpiBf16 {
    static constexpr bool PERM = true, HOOK = false;
    bf16_t* O; int ldc; int gcols;
    bf16_t* O2; int split_pn; int ldc2;
    __device__ __forceinline__ void operator()(const Acc& acc, const Unit& u, int wr, int wc, int fr, int fq) const {
        const bool second = u.pn >= split_pn; bf16_t* base = second ? O2 : O; const int ld = second ? ldc2 : ldc;
        const int row0 = u.pm * BM + wr * 64 + fr, col0 = u.g * gcols + (second ? u.pn - split_pn : u.pn) * BM + wc * 32 + 8 * fq;
#pragma unroll
        for (int ai = 0; ai < 2; ++ai)
#pragma unroll
            for (int m = 0; m < 4; ++m) { bf16_t* rowp = base + (size_t)(row0 + ai * HALF + m * 16) * ld + col0;
#pragma unroll
                for (int bj = 0; bj < 2; ++bj) { const f32x4 v0 = acc[ai][bj][m][0], v1 = acc[ai][bj][m][1];
                    u32x4 w; w.x = cvt_pk_bf16(v0[0], v0[1]); w.y = cvt_pk_bf16(v0[2], v0[3]); w.z = cvt_pk_bf16(v1[0], v1[1]); w.w = cvt_pk_bf16(v1[2], v1[3]);
                    *(u32x4*)(rowp + bj * HALF) = w; } }
    }
};
struct EpiSwiGLU {
    static constexpr bool PERM = true, HOOK = false;
    bf16_t* O; int ldc;
    __device__ __forceinline__ void operator()(const Acc& acc, const Unit& u, int wr, int wc, int fr, int fq) const {
        const int row0 = u.pm * BM + wr * 64 + fr, col0 = u.pn * HALF + wc * 32 + 8 * fq;
#pragma unroll
        for (int ai = 0; ai < 2; ++ai)
#pragma unroll
            for (int m = 0; m < 4; ++m) { bf16_t* rowp = O + (size_t)(row0 + ai * HALF + m * 16) * ldc + col0;
                float o[8];
#pragma unroll
                for (int n = 0; n < 2; ++n)
#pragma unroll
                    for (int j = 0; j < 4; ++j) { const float gg = acc[ai][0][m][n][j], uu = acc[ai][1][m][n][j]; o[n * 4 + j] = gg * uu * __builtin_amdgcn_rcpf(1.0f + __expf(-gg)); }
                u32x4 w; w.x = cvt_pk_bf16(o[0], o[1]); w.y = cvt_pk_bf16(o[2], o[3]); w.z = cvt_pk_bf16(o[4], o[5]); w.w = cvt_pk_bf16(o[6], o[7]);
                *(u32x4*)rowp = w; }
    }
};
struct EpiResid {
    static constexpr bool PERM = false, HOOK = false;
    float* X; const float* gvec; float coef; float alpha; int lnid; const float* xin;
    __device__ __forceinline__ void partial(const Acc& acc, const Unit& u, int wr, int wc, int fr, int fq) const {
        asm volatile("; K-split partial tile" ::: "memory");
        float* P = (float*)((char*)X + (WS_R + R_PART - WS_X));
        float* base = P + ((size_t)u.ks * 1024 + (u.pm / 17) * 256 + wr * 64 + fr) * D + u.pn * BM + wc * 32 + 4 * fq;
#pragma unroll
        for (int ai = 0; ai < 2; ++ai)
#pragma unroll
            for (int m = 0; m < 4; ++m) { float* rowp = base + (size_t)(ai * HALF + m * 16) * D;
#pragma unroll
                for (int bj = 0; bj < 2; ++bj)
#pragma unroll
                    for (int n = 0; n < 2; ++n) *(f32x4*)(rowp + bj * HALF + n * 16) = acc[ai][bj][m][n]; }
    }
    __device__ __forceinline__ void whole(const Acc& acc, const Unit& u, int wr, int wc, int fr, int fq) const {
        const int row0 = u.pm * BM + wr * 64 + fr, col0 = u.pn * BM + wc * 32 + 4 * fq;
        const float* gp = gvec + (size_t)modrow_of_panel(u.pm) * 18432 + col0;
        const f32x4 g00 = *(const f32x4*)(gp) * coef, g01 = *(const f32x4*)(gp + 16) * coef, g10 = *(const f32x4*)(gp + HALF) * coef, g11 = *(const f32x4*)(gp + HALF + 16) * coef;
        const float* lp = (const float*)((const char*)X + ((long)WS_LNT - (long)WS_X)) + lnid * 4096 + col0;
        const f32x4 ga00 = *(const f32x4*)(lp) * alpha, ga01 = *(const f32x4*)(lp + 16) * alpha, ga10 = *(const f32x4*)(lp + HALF) * alpha, ga11 = *(const f32x4*)(lp + HALF + 16) * alpha;
        const f32x4 be00 = *(const f32x4*)(lp + 2048) * alpha, be01 = *(const f32x4*)(lp + 2048 + 16) * alpha, be10 = *(const f32x4*)(lp + 2048 + HALF) * alpha, be11 = *(const f32x4*)(lp + 2048 + HALF + 16) * alpha;
        const float* st = (const float*)((const char*)X + ((long)WS_STATS - (long)WS_X)) + 2 * row0;
        const long dlt = xin ? (long)((const char*)(xin + ((size_t)(u.pm / 17) * SEQ + (size_t)(u.pm % 17 - 1) * BM) * D) - (const char*)(X + (size_t)u.pm * BM * D)) : 0l;
#pragma unroll
        for (int ai = 0; ai < 2; ++ai)
#pragma unroll
            for (int m2 = 0; m2 < 4; m2 += 2) {
                float* rp0 = X + (size_t)(row0 + ai * HALF + m2 * 16) * D + col0; float* rp1 = rp0 + (size_t)16 * D;
                const f32x4 xa0 = *(const f32x4*)((const char*)rp0 + dlt), xa1 = *(const f32x4*)((const char*)(rp0 + 16) + dlt), xa2 = *(const f32x4*)((const char*)(rp0 + HALF) + dlt), xa3 = *(const f32x4*)((const char*)(rp0 + HALF + 16) + dlt);
                const f32x4 xb0 = *(const f32x4*)((const char*)rp1 + dlt), xb1 = *(const f32x4*)((const char*)(rp1 + 16) + dlt), xb2 = *(const f32x4*)((const char*)(rp1 + HALF) + dlt), xb3 = *(const f32x4*)((const char*)(rp1 + HALF + 16) + dlt);
                { const int m = m2; const float mu = st[2 * (ai * HALF + m * 16)], rs = st[2 * (ai * HALF + m * 16) + 1]; const float nm = -mu * rs;
                  *(f32x4*)(rp0) = (xa0 * rs + nm) * ga00 + be00 + g00 * acc[ai][0][m][0]; *(f32x4*)(rp0 + 16) = (xa1 * rs + nm) * ga01 + be01 + g01 * acc[ai][0][m][1];
                  *(f32x4*)(rp0 + HALF) = (xa2 * rs + nm) * ga10 + be10 + g10 * acc[ai][1][m][0]; *(f32x4*)(rp0 + HALF + 16) = (xa3 * rs + nm) * ga11 + be11 + g11 * acc[ai][1][m][1]; }
                { const int m = m2 + 1; const float mu = st[2 * (ai * HALF + m * 16)], rs = st[2 * (ai * HALF + m * 16) + 1]; const float nm = -mu * rs;
                  *(f32x4*)(rp1) = (xb0 * rs + nm) * ga00 + be00 + g00 * acc[ai][0][m][0]; *(f32x4*)(rp1 + 16) = (xb1 * rs + nm) * ga01 + be01 + g01 * acc[ai][0][m][1];
                  *(f32x4*)(rp1 + HALF) = (xb2 * rs + nm) * ga10 + be10 + g10 * acc[ai][1][m][0]; *(f32x4*)(rp1 + HALF + 16) = (xb3 * rs + nm) * ga11 + be11 + g11 * acc[ai][1][m][1]; }
                asm volatile("" ::: "memory"); }
    }
    __device__ __forceinline__ void operator()(const Acc& acc, const Unit& u, int wr, int wc, int fr, int fq) const { if (u.ks >= 0) partial(acc, u, wr, wc, fr, fq); else whole(acc, u, wr, wc, fr, fq); }
};
struct EpiGate {
    static constexpr bool PERM = true, HOOK = false;
    bf16_t* O; const float* bias; int ldc;
    __device__ __forceinline__ void operator()(const Acc& acc, const Unit& u, int wr, int wc, int fr, int fq) const {
        const int row0 = u.pm * BM + wr * 64 + fr, col0 = u.pn * BM + wc * 32 + 8 * fq;
        f32x4 bv[2][2];
#pragma unroll
        for (int bj = 0; bj < 2; ++bj)
#pragma unroll
            for (int n = 0; n < 2; ++n) bv[bj][n] = *(const f32x4*)(bias + col0 + bj * HALF + 4 * n);
#pragma unroll
        for (int ai = 0; ai < 2; ++ai)
#pragma unroll
            for (int m = 0; m < 4; ++m) { bf16_t* rowp = O + (size_t)(row0 + ai * HALF + m * 16) * ldc + col0;
#pragma unroll
                for (int bj = 0; bj < 2; ++bj) { f32x4 v0 = acc[ai][bj][m][0] + bv[bj][0], v1 = acc[ai][bj][m][1] + bv[bj][1];
#pragma unroll
                    for (int j = 0; j < 4; ++j) { v0[j] = __builtin_amdgcn_rcpf(1.0f + __expf(-v0[j])); v1[j] = __builtin_amdgcn_rcpf(1.0f + __expf(-v1[j])); }
                    u32x4 w; w.x = cvt_pk_bf16(v0[0], v0[1]); w.y = cvt_pk_bf16(v0[2], v0[3]); w.z = cvt_pk_bf16(v1[0], v1[1]); w.w = cvt_pk_bf16(v1[2], v1[3]);
                    *(u32x4*)(rowp + bj * HALF) = w; } }
    }
};
template <int MODE> struct EpiMerge {
    static constexpr bool PERM = true, HOOK = false;
    const bf16_t* G; float* Yf; bf16_t* Yb; float gs;
    __device__ __forceinline__ void operator()(const Acc& acc, const Unit& u, int wr, int wc, int fr, int fq) const {
        const int row0 = u.pm * BM + wr * 64 + fr, col0 = u.pn * BM + wc * 32 + 8 * fq;
#pragma unroll
        for (int ai = 0; ai < 2; ++ai)
#pragma unroll
            for (int m = 0; m < 4; ++m) { const size_t r = (size_t)(row0 + ai * HALF + m * 16);
#pragma unroll
                for (int bj = 0; bj < 2; ++bj) { const int c = col0 + bj * HALF;
#ifdef DBG_GHALF
                    const u32x4 gw = (u32x4){0x3f003f00u, 0x3f003f00u, 0x3f003f00u, 0x3f003f00u};
#else
                    const u32x4 gw = *(const u32x4*)(G + r * GATE_IN + c);
#endif
                    f32x4 v0 = acc[ai][bj][m][0], v1 = acc[ai][bj][m][1];
                    v0[0] *= bf_lo(gw.x); v0[1] *= bf_hi(gw.x); v0[2] *= bf_lo(gw.y); v0[3] *= bf_hi(gw.y);
                    v1[0] *= bf_lo(gw.z); v1[1] *= bf_hi(gw.z); v1[2] *= bf_lo(gw.w); v1[3] *= bf_hi(gw.w); v0 *= gs; v1 *= gs;
                    float* yp = Yf + r * D + c;
                    if (MODE >= 1) { v0 += *(const f32x4*)yp; v1 += *(const f32x4*)(yp + 4); }
                    if (MODE <= 1) { *(f32x4*)yp = v0; *(f32x4*)(yp + 4) = v1; }
                    else { u32x4 w; w.x = cvt_pk_bf16(v0[0], v0[1]); w.y = cvt_pk_bf16(v0[2], v0[3]); w.z = cvt_pk_bf16(v1[0], v1[1]); w.w = cvt_pk_bf16(v1[2], v1[3]);
                        *(u32x4*)(Yb + r * D + c) = w; } }
                asm volatile("" ::: "memory"); }
    }
};
struct EpiMergeOne {
    static constexpr bool PERM = true, HOOK = true;
    const bf16_t* G; bf16_t* Yb; int t1, t2; LAS unsigned* flag;
    __device__ __forceinline__ void mid(Acc& acc, const Unit& u, int seg, int wr, int wc, int fr, int fq) const {
        const int row0 = u.pm * BM + wr * 64 + fr, col0 = u.pn * BM + wc * 32 + 8 * fq;
        const bf16_t* gp = G + (size_t)row0 * GATE_IN + seg * 2048 + col0;
#pragma unroll
        for (int ai = 0; ai < 2; ++ai)
#pragma unroll
            for (int m = 0; m < 4; ++m) { const bf16_t* rp = gp + (size_t)(ai * HALF + m * 16) * GATE_IN;
                const u32x4 a0 = *(const u32x4*)(rp), b0 = *(const u32x4*)(rp + 2048), a1 = *(const u32x4*)(rp + HALF), b1 = *(const u32x4*)(rp + 2048 + HALF);
                float ga[8], gb[8];
                unpack8(a0, ga); unpack8(b0, gb);
#pragma unroll
                for (int j = 0; j < 4; ++j) { acc[ai][0][m][0][j] *= ga[j] * __builtin_amdgcn_rcpf(gb[j]); acc[ai][0][m][1][j] *= ga[4 + j] * __builtin_amdgcn_rcpf(gb[4 + j]); }
                unpack8(a1, ga); unpack8(b1, gb);
#pragma unroll
                for (int j = 0; j < 4; ++j) { acc[ai][1][m][0][j] *= ga[j] * __builtin_amdgcn_rcpf(gb[j]); acc[ai][1][m][1][j] *= ga[4 + j] * __builtin_amdgcn_rcpf(gb[4 + j]); }
                asm volatile("" ::: "memory"); }
    }
    __device__ __forceinline__ void partial(const Acc& acc, const Unit& u, int wr, int wc, int fr, int fq) const {
        asm volatile("; K-split gated partial tile" ::: "memory");
        const int seg = (u.ks + 1) >> 1, bt = u.pm / 17;
        const int row0 = u.pm * BM + wr * 64 + fr, col0 = u.pn * BM + wc * 32 + 8 * fq;
        float* P = (float*)((char*)Yb + (R_PART - R_Y2B));
        { float* pb = P + ((size_t)u.ks * 1024 + bt * 256 + wr * 64 + fr) * D + col0;
#pragma unroll
        for (int ai = 0; ai < 2; ++ai)
#pragma unroll
            for (int m = 0; m < 4; ++m) { const size_t r = (size_t)(row0 + ai * HALF + m * 16);
#pragma unroll
                for (int bj = 0; bj < 2; ++bj) { const int c = col0 + bj * HALF; float g[8]; unpack8(*(const u32x4*)(G + r * GATE_IN + seg * 2048 + c), g);
                    const f32x4 v0 = acc[ai][bj][m][0], v1 = acc[ai][bj][m][1];
                    float* q = pb + (size_t)(ai * HALF + m * 16) * D + bj * HALF;
                    *(f32x4*)q = (f32x4){v0[0] * g[0], v0[1] * g[1], v0[2] * g[2], v0[3] * g[3]}; *(f32x4*)(q + 4) = (f32x4){v1[0] * g[4], v1[1] * g[5], v1[2] * g[6], v1[3] * g[7]}; }
                asm volatile("" ::: "memory"); } }
        asm volatile("s_waitcnt vmcnt(0)" ::: "memory");
        __builtin_amdgcn_s_barrier();
        const int tid = ((wr * 4 + wc) << 6) + (fq << 4) + fr;
        if (tid == 0) { unsigned* cnt = (unsigned*)((char*)Yb - (WS_R + R_Y2B - WS_CTL)) + 4096 + 16 * (bt + 4 * u.pn);
            __builtin_amdgcn_fence(__ATOMIC_RELEASE, "agent");
            const unsigned old = __hip_atomic_fetch_add(cnt, 1u, __ATOMIC_RELAXED, __HIP_MEMORY_SCOPE_AGENT);
            if (old == 3u) __builtin_amdgcn_fence(__ATOMIC_ACQUIRE, "agent");
            *(volatile LAS unsigned*)flag = old; asm volatile("s_waitcnt lgkmcnt(0)" ::: "memory"); }
        __builtin_amdgcn_s_barrier();
        if (*(volatile LAS unsigned*)flag == 3u) {
            const float* src = P + ((size_t)bt * 256 + (tid >> 5)) * D + u.pn * BM + (tid & 31) * 8;
            bf16_t* dst = Yb + ((size_t)u.pm * BM + (tid >> 5)) * D + u.pn * BM + (tid & 31) * 8;
#pragma unroll 4
            for (int it = 0; it < 16; ++it) { const float* sp = src + (size_t)it * 16 * D;
                f32x4 s0 = *(const f32x4*)sp, s1 = *(const f32x4*)(sp + 4);
#pragma unroll
                for (int k = 1; k < 4; ++k) { s0 += *(const f32x4*)(sp + (size_t)k * 1024 * D); s1 += *(const f32x4*)(sp + (size_t)k * 1024 * D + 4); }
                u32x4 w; w.x = cvt_pk_bf16(s0[0], s0[1]); w.y = cvt_pk_bf16(s0[2], s0[3]); w.z = cvt_pk_bf16(s1[0], s1[1]); w.w = cvt_pk_bf16(s1[2], s1[3]);
                *(u32x4*)(dst + (size_t)it * 16 * D) = w; }
        }
    }
    __device__ __forceinline__ void operator()(const Acc& acc, const Unit& u, int wr, int wc, int fr, int fq) const {
        if (u.ks >= 0) { partial(acc, u, wr, wc, fr, fq); return; }
        const int row0 = u.pm * BM + wr * 64 + fr, col0 = u.pn * BM + wc * 32 + 8 * fq;
#pragma unroll
        for (int ai = 0; ai < 2; ++ai)
#pragma unroll
            for (int m = 0; m < 4; ++m) { const size_t r = (size_t)(row0 + ai * HALF + m * 16);
#pragma unroll
                for (int bj = 0; bj < 2; ++bj) { const int c = col0 + bj * HALF; float g[8]; unpack8(*(const u32x4*)(G + r * GATE_IN + 4096 + c), g);
                    const f32x4 v0 = acc[ai][bj][m][0], v1 = acc[ai][bj][m][1];
                    u32x4 w; w.x = cvt_pk_bf16(v0[0] * g[0], v0[1] * g[1]); w.y = cvt_pk_bf16(v0[2] * g[2], v0[3] * g[3]); w.z = cvt_pk_bf16(v1[0] * g[4], v1[1] * g[5]); w.w = cvt_pk_bf16(v1[2] * g[6], v1[3] * g[7]);
                    *(u32x4*)(Yb + r * D + c) = w; }
                asm volatile("" ::: "memory"); }
    }
};
}
namespace att {
constexpr int NW = 8, QBLK = 32, KVBLK = 64;
constexpr float SCALE = 0.072168783648703216f;
constexpr float THR = 8.f;
constexpr int SDEPTH = 1;
constexpr int LDQ = 3072, LDK = 2048, LDR = 64, LDV = 2048, LDO = 4096;
constexpr int NQREG = 6;
constexpr int SHM_V = KVBLK * VD * 2, SHM_K = KVBLK * QKD * 2, SHM_QS = 2 * SHM_V + 2 * SHM_K + NW * 64 * 4, SHM_ATTN = SHM_QS + (12 - NQREG) * 8192;
#define KSWZ(row, colB) ((row) * 384 + ((colB) ^ ((((row) >> 1) & 7) << 4)))
#define SBAR() __builtin_amdgcn_sched_barrier(0)
__device__ __forceinline__ int crow(int r, int hi) { return (r & 3) + 8 * (r >> 2) + 4 * hi; }

__device__ __forceinline__ void partialSM(f32x16& p0, f32x16& p1, float& m_reg, float& mn, float& alpha) {
  constexpr float C = SCALE * 1.4426950408889634f;
  float pmax = p0[0];
#pragma unroll
  for (int r = 1; r < 16; ++r) pmax = fmaxf(pmax, p0[r]);
#pragma unroll
  for (int r = 0; r < 16; ++r) pmax = fmaxf(pmax, p1[r]);
  { auto rr = __builtin_amdgcn_permlane32_swap(__float_as_uint(pmax), __float_as_uint(pmax), false, false);
    pmax = fmaxf(__uint_as_float(rr[0]), __uint_as_float(rr[1])); }
  if (__builtin_expect(__all(pmax - m_reg <= THR / SCALE), 1)) { mn = m_reg; alpha = 1.f; }
  else { mn = fmaxf(m_reg, pmax); alpha = __builtin_amdgcn_exp2f((m_reg - mn) * C); m_reg = mn; }
  float mnC = -mn * C;
#pragma unroll
  for (int r = 0; r < 16; ++r) p0[r] = fmaf(p0[r], C, mnC);
#pragma unroll
  for (int r = 0; r < 16; ++r) p1[r] = fmaf(p1[r], C, mnC);
#pragma unroll
  for (int r = 0; r < 16; ++r) p0[r] = __builtin_amdgcn_exp2f(p0[r]);
}
__device__ __forceinline__ void finishSM(f32x16& p0, f32x16& p1, float alpha, float& l_reg, bf16x8& pa0, bf16x8& pa1, bf16x8& pa2, bf16x8& pa3) {
#pragma unroll
  for (int r = 0; r < 16; ++r) p1[r] = __builtin_amdgcn_exp2f(p1[r]);
  float ps = 0;
#pragma unroll
  for (int r = 0; r < 16; ++r) ps += p0[r];
#pragma unroll
  for (int r = 0; r < 16; ++r) ps += p1[r];
  { auto rr = __builtin_amdgcn_permlane32_swap(__float_as_uint(ps), __float_as_uint(ps), false, false);
    ps = __uint_as_float(rr[0]) + __uint_as_float(rr[1]); }
  l_reg = l_reg * alpha + ps;
#define PK4(P, BASE, OUT) do { unsigned a0 = cvt_pk_bf16(P[BASE + 0], P[BASE + 1]), a1 = cvt_pk_bf16(P[BASE + 2], P[BASE + 3]);   \
    unsigned b0 = cvt_pk_bf16(P[BASE + 4], P[BASE + 5]), b1 = cvt_pk_bf16(P[BASE + 6], P[BASE + 7]);                              \
    auto r0 = __builtin_amdgcn_permlane32_swap(a0, b0, false, false); auto r1 = __builtin_amdgcn_permlane32_swap(a1, b1, false, false); \
    u32x4 w = {r0[0], r1[0], r0[1], r1[1]}; OUT = *reinterpret_cast<bf16x8*>(&w); } while (0)
  PK4(p0, 0, pa0); PK4(p0, 8, pa1); PK4(p1, 0, pa2); PK4(p1, 8, pa3);
#undef PK4
}
__device__ __forceinline__ void qkt(f32x16& p0, f32x16& p1, const char* Ks, const bf16x8* qr, const char* qsp, int r32, int hi) {
  p0 = f32x16{}; p1 = f32x16{};
#pragma unroll
  for (int d0 = 0; d0 < 12; ++d0) { const int cb = (d0 * 16 + hi * 8) * 2;
    bf16x8 b0 = *reinterpret_cast<const bf16x8*>(Ks + KSWZ(r32, cb));
    bf16x8 b1 = *reinterpret_cast<const bf16x8*>(Ks + KSWZ(32 + r32, cb));
    bf16x8 qv; if (d0 < NQREG) qv = qr[d0]; else qv = *reinterpret_cast<const bf16x8*>(qsp + (d0 - NQREG) * 8192);
    p0 = MFMA32(b0, qv, p0);
    p1 = MFMA32(b1, qv, p1);
    if (d0 == 5) SBAR(); }
}
__device__ __forceinline__ int v_st(int k, int c) { const int kk = (k & ~0xC) | ((k & 4) << 1) | ((k & 8) >> 1); return ((kk >> 3) * 4 + (c >> 5)) * 512 + ((kk & 7) * 32 + (c & 31)) * 2; }
__device__ __forceinline__ int v_rd_base(int lane) { return ((lane & 3) << 3) | (((lane >> 2) & 3) << 6) | (((lane >> 4) & 1) << 5) | (((lane >> 5) & 1) << 8); }
constexpr int v_rd_off(int d0, int ks, int half) { return d0 * 512 + ks * 4096 + half * 2048; }
template <int OFF> __device__ __forceinline__ s16x4 tr_read(int vb) {
  s16x4 r; asm volatile("ds_read_b64_tr_b16 %0, %1 offset:%2" : "=&v"(r) : "v"(vb), "i"(OFF) : "memory"); return r;
}
template <int D0> __device__ __forceinline__ void pv_one(f32x16& od, int vb, bf16x8 pa0, bf16x8 pa1, bf16x8 pa2, bf16x8 pa3) {
  const s16x4 l0 = tr_read<v_rd_off(D0, 0, 0)>(vb), h0 = tr_read<v_rd_off(D0, 0, 1)>(vb), l1 = tr_read<v_rd_off(D0, 1, 0)>(vb), h1 = tr_read<v_rd_off(D0, 1, 1)>(vb);
  const s16x4 l2 = tr_read<v_rd_off(D0, 2, 0)>(vb), h2 = tr_read<v_rd_off(D0, 2, 1)>(vb), l3 = tr_read<v_rd_off(D0, 3, 0)>(vb), h3 = tr_read<v_rd_off(D0, 3, 1)>(vb);
  asm volatile("s_waitcnt lgkmcnt(0)" ::: "memory"); SBAR();
#define PK(L, H) (bf16x8){L[0], L[1], L[2], L[3], H[0], H[1], H[2], H[3]}
  od = MFMA32(pa0, PK(l0, h0), od);
  od = MFMA32(pa1, PK(l1, h1), od);
  od = MFMA32(pa2, PK(l2, h2), od);
  od = MFMA32(pa3, PK(l3, h3), od);
#undef PK
}
__device__ __forceinline__ void pv_d0(f32x16* o, int vb, bf16x8 pa0, bf16x8 pa1, bf16x8 pa2, bf16x8 pa3) {
  pv_one<0>(o[0], vb, pa0, pa1, pa2, pa3); pv_one<1>(o[1], vb, pa0, pa1, pa2, pa3); pv_one<2>(o[2], vb, pa0, pa1, pa2, pa3); pv_one<3>(o[3], vb, pa0, pa1, pa2, pa3);
}
__device__ __forceinline__ void attn_body(const bf16_t* __restrict__ Qb, const bf16_t* __restrict__ Kh, const bf16_t* __restrict__ Rh, const bf16_t* __restrict__ Vh, bf16_t* __restrict__ Ob, int seq, const float* __restrict__ rope  , char* lds) {
  int tid_ = threadIdx.x; asm volatile("" : "+v"(tid_));
  const int tid = tid_, wid = tid >> 6, lane = tid & 63, r32 = lane & 31, hi = lane >> 5;
  char* V_lds = lds; char* K_lds = lds + 2 * SHM_V;
  float* ws = (float*)(lds + 2 * SHM_V + 2 * SHM_K) + wid * 64; float* li_l = ws; float* al_l = ws + 32;
  float m_reg = -1e30f, l_reg = 0; f32x16 o[4] = {}; bf16x8 qr[NQREG];
  const bf16_t* Qw = Qb + (long)(wid * QBLK + r32) * LDQ + hi * 8;
  char* qsp = lds + SHM_QS + tid * 16;
#pragma unroll
  for (int d0 = 0; d0 < 12; ++d0) { bf16x8 qv = *reinterpret_cast<const bf16x8*>(Qw + d0 * 16);
    if (d0 >= 8 && rope) {
      const f32x4* cs = reinterpret_cast<const f32x4*>(rope + ((long)(wid * QBLK + r32) * 32 + (d0 - 8) * 8 + hi * 4) * 2); const f32x4 c0 = cs[0], c1 = cs[1];
      const u32x4 w = *reinterpret_cast<const u32x4*>(&qv);
      const float x0 = bf_lo(w.x), x1 = bf_hi(w.x), x2 = bf_lo(w.y), x3 = bf_hi(w.y), x4 = bf_lo(w.z), x5 = bf_hi(w.z), x6 = bf_lo(w.w), x7 = bf_hi(w.w);
      u32x4 o; o.x = cvt_pk_bf16(x0 * c0[0] - x1 * c0[1], x0 * c0[1] + x1 * c0[0]); o.y = cvt_pk_bf16(x2 * c0[2] - x3 * c0[3], x2 * c0[3] + x3 * c0[2]);
      o.z = cvt_pk_bf16(x4 * c1[0] - x5 * c1[1], x4 * c1[1] + x5 * c1[0]); o.w = cvt_pk_bf16(x6 * c1[2] - x7 * c1[3], x6 * c1[3] + x7 * c1[2]);
      qv = *reinterpret_cast<const bf16x8*>(&o); }
    if (d0 < NQREG) qr[d0] = qv; else *reinterpret_cast<bf16x8*>(qsp + (d0 - NQREG) * 8192) = qv; }
  const int sr = tid >> 4, sc = (tid & 15) * 8, vst0 = v_st(sr, sc);
  const int krow = tid >> 3, kc = tid & 7, kst = krow * 384 + ((kc * 16) ^ (((krow >> 1) & 7) << 4));
  const bf16_t* Vg = Vh + (long)sr * LDV + sc; const bf16_t* Kg = Kh + (long)krow * LDK + kc * 8; const bf16_t* Rg = Rh + (long)krow * LDR + kc * 8;
  const int vb0 = (int)(uintptr_t)V_lds + v_rd_base(lane);
  struct { bf16x8 vs0, vs1, ks0, ks1, ks2; } sr_[SDEPTH];
#define SLOAD(i, k0) do { sr_[i].vs0 = *reinterpret_cast<const bf16x8*>(Vg + (long)(k0) * LDV); sr_[i].vs1 = *reinterpret_cast<const bf16x8*>(Vg + (long)((k0) + 32) * LDV); \
    sr_[i].ks0 = *reinterpret_cast<const bf16x8*>(Kg + (long)(k0) * LDK); sr_[i].ks1 = *reinterpret_cast<const bf16x8*>(Kg + (long)(k0) * LDK + 64); \
    sr_[i].ks2 = *reinterpret_cast<const bf16x8*>(Rg + (long)(k0) * LDR); } while (0)
#define SWRITE(b, i) do { *(bf16x8*)(V_lds + (b) * SHM_V + vst0) = sr_[i].vs0; *(bf16x8*)(V_lds + (b) * SHM_V + vst0 + 8192) = sr_[i].vs1; \
    *(bf16x8*)(K_lds + (b) * SHM_K + kst) = sr_[i].ks0; *(bf16x8*)(K_lds + (b) * SHM_K + kst + 128) = sr_[i].ks1; *(bf16x8*)(K_lds + (b) * SHM_K + kst + 256) = sr_[i].ks2; } while (0)
#define SWAIT() do { if constexpr (SDEPTH == 2) asm volatile("s_waitcnt vmcnt(5)" ::: "memory"); else asm volatile("s_waitcnt vmcnt(0)" ::: "memory"); } while (0)
#define RESC(a) do { if (__any((a) < 1.f)) { if (hi == 0) al_l[r32] = (a); asm volatile("s_waitcnt lgkmcnt(0)" ::: "memory"); \
    _Pragma("unroll") for (int d = 0; d < 4; ++d) _Pragma("unroll") for (int r = 0; r < 16; ++r) o[d][r] *= al_l[crow(r, hi)]; } } while (0)
  f32x16 pA0, pA1, pB0, pB1; float mnA, mnB, alA, alB; bf16x8 pa0, pa1, pa2, pa3; const int NT = seq / KVBLK;
  constexpr int SE = 0, SO = SDEPTH - 1;
  SLOAD(SE, 0); asm volatile("s_waitcnt vmcnt(0)" ::: "memory"); SWRITE(0, SE); __syncthreads();
  qkt(pA0, pA1, K_lds, qr, qsp, r32, hi); partialSM(pA0, pA1, m_reg, mnA, alA);
  SLOAD(SO, KVBLK); if constexpr (SDEPTH == 2) { if (2 < NT) SLOAD(SE, 2 * KVBLK); }
  SWAIT(); SWRITE(1, SO); __syncthreads();
  for (int j = 1; j + 1 < NT; j += 2) {
    SBAR(); qkt(pB0, pB1, K_lds + SHM_K, qr, qsp, r32, hi);
    finishSM(pA0, pA1, alA, l_reg, pa0, pa1, pa2, pa3); SBAR();
    SLOAD(SO, (j + SDEPTH) * KVBLK); SBAR();
    pv_d0(o, vb0, pa0, pa1, pa2, pa3); partialSM(pB0, pB1, m_reg, mnB, alB);
    __syncthreads(); SWAIT(); SWRITE(0, SE);
    RESC(alB); __syncthreads();
    SBAR(); qkt(pA0, pA1, K_lds, qr, qsp, r32, hi);
    finishSM(pB0, pB1, alB, l_reg, pa0, pa1, pa2, pa3); SBAR();
    if (SDEPTH == 1 || j + 3 < NT) SLOAD(SE, (j + 1 + SDEPTH) * KVBLK); SBAR();
    pv_d0(o, vb0 + (int)SHM_V, pa0, pa1, pa2, pa3); partialSM(pA0, pA1, m_reg, mnA, alA);
    __syncthreads(); SWAIT(); SWRITE(1, SO);
    RESC(alA); __syncthreads();
  }
  SBAR(); qkt(pB0, pB1, K_lds + SHM_K, qr, qsp, r32, hi);
  finishSM(pA0, pA1, alA, l_reg, pa0, pa1, pa2, pa3); SBAR();
  pv_d0(o, vb0, pa0, pa1, pa2, pa3); partialSM(pB0, pB1, m_reg, mnB, alB);
  __syncthreads(); RESC(alB);
  finishSM(pB0, pB1, alB, l_reg, pa0, pa1, pa2, pa3); SBAR();
  pv_d0(o, vb0 + (int)SHM_V, pa0, pa1, pa2, pa3);
  if (hi == 0) li_l[r32] = l_reg; asm volatile("s_waitcnt lgkmcnt(0)" ::: "memory");
  float rli[16];
#pragma unroll
  for (int r = 0; r < 16; ++r) rli[r] = __builtin_amdgcn_rcpf(li_l[crow(r, hi)]);
  bf16_t* Ow = Ob + (long)(wid * QBLK) * LDO;
#pragma unroll
  for (int r = 0; r < 16; ++r) { const int orow = crow(r, hi);
#pragma unroll
    for (int d0 = 0; d0 < 4; ++d0) Ow[(long)orow * LDO + d0 * 32 + r32] = f2bf(o[d0][r] * rli[r]); }
#undef SLOAD
#undef SWRITE
#undef SWAIT
#undef RESC
}
}
#define RLX_AGENT __ATOMIC_RELAXED, __HIP_MEMORY_SCOPE_AGENT
#define LDS_WAIT() asm volatile("s_waitcnt lgkmcnt(0)" ::: "memory")
#define VM_WAIT() asm volatile("s_waitcnt vmcnt(0)" ::: "memory")

#define XB_TMO      128
#define XB_XCNT(j)  (256  + 64 * (j))
#define XB_XSUB(j)  (1280 + 64 * (j))
#define XB_XGEN(j)  (2304 + 64 * (j))
#define XB_TOP      3328
#define XB_TOPGEN   3392
#define XCD_BAR_WORDS 3456
#define XB_SPIN_CAP (1u << 22)
__device__ __forceinline__ unsigned xb_ld(unsigned* p)              { return __hip_atomic_load(p, __ATOMIC_RELAXED, __HIP_MEMORY_SCOPE_AGENT); }
__device__ __forceinline__ unsigned xb_add(unsigned* p, unsigned v) { return __hip_atomic_fetch_add(p, v, __ATOMIC_RELAXED, __HIP_MEMORY_SCOPE_AGENT); }
__device__ __forceinline__ unsigned xb_xcc_id() { return (unsigned)__builtin_amdgcn_s_getreg((3 << 11) | 20) & 0xFu; }
#define XB_SPIN(cond, bar) do { unsigned _sp = 0; while (cond) { __builtin_amdgcn_s_sleep(1); \
    if ((++_sp & 255u) == 0u) { if (xb_ld(&(bar)[XB_TMO])) break; if (_sp > XB_SPIN_CAP) { atomicAdd(&(bar)[XB_TMO], 1u); break; } } } } while (0)
struct XcdBarrier { unsigned* bar; unsigned x; volatile LAS unsigned* st; };
__device__ __forceinline__ XcdBarrier xcd_barrier_post(unsigned* bar, volatile LAS unsigned* st) {
    XcdBarrier b; b.bar = bar; b.x = xb_xcc_id(); b.st = st;
    if (threadIdx.x == 0) (void)xb_add(&bar[XB_XCNT(b.x)], 1u);
    return b;
}
__device__ __forceinline__ void xcd_barrier_complete(unsigned* bar, unsigned x, unsigned& nloc, unsigned& nx) {
    const unsigned G = gridDim.x * gridDim.y * gridDim.z;
    unsigned sum, cnt, mine, sp = 0u;
    for (;;) {
        sum = 0u; cnt = 0u; mine = 0u;
#pragma unroll
        for (unsigned j = 0; j < 16; ++j) { const unsigned c = xb_ld(&bar[XB_XCNT(j)]); sum += c; cnt += (c > 0u) ? 1u : 0u; mine = (j == x) ? c : mine; }
        if (sum == G) break;
        __builtin_amdgcn_s_sleep(1);
        if ((++sp & 255u) == 0u) { if (xb_ld(&bar[XB_TMO])) break; if (sp > XB_SPIN_CAP) { atomicAdd(&bar[XB_TMO], 1u); break; } }
    }
    nloc = mine > 0u ? mine : 1u; nx = cnt > 0u ? cnt : 1u;
}
__device__ __forceinline__ void xcd_barrier(const XcdBarrier& b) {
    asm volatile("s_waitcnt vmcnt(0)" ::: "memory");
    __syncthreads();
    if (threadIdx.x == 0) {
        unsigned* bar = b.bar;
        __builtin_amdgcn_s_waitcnt(0);
        unsigned nloc = b.st[0], nx = b.st[1];
        if (nloc == 0u) { xcd_barrier_complete(bar, b.x, nloc, nx); b.st[0] = nloc; b.st[1] = nx; }
        const unsigned old = xb_add(&bar[XB_XSUB(b.x)], 1u);
        const unsigned gen = old / nloc;
        if (old + 1u == (gen + 1u) * nloc) {
            __builtin_amdgcn_fence(__ATOMIC_RELEASE, "agent");
            asm volatile("s_waitcnt vmcnt(0)" ::: "memory");
            const unsigned og = xb_add(&bar[XB_TOP], 1u);
            const unsigned tg = og / nx;
            if (og + 1u == (tg + 1u) * nx) xb_add(&bar[XB_TOPGEN], 1u);
            else XB_SPIN(xb_ld(&bar[XB_TOPGEN]) == tg, bar);
            __builtin_amdgcn_fence(__ATOMIC_ACQUIRE, "agent");
            xb_add(&bar[XB_XGEN(b.x)], 1u);
            asm volatile("s_waitcnt vmcnt(0)" ::: "memory");
        } else {
            XB_SPIN(xb_ld(&bar[XB_XGEN(b.x)]) == gen, bar);
            __builtin_amdgcn_fence(__ATOMIC_ACQUIRE, "agent");
            asm volatile("s_waitcnt vmcnt(0)" ::: "memory");
        }
    }
    __syncthreads();
}

enum { I_X = 0, I_C, I_CTX, I_CCTX, I_ADAW, I_ADAB, I_LNG, I_LNB, I_WGATE, I_WUP, I_WDOWN, I_WIN, I_GATEB, I_MU, I_W0, I_WUPL, I_A0, I_AUP, I_GUP, I_KK, I_KA, I_RK, I_LNXG, I_LNXB,
       I_QNORM, I_KVNORM, I_WUQ, I_WUK, I_WUV, I_CONVW, I_CONVB, I_LRUWA, I_LRUBA, I_LRUWX, I_LRUBX, I_LAMBDA, I_PRWKV, I_PMLA, I_PLRU, I_WOUT };

struct Ctx {
    LAS unsigned char* lds; unsigned char* ws; const float* const __attribute__((address_space(4)))* in; float* out;
    int tid, lane, wave, G, vcu, gw, NGW;
};

constexpr int MODP_KC = 14;
__device__ __forceinline__ void ph_modp(Ctx& F) {
    LAS float* sl = (LAS float*)F.lds;
    for (int i = F.tid; i < 5 * 2048; i += 512) { const int r = i >> 11, k = i & 2047; const float v = r < 4 ? F.in[I_C][r * 2048 + k] : F.in[I_CCTX][k]; sl[i] = siluf_(v); }
    __syncthreads();
    float* modp = (float*)(F.ws + WS_R + R_MODP);
    const int NIT = MODP_KC * 9216;
    for (int it = blockIdx.x * 512 + F.tid; it < NIT; it += F.G * 512) {
        const int kc = it / 9216, c4 = it % 9216, cc = c4 * 4, l = cc / 18432, c = cc % 18432; const int k0 = kc * 2048 / MODP_KC, k1 = (kc + 1) * 2048 / MODP_KC;
        const float* w = F.in[I_ADAW] + ((size_t)l * 2048 + k0) * 18432 + c;
        f32x4 a0 = {0, 0, 0, 0}, a1 = a0, a2 = a0, a3 = a0, a4 = a0;
#pragma unroll 8
        for (int k = k0; k < k1; ++k) { const f32x4 wv = *(const f32x4*)(w + (size_t)(k - k0) * 18432);
            a0 += wv * sl[k]; a1 += wv * sl[2048 + k]; a2 += wv * sl[4096 + k]; a3 += wv * sl[6144 + k]; a4 += wv * sl[8192 + k]; }
        float* o = modp + (size_t)kc * 5 * 36864 + cc;
        *(f32x4*)(o) = a0; *(f32x4*)(o + 36864) = a1; *(f32x4*)(o + 2 * 36864) = a2; *(f32x4*)(o + 3 * 36864) = a3; *(f32x4*)(o + 4 * 36864) = a4;
    }
    __syncthreads();
}
__device__ __forceinline__ void ph_rope(Ctx& F) {
    float* rope = (float*)(F.ws + WS_ROPE);
    for (int i = blockIdx.x * 512 + F.tid; i < 4096 * 32; i += F.G * 512) { const int t = i >> 5, p = i & 31;
        const float inv = powf(10000.0f, -(float)(p & 15) / 16.0f); const float pos = (float)(p < 16 ? (t >> 6) : (t & 63)); const float ang = pos * inv;
        rope[2 * i] = cosf(ang); rope[2 * i + 1] = sinf(ang); }
}
__device__ __forceinline__ void ph_xasm(Ctx& F) {
    f32x4* X = (f32x4*)(F.ws + WS_X); float* LB = (float*)(F.ws + WS_LB);
    for (int i = blockIdx.x * 512 + F.tid; i < 2 * 4096; i += F.G * 512) { const int l = i >> 12, c = i & 4095; LB[i] = c < 2048 ? F.in[I_W0][l * 2048 + c] : F.in[I_A0][l * 2048 + c - 2048]; }
    { float* ST = (float*)(F.ws + WS_STATS); float* LT = (float*)(F.ws + WS_LNT);
      for (int i = blockIdx.x * 512 + F.tid; i < M; i += F.G * 512) { ST[2 * i] = 0.f; ST[2 * i + 1] = 1.f; }
      for (int i = blockIdx.x * 512 + F.tid; i < 7 * 4096; i += F.G * 512) { const int e = i >> 12, c = i & 4095;
          LT[i] = e == 0 ? (c < 2048 ? 1.f : 0.f) : (c < 2048 ? F.in[I_LNG][(e - 1) * 2048 + c] : F.in[I_LNB][(e - 1) * 2048 + c - 2048]); } }
}
struct CvtJob { const float* src; int sld, K, N, n0;  bf16_t* dst; int dld, kd0, rgrp, rstride, roff; };
__device__ __forceinline__ void cvt_item2(const CvtJob& J, int ia, int ib, LAS float* scr, int lane) {
    const int nblk = J.N / 32;
    float va[32], vb[32];
    { const int kb = ia / nblk, nb = ia % nblk, k0 = 64 * kb, n0 = 32 * nb;
#pragma unroll
      for (int i = 0; i < 32; ++i) { const int kk = 2 * i + (lane >> 5); va[i] = (k0 + kk < J.K) ? J.src[(size_t)(k0 + kk) * J.sld + J.n0 + n0 + (lane & 31)] : 0.f; } }
    if (ib >= 0) { const int kb = ib / nblk, nb = ib % nblk, k0 = 64 * kb, n0 = 32 * nb;
#pragma unroll
      for (int i = 0; i < 32; ++i) { const int kk = 2 * i + (lane >> 5); vb[i] = (k0 + kk < J.K) ? J.src[(size_t)(k0 + kk) * J.sld + J.n0 + n0 + (lane & 31)] : 0.f; } }
#pragma unroll
    for (int i = 0; i < 32; ++i) { const int kk = 2 * i + (lane >> 5); scr[kk * 33 + (lane & 31)] = va[i]; }
    if (ib >= 0) {
#pragma unroll
      for (int i = 0; i < 32; ++i) { const int kk = 2 * i + (lane >> 5); scr[64 * 33 + kk * 33 + (lane & 31)] = vb[i]; } }
    LDS_WAIT(); asm volatile("" ::: "memory");
    const int c = lane & 7;
#pragma unroll
    for (int h = 0; h < 2; ++h) { const int item = h ? ib : ia; if (item < 0) continue;
        const int kb = item / nblk, nb = item % nblk, k0 = 64 * kb, n0 = 32 * nb;
        if (k0 + 8 * c < J.K) {
#pragma unroll
        for (int j = 0; j < 4; ++j) { const int n = (lane >> 3) + 8 * j; const LAS float* s = scr + h * 64 * 33 + (8 * c) * 33 + n;
            u32x4 o; o.x = cvt_pk_bf16(s[0 * 33], s[1 * 33]); o.y = cvt_pk_bf16(s[2 * 33], s[3 * 33]); o.z = cvt_pk_bf16(s[4 * 33], s[5 * 33]); o.w = cvt_pk_bf16(s[6 * 33], s[7 * 33]);
            const int nn = n0 + n; const int row = (nn / J.rgrp) * J.rstride + nn % J.rgrp + J.roff;
            *(u32x4*)(J.dst + (size_t)row * J.dld + J.kd0 + k0 + 8 * c) = o; }
        } }
    LDS_WAIT(); asm volatile("" ::: "memory");
}
constexpr int NCVT = 20 + 32;
__device__ __forceinline__ CvtJob cvt_job(Ctx& F, int l, int j) {
    unsigned char* W = F.ws + WS_W; CvtJob J; const int BIG = 1 << 30;
    J.n0 = 0; J.kd0 = 0; J.rgrp = BIG; J.rstride = 0; J.roff = 0;
    switch (j) {
    case 0: case 1: case 2: case 3: { const int ff = j >> 1, up = j & 1;
        J.src = F.in[up ? I_WUP : I_WGATE] + ((size_t)l * 2 + ff) * 2048 * DFF; J.sld = DFF; J.K = 2048; J.N = DFF; J.dst = (bf16_t*)(W + (ff ? W_GU1 : W_GU0)); J.dld = 2048; J.rgrp = 128; J.rstride = 256; J.roff = up * 128; break; }
    case 4: case 5: { const int ff = j - 4; J.src = F.in[I_WDOWN] + ((size_t)l * 2 + ff) * DFF * 2048; J.sld = 2048; J.K = DFF; J.N = 2048; J.dst = (bf16_t*)(W + (ff ? W_D1 : W_D0)); J.dld = DFF; break; }
    case 6: J.src = F.in[I_WIN] + (size_t)l * 2048 * IN_COLS; J.sld = IN_COLS; J.K = 2048; J.N = FA; J.dst = (bf16_t*)(W + W_INA); J.dld = 2048; J.rgrp = OFF_GB; J.rstride = GB_ROW0; break;
    case 7: J.src = F.in[I_WIN] + (size_t)l * 2048 * IN_COLS; J.sld = IN_COLS; J.K = 2048; J.N = GATE_IN; J.n0 = FA; J.dst = (bf16_t*)(W + W_ING); J.dld = 2048; break;
    case 8: J.src = F.in[I_WUQ] + (size_t)l * 512 * 3072; J.sld = 3072; J.K = 512; J.N = 3072; J.dst = (bf16_t*)(W + W_UQ); J.dld = 512; break;
    case 9: J.src = F.in[I_WUK] + (size_t)l * 256 * 2048; J.sld = 2048; J.K = 256; J.N = 2048; J.dst = (bf16_t*)(W + W_UKV); J.dld = 256; break;
    case 10: J.src = F.in[I_WUV] + (size_t)l * 256 * 2048; J.sld = 2048; J.K = 256; J.N = 2048; J.dst = (bf16_t*)(W + W_UKV); J.dld = 256; J.roff = 2048; break;
    case 11: case 12: { const int d = j - 11; J.src = F.in[I_WUPL] + ((size_t)l * 2 + d) * 64 * 1024; J.sld = 1024; J.K = 64; J.N = 1024; J.dst = (bf16_t*)(W + W_LORA); J.dld = LORA_K; J.roff = d * 1024; break; }
    case 13: case 14: { const int d = j - 13; J.src = F.in[I_AUP] + ((size_t)l * 2 + d) * 64 * 1024; J.sld = 1024; J.K = 64; J.N = 1024; J.dst = (bf16_t*)(W + W_LORA); J.dld = LORA_K; J.roff = 2048 + d * 1024; J.kd0 = 64; break; }
    case 15: J.src = F.in[I_GUP] + (size_t)l * 160 * 1024; J.sld = 1024; J.K = 160; J.N = 1024; J.dst = (bf16_t*)(W + W_LORA); J.dld = LORA_K; J.roff = 4096; J.kd0 = 128; break;
    case 16: J.src = F.in[I_PRWKV] + (size_t)l * 1024 * 2048; J.sld = 2048; J.K = 1024; J.N = 2048; J.dst = (bf16_t*)(W + W_PROJ); J.dld = 4096; J.kd0 = 0; break;
    case 17: J.src = F.in[I_PMLA] + (size_t)l * 2048 * 2048; J.sld = 2048; J.K = 2048; J.N = 2048; J.dst = (bf16_t*)(W + W_PROJ); J.dld = 4096; J.kd0 = 1024; break;
    case 18: J.src = F.in[I_PLRU] + (size_t)l * 1024 * 2048; J.sld = 2048; J.K = 1024; J.N = 2048; J.dst = (bf16_t*)(W + W_PROJ); J.dld = 4096; J.kd0 = 3072; break;
    case 19: J.src = F.in[I_WOUT] + (size_t)l * 2048 * 2048; J.sld = 2048; J.K = 2048; J.N = 2048; J.dst = (bf16_t*)(W + W_OUT); J.dld = 2048; break;
    default: { const int q = j - 20, x = q >> 4, d = (q >> 3) & 1, nb = q & 7;
        J.src = F.in[x ? I_LRUWX : I_LRUWA] + (((size_t)l * 2 + d) * 8 + nb) * 128 * 128; J.sld = 128; J.K = 128; J.N = 128; J.dst = (bf16_t*)(W + W_LRU) + (size_t)nb * 512 * 256; J.dld = 256; J.roff = d * 256 + x * 128; J.kd0 = (nb & 1) * 128; break; }
    }
    return J;
}
__device__ __forceinline__ int cvt_items(const CvtJob& J) { return ((J.K + 63) / 64) * (J.N / 32); }
__device__ __forceinline__ void zero_rect(Ctx& F, bf16_t* dst, int ld, int row0, int nrows, int k0, int nk) {
    const int per = nk / 8; const long tot = (long)nrows * per;
    for (long i = (long)blockIdx.x * 512 + F.tid; i < tot; i += (long)F.G * 512) { const int r = (int)(i / per), c = (int)(i % per);
        *(u32x4*)(dst + (size_t)(row0 + r) * ld + k0 + c * 8) = zero4(); }
}
__device__ __forceinline__ void ph_cvt_m(Ctx& F, int l, unsigned long long mask, int me = -2, int nw = -1, bool zf = true) {
    LAS float* scr = (LAS float*)(F.lds + F.wave * 18176);
    if (nw < 0) nw = F.NGW;
    if (me == -2) me = F.gw;
    if (me >= 0 && me < nw) { int base = 0;
        for (int j = 0; j < NCVT; ++j) { if (!((mask >> j) & 1ull)) continue;
            const CvtJob J = cvt_job(F, l, j); const int ni = cvt_items(J);
            int first = (me - base % nw + nw) % nw;
            for (int it = first; it < ni; it += 2 * nw) cvt_item2(J, it, it + nw < ni ? it + nw : -1, scr, F.lane);
            base += ni; } }
    if (!zf) return;
    unsigned char* W = F.ws + WS_W;
    zero_rect(F, (bf16_t*)(W + W_INA), 2048, OFF_GB, GB_ROW0 - OFF_GB, 0, 2048);
    zero_rect(F, (bf16_t*)(W + W_LORA), LORA_K, 0, 2048, 64, LORA_K - 64);
    zero_rect(F, (bf16_t*)(W + W_LORA), LORA_K, 2048, 2048, 0, 64);
    zero_rect(F, (bf16_t*)(W + W_LORA), LORA_K, 2048, 2048, 128, LORA_K - 128);
    zero_rect(F, (bf16_t*)(W + W_LORA), LORA_K, 4096, 1024, 0, 128);
    zero_rect(F, (bf16_t*)(W + W_LORA), LORA_K, 4096, 1024, 288, LORA_K - 288);
    for (int nb = 0; nb < 8; ++nb) zero_rect(F, (bf16_t*)(W + W_LRU) + (size_t)nb * 512 * 256, 256, 0, 512, (1 - (nb & 1)) * 128, 128);
}
__device__ __forceinline__ void ph_cvt(Ctx& F, int l, int j0 = 0, int j1 = NCVT, int me = -2, int nw = -1, bool zf = true) { ph_cvt_m(F, l, ((1ull << j1) - 1ull) & ~((1ull << j0) - 1ull), me, nw, zf); }
constexpr unsigned long long CVT_ALL = (1ull << NCVT) - 1ull;
#ifndef CVT_SPLIT
#define CVT_SPLIT 1
#endif
constexpr unsigned long long CVT_FFN0 = (1ull << 0) | (1ull << 1) | (1ull << 4);
constexpr unsigned long long CVT_EARLY = CVT_ALL & ~((1ull << 2) | (1ull << 3) | (1ull << 5) | (0xFull << 16)) & ~(CVT_SPLIT ? CVT_FFN0 : 0ull);
constexpr unsigned long long CVT_MID = (1ull << 2) | (1ull << 3) | (CVT_SPLIT ? (1ull << 0) | (1ull << 1) : 0ull);
constexpr unsigned long long CVT_LATE = (1ull << 5) | (0xFull << 16) | (CVT_SPLIT ? (1ull << 4) : 0ull);
__device__ __forceinline__ void ph_modr(Ctx& F) {
    const float* modp = (const float*)(F.ws + WS_R + R_MODP); float* mod = (float*)(F.ws + WS_MOD);
    for (int i = blockIdx.x * 512 + F.tid; i < 5 * 36864; i += F.G * 512) { const int r = i / 36864, cc = i % 36864, l = cc / 18432, c = cc % 18432;
        float s = F.in[I_ADAB][cc];
#pragma unroll
        for (int kc = 0; kc < MODP_KC; ++kc) s += modp[(size_t)kc * 5 * 36864 + i];
        mod[((size_t)l * 5 + r) * 18432 + c] = s; }
}
__device__ __forceinline__ void ph_h0(Ctx& F) {
    bf16_t* H = (bf16_t*)(F.ws + WS_H); const float* mod = (const float*)(F.ws + WS_MOD);
    LAS float* ptab_ = (LAS float*)F.lds;
    { for (int i = F.tid; i < 5 * 512; i += 512) { const int mr_ = i >> 9, c_ = i & 511;
          ((LAS f32x4*)ptab_)[i] = ((const f32x4*)(mod + (size_t)mr_ * 18432 + 2048))[c_] + 1.0f; ((LAS f32x4*)ptab_)[2560 + i] = ((const f32x4*)(mod + (size_t)mr_ * 18432))[c_]; }
      __syncthreads(); }
    for (int n0 = F.gw; n0 < M; n0 += 2 * F.NGW) { f32x4 v[2][8];
#pragma unroll
        for (int u = 0; u < 2; ++u) { const int n = n0 + u * F.NGW < M ? n0 + u * F.NGW : n0; const int b_ = n / TPB, j_ = n % TPB;
            const float* src = j_ < CTX ? F.in[I_CTX] + ((size_t)b_ * CTX + j_) * D : F.in[I_X] + ((size_t)b_ * SEQ + (j_ - CTX)) * D;
#pragma unroll
            for (int j = 0; j < 8; ++j) v[u][j] = *(const f32x4*)(src + 4 * F.lane + 256 * j); }
#pragma unroll
        for (int u = 0; u < 2; ++u) { const int n = n0 + u * F.NGW; if (n >= M) break; const int mr = (n % TPB) < CTX ? 4 : n / TPB;
            int lo_ = 0; asm volatile("" : "+v"(lo_)); LAS const float* psc = ptab_ + lo_ + 4 * F.lane + mr * 2048; LAS const float* psh = psc + 5 * 2048;
#pragma unroll
            for (int j = 0; j < 8; ++j) { const int c = 4 * F.lane + 256 * j; const f32x4 y = v[u][j] * *(LAS const f32x4*)(psc + 256 * j) + *(LAS const f32x4*)(psh + 256 * j);
                u32x2 w; w.x = cvt_pk_bf16(y[0], y[1]); w.y = cvt_pk_bf16(y[2], y[3]); *(u32x2*)(H + (size_t)n * D + c) = w; } } }
}
#ifndef LN_NR
#define LN_NR 3
#endif
template <bool final_>
__device__ __forceinline__ void ph_ln_t(Ctx& F, const float* g, const float* b, const float* modl  , int sh_chunk, int sc_chunk, bool skip_ctx,
                                      const float* part, const float* pg, float pcoef, int previd) {
    float* X = (float*)(F.ws + WS_X); bf16_t* H = (bf16_t*)(F.ws + WS_H); float* ST = (float*)(F.ws + WS_STATS); const float* PL = (const float*)(F.ws + WS_LNT) + previd * 4096;
    LAS float* ptab_ = (LAS float*)F.lds;
    { for (int i = F.tid; i < 512; i += 512) { ((LAS f32x4*)ptab_)[i] = ((const f32x4*)g)[i]; ((LAS f32x4*)ptab_)[512 + i] = ((const f32x4*)b)[i]; }
      if (!final_) for (int i = F.tid; i < 5 * 512; i += 512) { const int mr_ = i >> 9, c_ = i & 511;
          ((LAS f32x4*)ptab_)[1024 + i] = ((const f32x4*)(modl + (size_t)mr_ * 18432 + sc_chunk * 2048))[c_] + 1.0f; ((LAS f32x4*)ptab_)[1024 + 2560 + i] = ((const f32x4*)(modl + (size_t)mr_ * 18432 + sh_chunk * 2048))[c_]; }
      __syncthreads(); }
    if (!final_ && part) {
        for (int n = F.gw; n < M; n += F.NGW) { const int bb = n / TPB, j0 = n % TPB; if (j0 >= CTX) continue;
            const float* pr = part + ((size_t)bb * 256 + j0) * D + 4 * F.lane; const float pmu = ST[2 * n], prs = ST[2 * n + 1]; const float pnm = -pmu * prs;
            const float* xs = previd == 0 ? F.in[I_CTX] + ((size_t)bb * CTX + j0) * D : X + (size_t)n * D;
#pragma unroll
            for (int j = 0; j < 8; ++j) { const int c = 4 * F.lane + 256 * j; f32x4 a = *(const f32x4*)(pr + 256 * j); const f32x4 x = *(const f32x4*)(xs + c);
#pragma unroll
                for (int sidx = 1; sidx < 4; ++sidx) a += *(const f32x4*)(pr + (size_t)sidx * 1024 * D + 256 * j);
                *(f32x4*)(X + (size_t)n * D + c) = ((x * prs + pnm) * *(const f32x4*)(PL + c) + *(const f32x4*)(PL + 2048 + c)) * ALPHA + a * (*(const f32x4*)(pg + 4 * 18432 + c) * pcoef); } }
        VM_WAIT(); }
    auto load2 = [&](f32x4 (&vv)[LN_NR][8], int n0) {
#pragma unroll
        for (int u = 0; u < LN_NR; ++u) { const int n = n0 + u * F.NGW; const int j0 = n % TPB; const bool on = n < M && !((final_ || skip_ctx) && j0 < CTX); const int nc = on ? n : n0 % M;
#pragma unroll
            for (int j = 0; j < 8; ++j) vv[u][j] = *(const f32x4*)(X + (size_t)nc * D + 4 * F.lane + 256 * j); } };
    auto proc2 = [&](f32x4 (&vv)[LN_NR][8], int n0) {
#pragma unroll
        for (int u = 0; u < LN_NR; ++u) { const int n = n0 + u * F.NGW; if (n >= M) continue; const int bb = n / TPB, j0 = n % TPB; if ((final_ || skip_ctx) && j0 < CTX) continue; const int mr = j0 < CTX ? 4 : bb;
        f32x4 (&v)[8] = vv[u]; float s = 0.f;
#pragma unroll
        for (int j = 0; j < 8; ++j) s += (v[j][0] + v[j][1]) + (v[j][2] + v[j][3]);
        const float mean = wave_sum(s) * (1.f / D); float s2 = 0.f;
#pragma unroll
        for (int j = 0; j < 8; ++j) { v[j] = v[j] - mean; s2 += (v[j][0] * v[j][0] + v[j][1] * v[j][1]) + (v[j][2] * v[j][2] + v[j][3] * v[j][3]); }
        const float rstd = __builtin_amdgcn_rsqf(wave_sum(s2) * (1.f / D) + LN_EPS);
        if (!final_ && F.lane == 0) { ST[2 * n] = mean; ST[2 * n + 1] = rstd; }
        int lo_ = 0; asm volatile("" : "+v"(lo_)); LAS const float* pt = ptab_ + lo_ + 4 * F.lane;
        LAS const float* psc = pt + 4096 + mr * 2048; LAS const float* psh = psc + 5 * 2048;
#pragma unroll
        for (int j = 0; j < 8; ++j) { const int c = 4 * F.lane + 256 * j; const f32x4 y = v[j] * rstd * *(LAS const f32x4*)(pt + 256 * j) + *(LAS const f32x4*)(pt + 2048 + 256 * j);
            if (final_) { *(f32x4*)(F.out + ((size_t)bb * SEQ + (j0 - CTX)) * D + c) = y; }
            else { const f32x4 h = y * *(LAS const f32x4*)(psc + 256 * j) + *(LAS const f32x4*)(psh + 256 * j);
                u32x2 w; w.x = cvt_pk_bf16(h[0], h[1]); w.y = cvt_pk_bf16(h[2], h[3]); *(u32x2*)(H + (size_t)n * D + c) = w; } } } };
    const int step = LN_NR * F.NGW; int n0 = F.gw;
    if (n0 < M) { f32x4 va[LN_NR][8], vb[LN_NR][8];
        load2(va, n0);
        for (;;) {
            const int n1 = n0 + step; if (n1 < M) load2(vb, n1);
            proc2(va, n0); if (n1 >= M) break;
            const int n2 = n1 + step; if (n2 < M) load2(va, n2);
            proc2(vb, n1); if (n2 >= M) break;
            n0 = n2; } }
}
__device__ __forceinline__ void ph_ln(Ctx& F, const float* g, const float* b, const float* modl, int sh_chunk, int sc_chunk, bool final_, bool skip_ctx = false,
                                      const float* part = nullptr, const float* pg = nullptr, float pcoef = 0.f, int previd = 0) {
    if (final_) ph_ln_t<true>(F, g, b, modl, sh_chunk, sc_chunk, skip_ctx, nullptr, pg, pcoef, previd);
    else ph_ln_t<false>(F, g, b, modl, sh_chunk, sc_chunk, skip_ctx, part, pg, pcoef, previd);
}
#ifndef DBG_RW_D0
#define DBG_RW_D0 1.0f
#endif
#ifndef DBG_RW_D1
#define DBG_RW_D1 1.0f
#endif
#ifndef DBG_LRU_D0
#define DBG_LRU_D0 1.0f
#endif
#ifndef DBG_LRU_D1
#define DBG_LRU_D1 1.0f
#endif
__device__ __forceinline__ void unpack8(const u32x4 w, float (&x)[8]) { x[0] = bf_lo(w.x); x[1] = bf_hi(w.x); x[2] = bf_lo(w.y); x[3] = bf_hi(w.y); x[4] = bf_lo(w.z); x[5] = bf_hi(w.z); x[6] = bf_lo(w.w); x[7] = bf_hi(w.w); }
__device__ __forceinline__ u32x4 pack8(const float (&x)[8]) { u32x4 w; w.x = cvt_pk_bf16(x[0], x[1]); w.y = cvt_pk_bf16(x[2], x[3]); w.z = cvt_pk_bf16(x[4], x[5]); w.w = cvt_pk_bf16(x[6], x[7]); return w; }
__device__ __forceinline__ int seq_j(int dir, int p) { return dir == 0 ? p : (p < CTX ? (CTX - 1 - p) : (TPB + CTX - 1 - p)); }

__device__ __forceinline__ float dpp_red8(float x) {
    x += __builtin_bit_cast(float, __builtin_amdgcn_update_dpp(0, __builtin_bit_cast(int, x), 0xB1, 0xF, 0xF, true));
    x += __builtin_bit_cast(float, __builtin_amdgcn_update_dpp(0, __builtin_bit_cast(int, x), 0x4E, 0xF, 0xF, true));
    x += __builtin_bit_cast(float, __builtin_amdgcn_update_dpp(0, __builtin_bit_cast(int, x), 0x141, 0xF, 0xF, true));
    return x;
}
__device__ __forceinline__ void ph_prep(Ctx& F, int l) {
    const bf16_t* FAp = (const bf16_t*)(F.ws + WS_R + R_FA);
    bf16_t* LIN = (bf16_t*)(F.ws + WS_R + R_LIN); bf16_t* RKV = (bf16_t*)(F.ws + WS_R + R_RKV); bf16_t* XC = (bf16_t*)(F.ws + WS_R + R_XC);
    bf16_t* QL = (bf16_t*)(F.ws + WS_R + R_QL); bf16_t* KVC = (bf16_t*)(F.ws + WS_R + R_KVC); bf16_t* KR = (bf16_t*)(F.ws + WS_R + R_KR);
    const float* mu = F.in[I_MU] + (size_t)l * RW_IN; const float* qn = F.in[I_QNORM] + (size_t)l * 512; const float* kvn = F.in[I_KVNORM] + (size_t)l * 256;
    float* KKN = (float*)(F.ws + WS_R + R_KKN); const float* kkp = F.in[I_KK] + (size_t)l * 1024;
    const float* cw = F.in[I_CONVW] + (size_t)l * 4 * 1024; const float* cb = F.in[I_CONVB] + (size_t)l * 1024; const float* rope = (const float*)(F.ws + WS_ROPE);
    const int lane = F.lane;
    {
        f32x4 mreg[7][2];
#pragma unroll
        for (int it = 0; it < 7; ++it) { const int ch = lane + 64 * it; const int chc = ch < 420 ? ch : 0; mreg[it][0] = *(const f32x4*)(mu + chc * 8); mreg[it][1] = *(const f32x4*)(mu + chc * 8 + 4); }
        f32x4 kkr[2][2];
#pragma unroll
        for (int it = 0; it < 2; ++it) { kkr[it][0] = *(const f32x4*)(kkp + (lane + 64 * it) * 8); kkr[it][1] = *(const f32x4*)(kkp + (lane + 64 * it) * 8 + 4); }
        for (int n = F.gw; n < M; n += F.NGW) {
            const int j = n % TPB; const bool isctx = j < CTX; const int t = j - CTX;
            int nb0, nb1, nb2, nb3;
            if (isctx) { nb0 = j > 0 ? n - 1 : -1; nb1 = j < CTX - 1 ? n + 1 : -1; nb2 = nb0; nb3 = nb1; }
            else { const int gc = t & 63, gr = t >> 6; nb0 = gc > 0 ? n - 1 : -1; nb1 = gc < 63 ? n + 1 : -1; nb2 = gr > 0 ? n - 64 : -1; nb3 = gr < 63 ? n + 64 : -1; }
            const bf16_t* Fr = FAp + (size_t)n * FA_PAD;
            u32x4 ow[7], sw[7];
#pragma unroll
            for (int it = 0; it < 7; ++it) { const int ch = lane + 64 * it; const int chc = ch < 420 ? ch : 0; const int q = chc / 105; const int nb = q == 0 ? nb0 : (q == 1 ? nb1 : (q == 2 ? nb2 : nb3));
                ow[it] = *(const u32x4*)(Fr + chc * 8); sw[it] = *(const u32x4*)(FAp + (size_t)(nb >= 0 ? nb : n) * FA_PAD + chc * 8); { const unsigned mk = nb >= 0 ? 0xffffffffu : 0u; sw[it].x &= mk; sw[it].y &= mk; sw[it].z &= mk; sw[it].w &= mk; } }
#pragma unroll
            for (int it = 0; it < 7; ++it) { const int ch = lane + 64 * it; if (ch >= 420) break;
                float own[8], sh[8], f[8]; unpack8(ow[it], own); unpack8(sw[it], sh);
#pragma unroll
                for (int i = 0; i < 8; ++i) { const float mm = i < 4 ? mreg[it][0][i] : mreg[it][1][i - 4]; f[i] = own[i] + (sh[i] - own[i]) * mm; }
                if (it == 2 || it == 3) { float ss = 0.f;
#pragma unroll
                    for (int i = 0; i < 8; ++i) { const float kv = f[i] * (i < 4 ? kkr[it - 2][0][i] : kkr[it - 2][1][i - 4]); ss += kv * kv; }
                    ss = dpp_red8(ss); if ((lane & 7) == 0) KKN[(size_t)n * 16 + ((ch - 128) >> 3)] = fminf(__builtin_amdgcn_rsqf(ss), 1e12f); }
                if (ch < 384) { *(u32x4*)(RKV + (size_t)n * 3072 + ch * 8) = pack8(f); }
                else if (ch < 392) {
#pragma unroll
                    for (int i = 0; i < 8; ++i) { const float e2 = __expf(2.0f * f[i]); f[i] = 1.0f - 2.0f * __builtin_amdgcn_rcpf(e2 + 1.0f); }
                    *(u32x4*)(LIN + (size_t)n * LORA_K + (ch - 384) * 8) = pack8(f); }
                else if (ch < 400) { *(u32x4*)(LIN + (size_t)n * LORA_K + 64 + (ch - 392) * 8) = pack8(f); }
                else {
#pragma unroll
                    for (int i = 0; i < 8; ++i) f[i] = __builtin_amdgcn_rcpf(1.0f + __expf(-f[i]));
                    *(u32x4*)(LIN + (size_t)n * LORA_K + 128 + (ch - 400) * 8) = pack8(f); }
            }
            if (lane < 12) *(u32x4*)(LIN + (size_t)n * LORA_K + 288 + lane * 8) = zero4();
        }
    }
    {
        const int ll = lane & 31;
        f32x4 qg[2], kg[2], cwr[2][4][2], cbr[2][2];
        qg[0] = *(const f32x4*)(qn + lane * 8); qg[1] = *(const f32x4*)(qn + lane * 8 + 4); kg[0] = *(const f32x4*)(kvn + ll * 8); kg[1] = *(const f32x4*)(kvn + ll * 8 + 4);
#pragma unroll
        for (int it = 0; it < 2; ++it) { const int c0 = (lane + 64 * it) * 8; cbr[it][0] = *(const f32x4*)(cb + c0); cbr[it][1] = *(const f32x4*)(cb + c0 + 4);
#pragma unroll
            for (int jj = 0; jj < 4; ++jj) { cwr[it][jj][0] = *(const f32x4*)(cw + jj * 1024 + c0); cwr[it][jj][1] = *(const f32x4*)(cw + jj * 1024 + c0 + 4); } }
        for (int n = F.gw; n < M; n += F.NGW) {
            const int j = n % TPB; const bool isctx = j < CTX; const int t = j - CTX; const bf16_t* Fr = FAp + (size_t)n * FA_PAD;
            const int spos = isctx ? j : t, slen = isctx ? CTX : SEQ;
            const u32x4 qw = *(const u32x4*)(Fr + OFF_QLAT + lane * 8), kw = *(const u32x4*)(Fr + OFF_KVLAT + ll * 8), rw = *(const u32x4*)(Fr + OFF_KROPE + (lane & 7) * 8);
            u32x4 xw[2][4];
#pragma unroll
            for (int it = 0; it < 2; ++it) { const int c0 = (lane + 64 * it) * 8;
#pragma unroll
                for (int jj = 0; jj < 4; ++jj) { const int pos = spos - 2 + jj; const bool ok = pos >= 0 && pos < slen; xw[it][jj] = *(const u32x4*)(FAp + (size_t)(ok ? n - 2 + jj : n) * FA_PAD + OFF_XR + c0); { const unsigned mk = ok ? 0xffffffffu : 0u; xw[it][jj].x &= mk; xw[it][jj].y &= mk; xw[it][jj].z &= mk; xw[it][jj].w &= mk; } } }
            f32x4 cs0 = {1.f, 0.f, 1.f, 0.f}, cs1 = cs0;
            if (!isctx) { const f32x4* cs = (const f32x4*)(rope + ((size_t)t * 32 + (lane & 7) * 4) * 2); cs0 = cs[0]; cs1 = cs[1]; }
            { float x[8]; unpack8(qw, x); float ss = 0.f;
#pragma unroll
              for (int i = 0; i < 8; ++i) ss += x[i] * x[i];
              const float r = __builtin_amdgcn_rsqf(wave_sum(ss) * (1.f / 512.f) + LN_EPS);
#pragma unroll
              for (int i = 0; i < 8; ++i) x[i] = x[i] * r * (i < 4 ? qg[0][i] : qg[1][i - 4]);
              *(u32x4*)(QL + (size_t)n * 512 + lane * 8) = pack8(x); }
            { float x[8]; unpack8(kw, x); float ss = 0.f;
#pragma unroll
              for (int i = 0; i < 8; ++i) ss += x[i] * x[i];
              if (lane >= 32) ss = 0.f;
              const float r = __builtin_amdgcn_rsqf(wave_sum(ss) * (1.f / 256.f) + LN_EPS);
#pragma unroll
              for (int i = 0; i < 8; ++i) x[i] = x[i] * r * (i < 4 ? kg[0][i] : kg[1][i - 4]);
              if (lane < 32) *(u32x4*)(KVC + (size_t)n * 256 + ll * 8) = pack8(x); }
            if (lane < 8) { float x[8], y[8]; unpack8(rw, x);
                y[0] = x[0] * cs0[0] - x[1] * cs0[1]; y[1] = x[0] * cs0[1] + x[1] * cs0[0]; y[2] = x[2] * cs0[2] - x[3] * cs0[3]; y[3] = x[2] * cs0[3] + x[3] * cs0[2];
                y[4] = x[4] * cs1[0] - x[5] * cs1[1]; y[5] = x[4] * cs1[1] + x[5] * cs1[0]; y[6] = x[6] * cs1[2] - x[7] * cs1[3]; y[7] = x[6] * cs1[3] + x[7] * cs1[2];
                *(u32x4*)(KR + (size_t)n * 64 + lane * 8) = pack8(y); }
#pragma unroll
            for (int it = 0; it < 2; ++it) { const int c0 = (lane + 64 * it) * 8; float acc[8];
#pragma unroll
                for (int i = 0; i < 8; ++i) acc[i] = i < 4 ? cbr[it][0][i] : cbr[it][1][i - 4];
#pragma unroll
                for (int jj = 0; jj < 4; ++jj) { float x[8]; unpack8(xw[it][jj], x);
#pragma unroll
                    for (int i = 0; i < 8; ++i) acc[i] += x[i] * (i < 4 ? cwr[it][jj][0][i] : cwr[it][jj][1][i - 4]); }
                *(u32x4*)(XC + (size_t)n * 1024 + c0) = pack8(acc); }
        }
    }
}
constexpr int SC_T = 32, SC_STEP = 352  , SC_BUF = SC_T * SC_STEP, SC_NCH = TPB / SC_T;
__device__ __forceinline__ float wave_sum_fast(float x) {
    x = dpp_red8(x);
    x += __builtin_bit_cast(float, __builtin_amdgcn_update_dpp(0, __builtin_bit_cast(int, x), 0x140, 0xF, 0xF, true));
    { auto r = __builtin_amdgcn_permlane16_swap(__float_as_uint(x), __float_as_uint(x), false, false); x = __uint_as_float(r[0]) + __uint_as_float(r[1]); }
    { auto r = __builtin_amdgcn_permlane32_swap(__float_as_uint(x), __float_as_uint(x), false, false); x = __uint_as_float(r[0]) + __uint_as_float(r[1]); }
    return x;
}
struct ScOps { f32x4 d0, d1, k0, k1, a0, a1, m0, m1, r0, r1; float vv; };
__device__ __forceinline__ void sc_load(ScOps& o, const LAS float* p, const LAS float* pv) {
    o.d0 = *(const LAS f32x4*)(p); o.d1 = *(const LAS f32x4*)(p + 4); o.k0 = *(const LAS f32x4*)(p + 64); o.k1 = *(const LAS f32x4*)(p + 68);
    o.a0 = *(const LAS f32x4*)(p + 128); o.a1 = *(const LAS f32x4*)(p + 132); o.m0 = *(const LAS f32x4*)(p + 192); o.m1 = *(const LAS f32x4*)(p + 196);
    o.r0 = *(const LAS f32x4*)(p + 256); o.r1 = *(const LAS f32x4*)(p + 260); o.vv = *pv;
}
__device__ __forceinline__ float sc_step(const ScOps& o, f32x2& s0, f32x2& s1, f32x2& s2, f32x2& s3) {
    const f32x2 p0 = s0 * (f32x2){o.k0[0], o.k0[1]} + s1 * (f32x2){o.k0[2], o.k0[3]}, p1 = s2 * (f32x2){o.k1[0], o.k1[1]} + s3 * (f32x2){o.k1[2], o.k1[3]};
    const f32x2 acc = p0 + p1; const float sa = dpp_red8(acc[0] + acc[1]);
    s0 = s0 * (f32x2){o.d0[0], o.d0[1]} - sa * (f32x2){o.a0[0], o.a0[1]} + o.vv * (f32x2){o.m0[0], o.m0[1]};
    s1 = s1 * (f32x2){o.d0[2], o.d0[3]} - sa * (f32x2){o.a0[2], o.a0[3]} + o.vv * (f32x2){o.m0[2], o.m0[3]};
    s2 = s2 * (f32x2){o.d1[0], o.d1[1]} - sa * (f32x2){o.a1[0], o.a1[1]} + o.vv * (f32x2){o.m1[0], o.m1[1]};
    s3 = s3 * (f32x2){o.d1[2], o.d1[3]} - sa * (f32x2){o.a1[2], o.a1[3]} + o.vv * (f32x2){o.m1[2], o.m1[3]};
    const f32x2 y0 = s0 * (f32x2){o.r0[0], o.r0[1]} + s1 * (f32x2){o.r0[2], o.r0[3]}, y1 = s2 * (f32x2){o.r1[0], o.r1[1]} + s3 * (f32x2){o.r1[2], o.r1[3]};
    const f32x2 ya = y0 + y1; return ya[0] + ya[1];
}
__device__ __forceinline__ void ph_rwkv_scan(Ctx& F, int l) {
    const bf16_t* RKV = (const bf16_t*)(F.ws + WS_R + R_RKV); const bf16_t* LO = (const bf16_t*)(F.ws + WS_R + R_LO); bf16_t* YS = (bf16_t*)(F.ws + WS_R + R_YS);
    LAS float* OP = (LAS float*)F.lds; LAS float* YB = (LAS float*)(F.lds + 2 * SC_BUF * 4);
    const int lane = F.lane, wave = F.wave;
    for (int item = F.vcu; item < 256; item += F.G) {
        const int vhalf = item & 1, dir = (item >> 1) & 1, h = (item >> 2) & 15, b = item >> 6;
        const int ch = h * 64 + lane; const size_t nb0 = (size_t)b * TPB;
        if (wave >= 4) {
            const float kkc = F.in[I_KK][(size_t)l * 1024 + ch], kac = F.in[I_KA][(size_t)l * 1024 + ch];
            const int sw = wave - 4, st = F.tid - 256; const float* KKN = (const float*)(F.ws + WS_R + R_KKN);
            bf16_t vr[8], vk[8], vv[8], vw[8], va[8]; float vn[8];
#define SC_FETCH(cn) do { _Pragma("unroll") for (int q = 0; q < 8; ++q) { const size_t n = nb0 + seq_j(dir, (cn) * SC_T + sw * 8 + q); \
                vr[q] = RKV[n * 3072 + ch]; vk[q] = RKV[n * 3072 + 1024 + ch]; vv[q] = RKV[n * 3072 + 2048 + ch]; vw[q] = LO[n * LORA_N + dir * 1024 + ch]; va[q] = LO[n * LORA_N + 2048 + dir * 1024 + ch]; vn[q] = KKN[n * 16 + h]; } } while (0)
            SC_FETCH(0);
            for (int ci = -1; ci < SC_NCH; ++ci) {
                if (ci + 1 < SC_NCH) { const int cn = ci + 1; LAS float* ob = OP + (cn & 1) * SC_BUF;
                    float fr[8], fk[8], fv[8], fw[8], fa[8], fn[8];
#pragma unroll
                    for (int q = 0; q < 8; ++q) { fr[q] = bf2f(vr[q]); fk[q] = bf2f(vk[q]); fv[q] = bf2f(vv[q]); fw[q] = bf2f(vw[q]); fa[q] = bf2f(va[q]); fn[q] = vn[q]; }
                    if (cn + 1 < SC_NCH) SC_FETCH(cn + 1);
#pragma unroll
                    for (int q = 0; q < 8; ++q) { const int s = sw * 8 + q; LAS float* o = ob + s * SC_STEP;
                        const float kx = fk[q]; const float kk = kx * kkc * fn[q];
                        const float dec = __expf(-0.60653065971263342f * fw[q]);
                        const float a = fa[q]; const float km = kx * (1.0f + (a - 1.0f) * kac);
                        o[lane] = dec; o[64 + lane] = kk; o[128 + lane] = a * kk; o[192 + lane] = km; o[256 + lane] = fr[q];
                        if ((lane >> 5) == vhalf) o[320 + (lane & 31)] = fv[q]; } }
                if (ci >= 1) { const int cp = ci - 1; const LAS float* yb = YB + (cp & 1) * (SC_T * 32); const int s = st >> 3, i0 = (st & 7) * 4;
                    const size_t n = nb0 + seq_j(dir, cp * SC_T + s); const f32x4 y = *(const LAS f32x4*)(yb + s * 32 + i0);
                    u32x2 w; w.x = cvt_pk_bf16(y[0], y[1]); w.y = cvt_pk_bf16(y[2], y[3]);
                    *(u32x2*)(YS + ((size_t)dir * M + n) * 1024 + h * 64 + vhalf * 32 + i0) = w; }
                LDS_WAIT(); __builtin_amdgcn_s_barrier(); asm volatile("" ::: "memory");
            }
#undef SC_FETCH
            { const int cp = SC_NCH - 1; const LAS float* yb = YB + (cp & 1) * (SC_T * 32); const int s = st >> 3, i0 = (st & 7) * 4;
                const size_t n = nb0 + seq_j(dir, cp * SC_T + s); const f32x4 y = *(const LAS f32x4*)(yb + s * 32 + i0);
                u32x2 w; w.x = cvt_pk_bf16(y[0], y[1]); w.y = cvt_pk_bf16(y[2], y[3]);
                *(u32x2*)(YS + ((size_t)dir * M + n) * 1024 + h * 64 + vhalf * 32 + i0) = w; }
        } else {
            const int rl = lane >> 3, c = lane & 7, rowl = wave * 8 + rl;
            f32x2 s0 = {0.f, 0.f}, s1 = s0, s2 = s0, s3 = s0;
            __builtin_amdgcn_s_barrier(); asm volatile("" ::: "memory");
            for (int ci = 0; ci < SC_NCH; ++ci) { const LAS float* ob = OP + (ci & 1) * SC_BUF + 8 * c; const LAS float* vb = OP + (ci & 1) * SC_BUF + 320 + rowl; LAS float* yb = YB + (ci & 1) * (SC_T * 32) + rowl;
                ScOps A, B; sc_load(A, ob, vb);
#pragma unroll 1
                for (int s8 = 0; s8 < SC_T; s8 += 8) { float ys[8];
#pragma unroll
                    for (int q = 0; q < 8; q += 2) { const int s = s8 + q;
                        sc_load(B, ob + (s + 1) * SC_STEP, vb + (s + 1) * SC_STEP);
                        ys[q] = sc_step(A, s0, s1, s2, s3);
                        if (s + 2 < SC_T) sc_load(A, ob + (s + 2) * SC_STEP, vb + (s + 2) * SC_STEP);
                        ys[q + 1] = sc_step(B, s0, s1, s2, s3); }
#pragma unroll
                    for (int q = 0; q < 8; ++q) ys[q] = dpp_red8(ys[q]);
                    if (c == 0) {
#pragma unroll
                        for (int q = 0; q < 8; ++q) yb[(s8 + q) * 32] = ys[q]; } }
                LDS_WAIT(); __builtin_amdgcn_s_barrier(); asm volatile("" ::: "memory");
            }
        }
        __syncthreads();
    }
}
__device__ __forceinline__ void rwkv_readout_half(const u32x4 y0w, const u32x4 y1w, const u32x4 rw, const u32x4 kw, const u32x4 vw, const u32x4 a0w, const u32x4 a1w, const u32x4 gw_,
                                                  const float (&lg)[8], const float (&lb)[8], const float (&rk)[8], const float (&ka)[8], const float (&a00)[8], const float (&a01)[8], bf16_t* dst) {
    float y0[8], y1[8], r[8], k[8], v[8], al0[8], al1[8], g[8], y[8], o[8];
    unpack8(y0w, y0); unpack8(y1w, y1); unpack8(rw, r); unpack8(kw, k); unpack8(vw, v); unpack8(a0w, al0); unpack8(a1w, al1); unpack8(gw_, g);
    float s = 0.f;
#pragma unroll
    for (int i = 0; i < 8; ++i) { y[i] = DBG_RW_D0 * y0[i] + DBG_RW_D1 * y1[i]; s += y[i]; }
    const float mu_ = dpp_red8(s) * (1.f / 64.f); float q = 0.f, bp = 0.f;
#pragma unroll
    for (int i = 0; i < 8; ++i) { y[i] -= mu_; q += y[i] * y[i];
        const float a_0 = al0[i], a_1 = al1[i];
        const float kb = k[i] * (1.0f + (0.5f * (a_0 + a_1) - 1.0f) * ka[i]); bp += r[i] * kb * rk[i]; }
    const float rstd = __builtin_amdgcn_rsqf(dpp_red8(q) * (1.f / 64.f) + GN_EPS); const float bonus = dpp_red8(bp);
#pragma unroll
    for (int i = 0; i < 8; ++i) o[i] = (y[i] * rstd * lg[i] + lb[i] + bonus * v[i]) * g[i];
    *(u32x4*)dst = pack8(o);
}
__device__ __forceinline__ void ph_rwkv_readout(Ctx& F, int l) {
    const bf16_t* RKV = (const bf16_t*)(F.ws + WS_R + R_RKV); const bf16_t* LO = (const bf16_t*)(F.ws + WS_R + R_LO); const bf16_t* YS = (const bf16_t*)(F.ws + WS_R + R_YS);
    bf16_t* YC = (bf16_t*)(F.ws + WS_YCAT);
    const int half = F.gw & 1, c0 = half * 512 + F.lane * 8;
    float lg[8], lb[8], rk[8], ka[8], a00[8], a01[8];
#pragma unroll
    for (int i = 0; i < 8; ++i) { lg[i] = F.in[I_LNXG][(size_t)l * 1024 + c0 + i]; lb[i] = F.in[I_LNXB][(size_t)l * 1024 + c0 + i]; rk[i] = F.in[I_RK][(size_t)l * 1024 + c0 + i];
        ka[i] = F.in[I_KA][(size_t)l * 1024 + c0 + i]; a00[i] = F.in[I_A0][(size_t)l * 2048 + c0 + i]; a01[i] = F.in[I_A0][(size_t)l * 2048 + 1024 + c0 + i]; }
    const int NW2 = F.NGW >> 1;
    for (int n = F.gw >> 1; n < M; n += 2 * NW2) { const int n2 = n + NW2; const bool two = n2 < M; const size_t m2 = two ? n2 : n;
        const u32x4 y0a = *(const u32x4*)(YS + (size_t)n * 1024 + c0), y1a = *(const u32x4*)(YS + ((size_t)M + n) * 1024 + c0), ra = *(const u32x4*)(RKV + (size_t)n * 3072 + c0), ka_ = *(const u32x4*)(RKV + (size_t)n * 3072 + 1024 + c0),
                    va = *(const u32x4*)(RKV + (size_t)n * 3072 + 2048 + c0), a0a = *(const u32x4*)(LO + (size_t)n * LORA_N + 2048 + c0), a1a = *(const u32x4*)(LO + (size_t)n * LORA_N + 3072 + c0), ga = *(const u32x4*)(LO + (size_t)n * LORA_N + 4096 + c0);
        const u32x4 y0b = *(const u32x4*)(YS + m2 * 1024 + c0), y1b = *(const u32x4*)(YS + ((size_t)M + m2) * 1024 + c0), rb = *(const u32x4*)(RKV + m2 * 3072 + c0), kb_ = *(const u32x4*)(RKV + m2 * 3072 + 1024 + c0),
                    vb = *(const u32x4*)(RKV + m2 * 3072 + 2048 + c0), a0b = *(const u32x4*)(LO + m2 * LORA_N + 2048 + c0), a1b = *(const u32x4*)(LO + m2 * LORA_N + 3072 + c0), gb = *(const u32x4*)(LO + m2 * LORA_N + 4096 + c0);
        rwkv_readout_half(y0a, y1a, ra, ka_, va, a0a, a1a, ga, lg, lb, rk, ka, a00, a01, YC + (size_t)n * 4096 + c0);
        if (two) rwkv_readout_half(y0b, y1b, rb, kb_, vb, a0b, a1b, gb, lg, lb, rk, ka, a00, a01, YC + m2 * 4096 + c0);
    }
}
constexpr int LR_CL = 34, LR_NC = TPB / LR_CL;
__device__ __forceinline__ float one_minus_exp(float x) {
    const float p = -x * (1.0f + x * (0.5f + x * (0.16666667f + x * 0.041666668f))); const float e = 1.0f - __expf(x); return x > -0.06f ? p : e;
}
template <int NB, bool PASS2>
__device__ __forceinline__ void lru_batch(bf16_t* GT, const bf16_t* XC, size_t nb0, int dir, int p0, int gcol, int c0, const float (&sp8)[8], const float (&ba)[8], const float (&bx)[8], float (&A)[8], float (&hh)[8], bool store) {
    u32x4 gr[NB], gi[NB], xx[NB];
#pragma unroll
    for (int q = 0; q < NB; ++q) { const size_t n = nb0 + seq_j(dir, p0 + q); gr[q] = *(const u32x4*)(GT + n * 4096 + gcol); gi[q] = *(const u32x4*)(GT + n * 4096 + gcol + 128); xx[q] = *(const u32x4*)(XC + n * 1024 + c0); }
#pragma unroll
    for (int q = 0; q < NB; ++q) { float r[8], ii[8], x[8], o[8]; unpack8(gr[q], r); unpack8(gi[q], ii); unpack8(xx[q], x);
#pragma unroll
        for (int i = 0; i < 8; ++i) {
            const float dr = 1.0f + __expf(fminf(-(r[i] + ba[i]), 40.f)), di = 1.0f + __expf(fminf(-(ii[i] + bx[i]), 40.f)); const float rc = __builtin_amdgcn_rcpf(dr * di);
            const float g_r = di * rc, g_i = dr * rc;
            const float la = sp8[i] * g_r; const float a = __expf(la); const float x2 = 2.0f * la;
            const float om = x2 > -0.06f ? -x2 * (1.0f + x2 * (0.5f + x2 * (0.16666667f + x2 * 0.041666668f))) : 1.0f - a * a;
            const float bb = __builtin_amdgcn_sqrtf(om) * g_i * x[i];
            if (!PASS2) A[i] *= a; hh[i] = a * hh[i] + bb; o[i] = hh[i]; }
        if (PASS2 && store) *(u32x4*)(GT + (nb0 + seq_j(dir, p0 + q)) * 4096 + gcol) = pack8(o);
        __builtin_amdgcn_sched_barrier(0); }
}
__device__ __forceinline__ void ph_lru_scan(Ctx& F, int l, bool store = true) {
    bf16_t* GT = (bf16_t*)(F.ws + WS_R + R_GT); const bf16_t* XC = (const bf16_t*)(F.ws + WS_R + R_XC);
    LAS float* agg = (LAS float*)F.lds;
    for (int item = F.vcu; item < 256; item += F.G) {
        const int cg = item & 31, dir = (item >> 5) & 1, b = item >> 6; const int tc = F.tid >> 2, o = F.tid & 3, c0 = cg * 32 + o * 8, blk = c0 >> 7, e0 = c0 & 127;
        float sp8[8], ba[8], bx[8];
#pragma unroll
        for (int i = 0; i < 8; ++i) { sp8[i] = -8.0f * softplusf_(-F.in[I_LAMBDA][((size_t)l * 2 + dir) * 1024 + c0 + i]); ba[i] = F.in[I_LRUBA][((size_t)l * 2 + dir) * 1024 + c0 + i]; bx[i] = F.in[I_LRUBX][((size_t)l * 2 + dir) * 1024 + c0 + i]; }
        const size_t nb0 = (size_t)b * TPB; const int gcol = blk * 512 + dir * 256 + e0; const int p0 = tc * LR_CL;
        float A[8], hh[8];
#pragma unroll
        for (int i = 0; i < 8; ++i) { A[i] = 1.f; hh[i] = 0.f; }
#pragma unroll 1
        for (int bb = 0; bb < 8; ++bb) lru_batch<4, false>(GT, XC, nb0, dir, p0 + 4 * bb, gcol, c0, sp8, ba, bx, A, hh, false);
        lru_batch<2, false>(GT, XC, nb0, dir, p0 + 32, gcol, c0, sp8, ba, bx, A, hh, false);
        { LAS float* ag = agg + (size_t)(tc * 4 + o) * 16;
          *(LAS f32x4*)(ag) = (f32x4){A[0], A[1], A[2], A[3]}; *(LAS f32x4*)(ag + 4) = (f32x4){A[4], A[5], A[6], A[7]}; *(LAS f32x4*)(ag + 8) = (f32x4){hh[0], hh[1], hh[2], hh[3]}; *(LAS f32x4*)(ag + 12) = (f32x4){hh[4], hh[5], hh[6], hh[7]}; }
        __syncthreads();
#pragma unroll
        for (int i = 0; i < 8; ++i) hh[i] = 0.f;
        for (int i = 0; i < tc; ++i) { const LAS float* ag = agg + (size_t)(i * 4 + o) * 16; const f32x4 a0 = *(const LAS f32x4*)(ag), a1 = *(const LAS f32x4*)(ag + 4), h0 = *(const LAS f32x4*)(ag + 8), h1 = *(const LAS f32x4*)(ag + 12);
#pragma unroll
            for (int j = 0; j < 4; ++j) { hh[j] = a0[j] * hh[j] + h0[j]; hh[4 + j] = a1[j] * hh[4 + j] + h1[j]; } }
#pragma unroll 1
        for (int bb = 0; bb < 8; ++bb) lru_batch<4, true>(GT, XC, nb0, dir, p0 + 4 * bb, gcol, c0, sp8, ba, bx, A, hh, store);
        lru_batch<2, true>(GT, XC, nb0, dir, p0 + 32, gcol, c0, sp8, ba, bx, A, hh, store);
        if (!store && hh[0] == 12345.678f) GT[0] = 0;
        __syncthreads();
    }
}
__device__ __forceinline__ void ph_lru_readout(Ctx& F) {
    const bf16_t* GT = (const bf16_t*)(F.ws + WS_R + R_GT); const bf16_t* GB = (const bf16_t*)(F.ws + WS_R + R_GB); bf16_t* YC = (bf16_t*)(F.ws + WS_YCAT);
    const int NIT = 2 * M;
    for (int it0 = F.gw; it0 < NIT; it0 += 4 * F.NGW) { u32x4 h0w[4], h1w[4], gw_[4];
#pragma unroll
        for (int u = 0; u < 4; ++u) { const int it = it0 + u * F.NGW; const int itc = it < NIT ? it : it0; const int n = itc >> 1, c0 = (itc & 1) * 512 + F.lane * 8, blk = c0 >> 7, e0 = c0 & 127;
            h0w[u] = *(const u32x4*)(GT + (size_t)n * 4096 + blk * 512 + e0); h1w[u] = *(const u32x4*)(GT + (size_t)n * 4096 + blk * 512 + 256 + e0); gw_[u] = *(const u32x4*)(GB + (size_t)n * 1024 + c0); }
#pragma unroll
        for (int u = 0; u < 4; ++u) { const int it = it0 + u * F.NGW; if (it >= NIT) break; const int n = it >> 1, c0 = (it & 1) * 512 + F.lane * 8; float h0[8], h1[8], g[8], o[8];
            unpack8(h0w[u], h0); unpack8(h1w[u], h1); unpack8(gw_[u], g);
#pragma unroll
            for (int i = 0; i < 8; ++i) o[i] = (DBG_LRU_D0 * h0[i] + DBG_LRU_D1 * h1[i]) * gelu_tanh_(g[i]);
            *(u32x4*)(YC + (size_t)n * 4096 + 3072 + c0) = pack8(o); } }
}
__device__ __forceinline__ void ph_attn(Ctx& F, bool with_ctx, char* lds_gen) {
    const bf16_t* Q = (const bf16_t*)(F.ws + WS_R + R_Q); const bf16_t* KN = (const bf16_t*)(F.ws + WS_R + R_KN); const bf16_t* KR = (const bf16_t*)(F.ws + WS_R + R_KR); const bf16_t* V = (const bf16_t*)(F.ws + WS_R + R_V); bf16_t* YC = (bf16_t*)(F.ws + WS_YCAT);
    const int NU = 1024 + (with_ctx ? 64 : 0);
    for (int u = F.vcu; u < NU; u += F.G) {
        int b, h, seq; size_t q0; const float* rp = nullptr;
        if (u < 1024) { b = u >> 8; h = (u >> 4) & 15; q0 = (size_t)b * TPB + CTX + (size_t)(u & 15) * 256; seq = TPB; rp = (const float*)(F.ws + WS_ROPE) + (size_t)(u & 15) * 256 * 64; }
        else { const int uu = u - 1024; b = uu >> 4; h = uu & 15; q0 = (size_t)b * TPB; seq = CTX; }
        att::attn_body(Q + q0 * 3072 + h * QKD, KN + (size_t)b * TPB * 2048 + h * QK_NOPE, KR + (size_t)b * TPB * 64, V + (size_t)b * TPB * 2048 + h * VD, YC + q0 * 4096 + 1024 + h * VD, seq, rp, lds_gen);
        __syncthreads();
    }
}
namespace sc2 {
constexpr int BS = 8, NBLK = TPB / BS  , RB = 8, NSTG = 6;
constexpr int SL_X = 0, SL_W2T = 4096, SL_QT = 8192, SL_VT = 9216, SL_G = 10240, SLOT = 10496;
constexpr int ST_PM = 0, ST_GM = 4096, ST_T = 5120, ST_TG = 5376, STG = 5632;
constexpr int OFF_STG = RB * SLOT, OFF_FLAG = OFF_STG + NSTG * STG;
__device__ __forceinline__ unsigned lds_ld(volatile LAS unsigned* p) { return *p; }
__device__ __forceinline__ int keyperm(int ks, int q) { return 16 * (ks >> 2) + 4 * q + (ks & 3); }
}
#ifndef SC2_VARIANT
#define SC2_VARIANT 0
#endif
__device__ __forceinline__ void ph_rwkv_scan2(Ctx& F, int l, int pass = 0) {
    const int variant = pass ? SC2_VARIANT : 0;
    using namespace sc2;
    const bf16_t* RKV = (const bf16_t*)(F.ws + WS_R + R_RKV); const bf16_t* LO = (const bf16_t*)(F.ws + WS_R + R_LO); bf16_t* YS = (bf16_t*)(F.ws + WS_R + R_YS); const float* KKN = (const float*)(F.ws + WS_R + R_KKN);
    const int lane = F.lane, wave = F.wave;
    volatile LAS unsigned* flags = (volatile LAS unsigned*)(F.lds + OFF_FLAG);
    for (int item = F.vcu; item < 256; item += F.G) {
        const int vhalf = item & 1, dir = (item >> 1) & 1, h = (item >> 2) & 15, b = item >> 6; const size_t nb0 = (size_t)b * TPB;
        __syncthreads();
        if (F.tid < 16) flags[F.tid] = 0u;
        for (int i = F.tid; i < RB * 256; i += 512) { const int s = i >> 8, e = i & 255; if (e >= 128) ((LAS float*)(F.lds + s * SLOT + SL_QT))[e] = 0.f; }
        __syncthreads();
        if (wave < 2) {
            const int n = lane & 15, q = lane >> 4; const int rowg = h * 64 + vhalf * 32 + wave * 16 + n;
            f32x4 S[4]; S[0] = S[1] = S[2] = S[3] = (f32x4){0.f, 0.f, 0.f, 0.f};
            for (int blk = 0; blk < NBLK; ++blk) { const int slot = blk & (RB - 1); const LAS unsigned char* sp = F.lds + slot * SLOT;
                { unsigned spin = 0; while (lds_ld(flags + slot) != (unsigned)(blk + 1)) { __builtin_amdgcn_s_sleep(1); if (++spin > (1u << 24)) break; } }
                asm volatile("" ::: "memory");
                f32x4 xa[4];
#pragma unroll
                for (int mb = 0; mb < 4; ++mb) xa[mb] = *(const LAS f32x4*)(sp + SL_X + (n * 64 + 16 * mb + 4 * q) * 4);
                const f32x4 vt = *(const LAS f32x4*)(sp + SL_VT + ((wave * 16 + n) * 8 + 4 * (q & 1)) * 4);
                f32x4 w2[4];
#pragma unroll
                for (int mb = 0; mb < 4; ++mb) w2[mb] = *(const LAS f32x4*)(sp + SL_W2T + ((16 * mb + n) * 16 + 4 * q) * 4);
                const f32x4 qt = *(const LAS f32x4*)(sp + SL_QT + (n * 16 + 4 * q) * 4);
                f32x4 gm[4];
#pragma unroll
                for (int mb = 0; mb < 4; ++mb) gm[mb] = *(const LAS f32x4*)(sp + SL_G + (16 * mb + 4 * q) * 4);
                if (variant == 1) { asm volatile("s_waitcnt lgkmcnt(0)" ::: "memory"); if (lane == 0) flags[8 + wave] = (unsigned)(blk + 1); continue; }
                f32x4 D1 = {0.f, 0.f, 0.f, 0.f}, D1b = D1;
#pragma unroll
                for (int mb = 0; mb < 4; mb += 2)
#pragma unroll
                    for (int i = 0; i < 4; ++i) { D1 = __builtin_amdgcn_mfma_f32_16x16x4f32(xa[mb][i], S[mb][i], D1, 0, 0, 0); D1b = __builtin_amdgcn_mfma_f32_16x16x4f32(xa[mb + 1][i], S[mb + 1][i], D1b, 0, 0, 0); }
                f32x4 Sg[4];
#pragma unroll
                for (int mb = 0; mb < 4; ++mb) Sg[mb] = S[mb] * gm[mb];
                D1 += D1b;
                f32x4 bop;
#pragma unroll
                for (int i = 0; i < 4; ++i) bop[i] = q < 2 ? vt[i] : D1[i];
                f32x4 Dy;
#pragma unroll
                for (int i = 0; i < 4; ++i) Dy[i] = q < 2 ? D1[i] : 0.f;
#pragma unroll
                for (int i = 0; i < 4; ++i) Dy = __builtin_amdgcn_mfma_f32_16x16x4f32(qt[i], bop[i], Dy, 0, 0, 0);
                { f32x4 Dm0 = Sg[0], Dm1 = Sg[1], Dm2 = Sg[2], Dm3 = Sg[3];
#pragma unroll
                  for (int i = 0; i < 4; ++i) { Dm0 = __builtin_amdgcn_mfma_f32_16x16x4f32(w2[0][i], bop[i], Dm0, 0, 0, 0); Dm1 = __builtin_amdgcn_mfma_f32_16x16x4f32(w2[1][i], bop[i], Dm1, 0, 0, 0);
                      Dm2 = __builtin_amdgcn_mfma_f32_16x16x4f32(w2[2][i], bop[i], Dm2, 0, 0, 0); Dm3 = __builtin_amdgcn_mfma_f32_16x16x4f32(w2[3][i], bop[i], Dm3, 0, 0, 0); }
                  S[0] = Dm0; S[1] = Dm1; S[2] = Dm2; S[3] = Dm3; }
                asm volatile("s_waitcnt lgkmcnt(0)" ::: "memory");
                if (lane == 0) flags[8 + wave] = (unsigned)(blk + 1);
                if (q < 2 && !pass) {
#pragma unroll
                    for (int i = 0; i < 4; ++i) { const size_t nt = nb0 + seq_j(dir, blk * BS + 4 * q + i); YS[((size_t)dir * M + nt) * 1024 + rowg] = f2bf(Dy[i]); } }
            }
        } else {
            const int sw = wave - 2; const int ch = h * 64 + lane;
            LAS unsigned char* sc = F.lds + OFF_STG + sw * STG;
            const float kkc = F.in[I_KK][(size_t)l * 1024 + ch], kac = F.in[I_KA][(size_t)l * 1024 + ch];
            bf16_t pr[8], pk[8], pv[8], pw[8], pa_[8]; float pn[8];
#define SC2_FETCH(bk) do { _Pragma("unroll") for (int t = 0; t < 8; ++t) { const size_t nt = nb0 + seq_j(dir, (bk) * BS + t); \
                pr[t] = RKV[nt * 3072 + ch]; pk[t] = RKV[nt * 3072 + 1024 + ch]; pv[t] = RKV[nt * 3072 + 2048 + h * 64 + vhalf * 32 + (lane & 31)]; \
                pw[t] = LO[nt * LORA_N + dir * 1024 + ch]; pa_[t] = LO[nt * LORA_N + 2048 + dir * 1024 + ch]; pn[t] = KKN[nt * 16 + h]; } } while (0)
#ifndef SC2_WEIGHTED
#define SC2_WEIGHTED 1
#endif
            const int pA = sw == 0 ? 0 : sw == 1 ? 1 : sw == 4 ? 2 : sw == 5 ? 3 : sw == 2 ? 8 : 9; const bool two = !(sw == 2 || sw == 3);
#define SC2_BLK(it) (SC2_WEIGHTED == 2 ? (two ? (it) * 4 + pA : NBLK) : SC2_WEIGHTED ? (two ? ((it) >> 1) * 10 + pA + 4 * ((it) & 1) : (it) * 10 + pA) : sw + (it) * NSTG)
            SC2_FETCH(SC2_BLK(0));
            for (int it_ = 0;; ++it_) { const int blk = SC2_BLK(it_); if (blk >= NBLK) break; const int nblk_ = SC2_BLK(it_ + 1);
                const int slot = blk & (RB - 1); LAS unsigned char* sp = F.lds + slot * SLOT;
                float fr[8], fk[8], fv[8], fw[8], fa[8], fn[8];
#pragma unroll
                for (int t = 0; t < 8; ++t) { fr[t] = bf2f(pr[t]); fk[t] = bf2f(pk[t]); fv[t] = bf2f(pv[t]); fw[t] = bf2f(pw[t]); fa[t] = bf2f(pa_[t]); fn[t] = pn[t]; }
                if (nblk_ < NBLK) SC2_FETCH(nblk_);
                if (blk >= RB) { unsigned spin = 0; while (lds_ld(flags + 8) < (unsigned)(blk - RB + 1) || lds_ld(flags + 9) < (unsigned)(blk - RB + 1)) { __builtin_amdgcn_s_sleep(2); if (++spin > (1u << 24)) break; } }
                asm volatile("" ::: "memory");
                if (variant == 2) { if (lane == 0) flags[slot] = (unsigned)(blk + 1); continue; }
                float bt[8], km[8]; float g = 1.f;
#pragma unroll
                for (int t = 0; t < 8; ++t) { const float dec = __expf(-0.60653065971263342f * fw[t]); const float kk = fk[t] * kkc * fn[t]; const float gp = g; g *= dec; const float ig = __builtin_amdgcn_rcpf(g);
                    const float a = fa[t]; bt[t] = a * kk * ig; km[t] = fk[t] * (1.0f + (a - 1.0f) * kac) * ig;
                    ((LAS float*)(sp + SL_X))[t * 64 + lane] = g * fr[t]; ((LAS float*)(sp + SL_X))[(8 + t) * 64 + lane] = gp * kk;
                    ((LAS float*)(sc + ST_PM))[t * 64 + lane] = bt[t]; ((LAS float*)(sc + ST_PM))[(8 + t) * 64 + lane] = km[t];
                    if (lane < 32) ((LAS float*)(sp + SL_VT))[lane * 8 + t] = fv[t]; }
                ((LAS float*)(sp + SL_G))[lane] = g;
                asm volatile("s_waitcnt lgkmcnt(0)" ::: "memory");
                { const int n = lane & 15, q = lane >> 4; f32x4 Gp[4], pa[4], xb[4];
#pragma unroll
                  for (int mb = 0; mb < 4; ++mb) { pa[mb] = *(const LAS f32x4*)(sc + ST_PM + (n * 64 + 16 * mb + 4 * q) * 4); xb[mb] = *(const LAS f32x4*)(sp + SL_X + (n * 64 + 16 * mb + 4 * q) * 4); Gp[mb] = (f32x4){0.f, 0.f, 0.f, 0.f}; }
#pragma unroll
                  for (int i = 0; i < 4; ++i)
#pragma unroll
                      for (int mb = 0; mb < 4; ++mb) Gp[mb] = __builtin_amdgcn_mfma_f32_16x16x4f32(pa[mb][i], xb[mb][i], Gp[mb], 0, 0, 0);
                  const f32x4 Gd = (Gp[0] + Gp[1]) + (Gp[2] + Gp[3]);
#pragma unroll
                  for (int i = 0; i < 4; ++i) ((LAS float*)(sc + ST_GM))[(4 * q + i) * 16 + n] = Gd[i]; }
                asm volatile("s_waitcnt lgkmcnt(0)" ::: "memory");
                const LAS float* GM = (const LAS float*)(sc + ST_GM); LAS float* Tm = (LAS float*)(sc + ST_T); LAS float* TG = (LAS float*)(sc + ST_TG);
                const int p = lane & 7;
                { f32x4 g0[8][4];
#pragma unroll
                  for (int i = 0; i < 8; ++i)
#pragma unroll
                      for (int c4 = 0; c4 < 4; ++c4) g0[i][c4] = *(const LAS f32x4*)(GM + i * 16 + 4 * c4);
                  float Tr[8], Q1r[8];
#pragma unroll
                  for (int c = 0; c < 8; ++c) { float acc = (c == p) ? 1.f : 0.f;
#pragma unroll
                      for (int i = 0; i < 8; ++i) if (i < c) acc -= Tr[i] * g0[i][2 + (c >> 2)][c & 3];
                      Tr[c] = acc; }
#pragma unroll
                  for (int t = 0; t < 8; ++t) { float acc = 0.f;
#pragma unroll
                      for (int j = 0; j < 8; ++j) if (j <= t) acc += Tr[j] * g0[j][t >> 2][t & 3];
                      Q1r[t] = acc; }
                  if (lane < 8) { *(LAS f32x4*)(Tm + p * 8) = (f32x4){Tr[0], Tr[1], Tr[2], Tr[3]}; *(LAS f32x4*)(Tm + p * 8 + 4) = (f32x4){Tr[4], Tr[5], Tr[6], Tr[7]};
                                  *(LAS f32x4*)(TG + p * 8) = (f32x4){Q1r[0], Q1r[1], Q1r[2], Q1r[3]}; *(LAS f32x4*)(TG + p * 8 + 4) = (f32x4){Q1r[4], Q1r[5], Q1r[6], Q1r[7]}; }
                  asm volatile("s_waitcnt lgkmcnt(0)" ::: "memory");
                  f32x4 tg[8][2], gr[4];
#pragma unroll
                  for (int j = 0; j < 8; ++j) { tg[j][0] = *(const LAS f32x4*)(TG + j * 8); tg[j][1] = *(const LAS f32x4*)(TG + j * 8 + 4); }
#pragma unroll
                  for (int c4 = 0; c4 < 4; ++c4) gr[c4] = *(const LAS f32x4*)(GM + (8 + p) * 16 + 4 * c4);
                  float q2[8];
#pragma unroll
                  for (int t = 0; t < 8; ++t) { float acc = (p <= t) ? gr[t >> 2][t & 3] : 0.f;
#pragma unroll
                      for (int j = 1; j < 8; ++j) { const float cj = (j > p) ? gr[2 + (j >> 2)][j & 3] : 0.f; acc -= cj * tg[j][t >> 2][t & 3]; }
                      q2[t] = acc; }
                  if (lane < 8) { LAS float* QT = (LAS float*)(sp + SL_QT);
#pragma unroll
                      for (int t = 0; t < 8; ++t) { QT[t * 16 + p] = q2[t]; QT[t * 16 + 8 + p] = -Q1r[t]; } }
                }
                { float M1[8];
#pragma unroll
                  for (int i = 0; i < 8; ++i) { float acc = 0.f;
#pragma unroll
                      for (int j = 0; j < 8; ++j) if (j >= i) acc += Tm[i * 8 + j] * bt[j];
                      M1[i] = acc; }
                  float K2[8];
#pragma unroll
                  for (int i = 0; i < 8; ++i) { float acc = km[i];
#pragma unroll
                      for (int j = 0; j < 8; ++j) if (j > i) acc -= GM[(8 + i) * 16 + 8 + j] * M1[j];
                      K2[i] = acc; }
                  LAS f32x4* wo = (LAS f32x4*)(sp + SL_W2T + lane * 64); const float ng = -g;
                  wo[0] = (f32x4){K2[0], K2[1], K2[2], K2[3]} * g; wo[1] = (f32x4){K2[4], K2[5], K2[6], K2[7]} * g; wo[2] = (f32x4){M1[0], M1[1], M1[2], M1[3]} * ng; wo[3] = (f32x4){M1[4], M1[5], M1[6], M1[7]} * ng; }
                asm volatile("s_waitcnt lgkmcnt(0)" ::: "memory");
                if (lane == 0) flags[slot] = (unsigned)(blk + 1);
            }
#undef SC2_FETCH
#undef SC2_BLK
        }
    }
    __syncthreads();
}
#ifndef MK_MULTI
#define MK_MULTI 0
#endif
constexpr int NPL = 16, NPH = 3 + DEPTH * NPL;
#ifndef DBG_MIX
#define DBG_MIX 1.0f
#endif
#ifndef DBG_FFN
#define DBG_FFN 1.0f
#endif
#ifndef DBG_RW
#define DBG_RW 1.0f
#endif
#ifndef DBG_MLA
#define DBG_MLA 1.0f
#endif
#ifndef DBG_LRU
#define DBG_LRU 1.0f
#endif
struct Args { const float* in[40]; float* out; unsigned char* ws; int ph_lo, ph_hi; };
#define CAS __attribute__((address_space(4)))
#define GEMM(EPI, e, Aptr, Bptr, lda_, ldb_, K_, nM_, nN_, nG_, pmode_, lrug_) do { pg8::Gemm g_{(const bf16_t*)(Aptr), (const bf16_t*)(Bptr), lda_, ldb_, K_, lrug_, (pmode_) == 2 ? 4 : 0}; pg8::Order S_; \
        S_.init(nM_, nN_, nG_, G, (bx + G - rot) % G, pmode_, 4); pg8::gemm_phase<EPI>(F.lds, g_, S_, e); rot = (rot + (nM_) * (nN_) * (nG_)) % G; } while (0)
__device__ __forceinline__ void make_ctx(Ctx& F, const CAS Args& args, unsigned char* lds_) {
    unsigned char* ws = args.ws;
    int tid = threadIdx.x; asm volatile("" : "+v"(tid));
    F.lds = (LAS unsigned char*)lds_; F.ws = ws; F.in = args.in; F.out = args.out;
    F.tid = tid; F.lane = F.tid & 63; F.wave = __builtin_amdgcn_readfirstlane(F.tid >> 6);
    F.G = gridDim.x; { int bx = blockIdx.x; asm volatile("" : "+s"(bx)); F.vcu = (F.G % 8 == 0) ? (bx % 8) * (F.G / 8) + bx / 8 : bx; }
    F.gw = F.vcu * 8 + F.wave; F.NGW = F.G * 8;
}
template <int KIND> __device__ __forceinline__ void run_phase(const Args& args_, int l_, unsigned char* lds_, int pass = 0) {
    int l = l_; asm volatile("" : "+s"(l));
    unsigned long long kp_ = (unsigned long long)__builtin_amdgcn_kernarg_segment_ptr(); asm volatile("" : "+s"(kp_));
    const CAS Args& args = *(const CAS Args*)kp_; (void)args_;
    Ctx F; make_ctx(F, args, lds_); char* lds_gen = (char*)lds_;
    unsigned char* W = F.ws + WS_W; unsigned char* R = F.ws + WS_R;
    bf16_t* H = (bf16_t*)(F.ws + WS_H); float* X = (float*)(F.ws + WS_X); bf16_t* YC = (bf16_t*)(F.ws + WS_YCAT);
    int bx = blockIdx.x; asm volatile("" : "+s"(bx)); const int G = F.G; int rot = 0;
    const float* modl = (const float*)(F.ws + WS_MOD) + (size_t)l * 5 * 18432;
    const bool lastl = (l + 1 == DEPTH); const int PM = lastl ? 1 : 0, NP = lastl ? 64 : NPAN;
    float* PART = (float*)(R + R_PART); const int PMS = lastl ? 1 : 2;
    const float* lng = F.in[I_LNG] + (size_t)l * 3 * D; const float* lnb = F.in[I_LNB] + (size_t)l * 3 * D;
    if constexpr (KIND == 0) { ph_modp(F); ph_rope(F); ph_xasm(F); ph_cvt(F, 0); }
    if constexpr (KIND == 1) { ph_modr(F); }
    if constexpr (KIND == 2) { ph_h0(F); }
    if constexpr (KIND == 3) { pg8::EpiSwiGLU e{(bf16_t*)(R + R_ACT), DFF}; GEMM(pg8::EpiSwiGLU, e, H, W + W_GU0, D, D, D, NPAN, 44, 1, 0, 0); }
    if constexpr (KIND == 4) { pg8::EpiResid e{X, modl + 2 * 2048, pass ? 0.f : 0.5f * DBG_FFN, pass ? 1.f : ALPHA, 3 * l, l == 0 ? F.in[I_X] : nullptr}; GEMM(pg8::EpiResid, e, R + R_ACT, W + W_D0, DFF, DFF, DFF, 64, 8, 1, 2, 0); }
    if constexpr (KIND == 5) { ph_ln(F, lng, lnb, modl, 3, 4, false, false, pass ? nullptr : PART, modl + 2 * 2048, 0.5f * DBG_FFN, 3 * l); }
    if constexpr (KIND == 6) { pg8::EpiBf16 e{(bf16_t*)(R + R_FA), FA_PAD, 0, (bf16_t*)(R + R_GB), GB_TILE0, 1024};     GEMM(pg8::EpiBf16, e, H, W + W_INA, D, D, D, NPAN, FA_PAD / 256, 1, 0, 0); }
    if constexpr (KIND == 7) { ph_prep(F, l); }
    if constexpr (KIND == 8) { { pg8::EpiGate e{(bf16_t*)(R + R_LO), (const float*)(F.ws + WS_LB) + (size_t)l * 4096, LORA_N}; GEMM(pg8::EpiGate, e, R + R_LIN, W + W_LORA, LORA_K, LORA_K, LORA_K, NPAN, 16, 1, 0, 0); }
                               { pg8::EpiBf16 e{(bf16_t*)(R + R_LO) + 4096, LORA_N, 0, nullptr, 1 << 30, 0}; GEMM(pg8::EpiBf16, e, R + R_LIN, (bf16_t*)(W + W_LORA) + (size_t)4096 * LORA_K, LORA_K, LORA_K, LORA_K, NPAN, 4, 1, 0, 0); }
                               { pg8::EpiBf16 e{(bf16_t*)(R + R_GT), 4096, 512, nullptr, 1 << 30, 0}; GEMM(pg8::EpiBf16, e, R + R_XC, W + W_LRU, 1024, 256, 256, NPAN, 2, 8, 0, 1); } }
#ifndef MERGE_KSPLIT
#define MERGE_KSPLIT 1
#endif
#ifndef CVT_IN_MERGE
#define CVT_IN_MERGE 0
#endif
#ifndef SCAN_V
#define SCAN_V 2
#endif
    if constexpr (KIND == 9) { if (pass < 2) { if (SCAN_V == 2) ph_rwkv_scan2(F, l, pass); else ph_rwkv_scan(F, l); } if (pass != 1) ph_lru_scan(F, l, pass == 0); }
    if constexpr (KIND == 10) { ph_rwkv_readout(F, l); ph_lru_readout(F); }
    if constexpr (KIND == 11) { { pg8::EpiBf16 e{(bf16_t*)(R + R_Q), 3072, 0, nullptr, 1 << 30, 0}; GEMM(pg8::EpiBf16, e, R + R_QL, W + W_UQ, 512, 512, 512, NP, 12, 1, PM, 0); }
                                { pg8::EpiBf16 e{(bf16_t*)(R + R_KN), 2048, 0, (bf16_t*)(R + R_V), 8, 2048}; GEMM(pg8::EpiBf16, e, R + R_KVC, W + W_UKV, 256, 256, 256, NPAN, 16, 1, 0, 0); } }
    if constexpr (KIND == 12) { ph_attn(F, l + 1 < DEPTH, lds_gen);
                                { pg8::EpiGate e{(bf16_t*)(R + R_GATE), F.in[I_GATEB] + (size_t)l * GATE_IN, GATE_IN}; GEMM(pg8::EpiGate, e, H, W + W_ING, D, D, D, NP, 24, 1, PM, 0); } }
    if constexpr (KIND == 13) { pg8::EpiMergeOne e{(const bf16_t*)(R + R_GATE), (bf16_t*)(R + R_Y2B), 16, 48, (LAS unsigned*)(F.lds + LDSCTL_OFF + 64)}; GEMM(pg8::EpiMergeOne, e, YC, W + W_PROJ, 4096, 4096, 4096, 64, 8, 1, MERGE_KSPLIT ? PMS : PM, 0);
#if CVT_IN_MERGE
                                if (!lastl && !pass) { const int nwg = NP * 8, nlast = nwg - ((nwg - 1) / G) * G, i0 = (2 * nlast < G) ? nlast : 0;
                                    __syncthreads(); if (bx >= i0) ph_cvt_m(F, l + 1, CVT_EARLY, (bx - i0) * 8 + F.wave, (G - i0) * 8, false); }
#endif
                              }
    if constexpr (KIND == 14) { pg8::EpiResid e{X, modl + 5 * 2048, pass ? 0.f : 1.0f * DBG_MIX, pass ? 1.f : ALPHA, 3 * l + 1, nullptr}; GEMM(pg8::EpiResid, e, R + R_Y2B, W + W_OUT, D, D, D, 64, 8, 1, PMS, 0); }
    if constexpr (KIND == 15) { ph_ln(F, lng + D, lnb + D, modl, 6, 7, false, lastl, (lastl || pass) ? nullptr : PART, modl + 5 * 2048, 1.0f * DBG_MIX, 3 * l + 1); }
    if constexpr (KIND == 16) { pg8::EpiSwiGLU e{(bf16_t*)(R + R_ACT), DFF}; GEMM(pg8::EpiSwiGLU, e, H, W + W_GU1, D, D, D, NP, 44, 1, PM, 0); }
    if constexpr (KIND == 17) { pg8::EpiResid e{X, modl + 8 * 2048, pass ? 0.f : 0.5f * DBG_FFN, pass ? 1.f : ALPHA, 3 * l + 2, nullptr}; GEMM(pg8::EpiResid, e, R + R_ACT, W + W_D1, DFF, DFF, DFF, 64, 8, 1, PMS, 0);
                                if (!lastl && !pass) { __syncthreads(); ph_cvt_m(F, l + 1, CVT_IN_MERGE ? CVT_MID : 0xFull, bx * 8 + F.wave, G * 8, false); } }
    if constexpr (KIND == 18) { ph_ln(F, lng + 2 * D, lnb + 2 * D, modl + 5 * 18432, 0, 1, l + 1 == DEPTH, false, lastl ? nullptr : PART, modl + 8 * 2048, 0.5f * DBG_FFN, 3 * l + 2); if (l + 1 < DEPTH) { __syncthreads(); ph_cvt_m(F, l + 1, CVT_IN_MERGE ? CVT_LATE : (CVT_ALL & ~0xFull)); } }
}
#if MK_MULTI
template <int KIND> __global__ void __launch_bounds__(512, 2) k_one(Args args, int l) {
    extern __shared__ __attribute__((aligned(16))) unsigned char lds_[];
    run_phase<KIND>(args, l, lds_);
}
#else
__device__ __forceinline__ void grid_bar(const Args& args, unsigned char* lds_) {
    XcdBarrier bar; bar.bar = (unsigned*)(args.ws + WS_CTL); bar.x = xb_xcc_id(); bar.st = (volatile LAS unsigned*)((LAS unsigned char*)lds_ + LDSCTL_OFF) + 8;
    xcd_barrier(bar);
}
__global__ void __launch_bounds__(512, 2) fwd(Args args) {
    extern __shared__ __attribute__((aligned(16))) unsigned char lds_[];
    { volatile LAS unsigned* MISC = (volatile LAS unsigned*)((LAS unsigned char*)lds_ + LDSCTL_OFF);
      for (int u = threadIdx.x; u < 256; u += 512) MISC[u] = 0u;
      __syncthreads();
      (void)xcd_barrier_post((unsigned*)(args.ws + WS_CTL), MISC + 8); }
#ifndef REP3
#define REP3 1
#endif
#ifndef REP4
#define REP4 1
#endif
#ifndef REP6
#define REP6 1
#endif
#ifndef REP7
#define REP7 1
#endif
#ifndef REP8
#define REP8 1
#endif
#ifndef REP9
#define REP9 1
#endif
#ifndef REP10
#define REP10 1
#endif
#ifndef REP11
#define REP11 1
#endif
#ifndef REP12
#define REP12 1
#endif
#ifndef REP19
#define REP19 1
#endif
#ifndef REP13
#define REP13 1
#endif
#ifndef REP14
#define REP14 1
#endif
#ifndef REP16
#define REP16 1
#endif
#ifndef REP17
#define REP17 1
#endif
#define PH(K, l) run_phase<K>(args, l, lds_); grid_bar(args, lds_);
#define PHR(K, l, REP) for (int rep_ = 0; rep_ < (REP); ++rep_) { run_phase<K>(args, l, lds_, rep_); grid_bar(args, lds_); }
#ifndef REP0
#define REP0 1
#endif
#ifndef REP9L
#define REP9L 0
#endif
#ifndef REPLN
#define REPLN 1
#endif
#ifndef REPBAR
#define REPBAR 0
#endif
#ifndef REP2
#define REP2 1
#endif
    PHR(0, 0, REP0) PH(1, 0) PHR(2, 0, REP2)
    for (int rb_ = 0; rb_ < REPBAR; ++rb_) grid_bar(args, lds_);
    for (int l = 0; l < DEPTH; ++l) {
        PHR(3, l, REP3) PHR(4, l, REP4) PHR(5, l, REPLN) PHR(6, l, REP6) PHR(7, l, REP7) PHR(8, l, REP8) PHR(9, l, REP9) if (REP9L) { run_phase<9>(args, l, lds_, 2); grid_bar(args, lds_); } PHR(10, l, REP10) PHR(11, l, REP11) PHR(12, l, REP12) PHR(13, l, REP13) PHR(14, l, REP14) PHR(15, l, REPLN) PHR(16, l, REP16) PHR(17, l, REP17)
        run_phase<18>(args, l, lds_); if (l + 1 < DEPTH) grid_bar(args, lds_);
    }
#undef PHR
#undef PH
}
#endif


#if MK_MULTI
template <int K> static void launch_kind(int grid, hipStream_t stream, const Args& a, int l) {
    static bool attr = false;
    if (!attr) { (void)hipFuncSetAttribute((const void*)k_one<K>, hipFuncAttributeMaxDynamicSharedMemorySize, LDS_BYTES); attr = true; }
    hipLaunchKernelGGL(k_one<K>, dim3(grid), dim3(512), LDS_BYTES, stream, a, l);
}
template <int K> static void launch_layer(int grid, hipStream_t stream, const Args& a, int l) { if constexpr (K <= 18) { launch_kind<K>(grid, stream, a, l); if (K == 12) {
#if defined(DBG_PROBE)
        if (DBG_PROBE == 1 && l == 0) hipLaunchKernelGGL(k_dbg_gate, dim3(32), dim3(256), 0, stream, a, l);
        if (DBG_PROBE >= 6 && DBG_PROBE <= 11 && l == 0) { (void)hipMemsetAsync((char*)a.ws + WS_CTL + 8201 * 4, 0xff, 4, stream); hipLaunchKernelGGL(k_dbg_gate_tiles, dim3(68 * 24), dim3(256), 0, stream, a); hipLaunchKernelGGL(k_dbg_tiles_fin, dim3(1), dim3(64), 0, stream, a, DBG_PROBE); }
        if (DBG_PROBE >= 3 && DBG_PROBE <= 5 && l == 0) { (void)hipMemsetAsync((char*)a.ws + WS_CTL + 8201 * 4, 0xff, 4, stream); hipLaunchKernelGGL(k_dbg_gate_range, dim3(1024), dim3(256), 0, stream, a, DBG_PROBE); hipLaunchKernelGGL(k_dbg_range_fin, dim3(1), dim3(64), 0, stream, a, DBG_PROBE); }
#endif
        }
#if defined(DBG_PROBE)
        if (K == 6 && DBG_PROBE == 2 && l == 0) hipLaunchKernelGGL(k_dbg_fa, dim3(32), dim3(256), 0, stream, a, l);
        if (K == 4 && DBG_PROBE == 21 && l == 0) hipLaunchKernelGGL(k_dbg_ffn, dim3(96), dim3(256), 0, stream, a);
        if (K == 7 && DBG_PROBE == 24 && l == 0) hipLaunchKernelGGL(k_dbg_prep, dim3(16), dim3(256), 0, stream, a, l);
        if (K == 3 && DBG_PROBE == 23 && l == 0) hipLaunchKernelGGL(k_dbg_mod, dim3(8), dim3(256), 0, stream, a);
        if (K == 10 && DBG_PROBE == 22 && l == 0) hipLaunchKernelGGL(k_dbg_rwkv, dim3(32), dim3(64), 0, stream, a, l);
        if (K == 10 && DBG_PROBE == 20 && l == 0) hipLaunchKernelGGL(k_dbg_lru, dim3(4), dim3(64), 0, stream, a, l);
#endif
        launch_layer<K + 1>(grid, stream, a, l); } }
#endif
extern "C" void kernel_launch(void* const* d_in, const int* in_sizes, int n_in, void* d_out, int out_size, void* d_ws, size_t ws_size, hipStream_t stream) {
    static int grid = 0;
    if (grid == 0) {
        if (n_in != 40 || in_sizes[0] != NB * SEQ * D || out_size != NB * SEQ * D || ws_size < WS_END) {
            fprintf(stderr, "kernel_launch: shape mismatch: n_in %d in0 %d out %d ws %zu (need %zu); nothing launched\n", n_in, n_in > 0 ? in_sizes[0] : -1, out_size, ws_size, (size_t)WS_END); grid = -1; return; }
        int dev = 0, cus = 0;
        if (hipGetDevice(&dev) != hipSuccess || hipDeviceGetAttribute(&cus, hipDeviceAttributeMultiprocessorCount, dev) != hipSuccess) { grid = -1; return; }
#if !MK_MULTI
        int per_cu = 0;
        if (hipFuncSetAttribute((const void*)fwd, hipFuncAttributeMaxDynamicSharedMemorySize, LDS_BYTES) != hipSuccess) { fprintf(stderr, "kernel_launch: hipFuncSetAttribute failed\n"); grid = -1; return; }
        if (hipOccupancyMaxActiveBlocksPerMultiprocessor(&per_cu, (const void*)fwd, 512, LDS_BYTES) != hipSuccess || per_cu < 1) { fprintf(stderr, "kernel_launch: occupancy query says %d blocks per CU\n", per_cu); }
        (void)hipGetLastError();
#endif
        grid = cus;
    }
    if (grid < 0) return;
    if (hipMemsetAsync((char*)d_ws + WS_CTL, 0, CTL_BYTES, stream) != hipSuccess) return;
    Args a{};
    for (int i = 0; i < 40; ++i) a.in[i] = (const float*)d_in[i];
    a.out = (float*)d_out; a.ws = (unsigned char*)d_ws; a.ph_lo = 0; a.ph_hi = NPH;
#if MK_MULTI
    launch_kind<0>(grid, stream, a, 0); launch_kind<1>(grid, stream, a, 0); launch_kind<2>(grid, stream, a, 0);
    for (int l = 0; l < DEPTH; ++l) launch_layer<3>(grid, stream, a, l);
#if defined(DBG_PROBE)
    hipLaunchKernelGGL(k_dbg_final, dim3(1), dim3(64), 0, stream, a);
#endif
#else
    hipLaunchKernelGGL(fwd, dim3(grid), dim3(512), LDS_BYTES, stream, a);
#endif
    const hipError_t le = hipPeekAtLastError();
    if (le != hipSuccess) fprintf(stderr, "kernel_launch: launch failed: %s\n", hipGetErrorName(le));
}
```

```cpp
#include <hip/hip_runtime.h>
#include <cstdio>
#include <cstdint>

#define LAS __attribute__((address_space(3)))
#define GAS __attribute__((address_space(1)))
typedef unsigned short bf16_t;
typedef short bf16x8 __attribute__((ext_vector_type(8)));
typedef short s16x4 __attribute__((ext_vector_type(4)));
typedef float f32x2 __attribute__((ext_vector_type(2)));
typedef float f32x4 __attribute__((ext_vector_type(4)));
typedef float f32x8 __attribute__((ext_vector_type(8)));
typedef float f32x16 __attribute__((ext_vector_type(16)));
typedef unsigned u32x2 __attribute__((ext_vector_type(2)));
typedef unsigned u32x4 __attribute__((ext_vector_type(4)));

constexpr int D = 2048, NB = 4, SEQ = 4096, CTX = 256, TPB = CTX + SEQ  , M = NB * TPB  , DFF = 5632, NMOD = 9, DEPTH = 2;
constexpr int NPAN = M / 256;
constexpr int RWKV_W = 1024, RW_IN = 3360, MLA_IN = 832, LRU_IN = 2048, GATE_IN = 6144, IN_COLS = 12384;
constexpr int FA = RW_IN + MLA_IN + LRU_IN  , FA_PAD = 6400;
constexpr int OFF_QLAT = 3360, OFF_KVLAT = 3872, OFF_KROPE = 4128, OFF_XR = 4192, OFF_GB = 5216;
constexpr int GB_TILE0 = 21, GB_ROW0 = GB_TILE0 * 256  ;
static_assert(GB_ROW0 + 1024 == FA_PAD && OFF_GB % 32 == 0, "gelu-branch tiles");
constexpr int LORA_K = 384, LORA_N = 5120;
constexpr int NHEAD = 16, QK_NOPE = 128, QK_ROPE = 64, QKD = 192, VD = 128;
constexpr float LN_EPS = 1e-6f, GN_EPS = 64e-5f, ALPHA = 1.41421356237309515f;

constexpr size_t al256(size_t x) { return (x + 255) & ~(size_t)255; }
constexpr size_t WS_CTL = 0, CTL_BYTES = 65536;
constexpr size_t WS_MOD = WS_CTL + CTL_BYTES;
constexpr size_t WS_ROPE = al256(WS_MOD + (size_t)2 * 5 * 18432 * 4);
constexpr size_t WS_LB = al256(WS_ROPE + (size_t)4096 * 32 * 2 * 4);
constexpr size_t WS_STATS = al256(WS_LB + (size_t)2 * 4096 * 4);
constexpr size_t WS_LNT = al256(WS_STATS + (size_t)M * 2 * 4);
constexpr size_t WS_W = al256(WS_LNT + (size_t)7 * 4096 * 4);
constexpr size_t W_GU0 = 0, W_GU1 = W_GU0 + (size_t)11264 * 2048 * 2, W_D0 = W_GU1 + (size_t)11264 * 2048 * 2, W_D1 = W_D0 + (size_t)2048 * 5632 * 2;
constexpr size_t W_INA = W_D1 + (size_t)2048 * 5632 * 2, W_ING = W_INA + (size_t)FA_PAD * 2048 * 2, W_UQ = W_ING + (size_t)6144 * 2048 * 2;
constexpr size_t W_UKV = W_UQ + (size_t)3072 * 512 * 2, W_LORA = W_UKV + (size_t)4096 * 256 * 2, W_LRU = W_LORA + (size_t)LORA_N * LORA_K * 2;
constexpr size_t W_PROJ = W_LRU + (size_t)8 * 512 * 256 * 2, W_OUT = W_PROJ + (size_t)2048 * 4096 * 2, W_END = W_OUT + (size_t)2048 * 2048 * 2;
constexpr size_t WS_X = al256(WS_W + W_END);
constexpr size_t WS_H = WS_X + (size_t)M * D * 4;
constexpr size_t WS_YCAT = WS_H + (size_t)M * D * 2;
constexpr size_t WS_R = WS_YCAT + (size_t)M * 4096 * 2;
constexpr size_t R_ACT = 0;
constexpr size_t R_MODP = 0;
constexpr size_t R_FA = 0;
constexpr size_t R_PREP = (size_t)M * FA_PAD * 2;
constexpr size_t R_LIN = R_PREP;
constexpr size_t R_RKV = R_LIN + (size_t)M * LORA_K * 2;
constexpr size_t R_XC = R_RKV + (size_t)M * 3072 * 2;
constexpr size_t R_GB = R_XC + (size_t)M * 1024 * 2;
constexpr size_t R_QL = R_GB + (size_t)M * 1024 * 2;
constexpr size_t R_KVC = R_QL + (size_t)M * 512 * 2;
constexpr size_t R_KR = R_KVC + (size_t)M * 256 * 2;
constexpr size_t R_KKN = R_KR + (size_t)M * 64 * 2;
constexpr size_t R_PREP_END = R_KKN + (size_t)M * 16 * 4;
constexpr size_t R_LO = 0;
constexpr size_t R_GT = R_PREP_END;
constexpr size_t R_YS = R_GT + (size_t)M * 4096 * 2;
constexpr size_t R_Q = 0;
constexpr size_t R_KN = R_Q + (size_t)M * 3072 * 2;
constexpr size_t R_V = R_KN + (size_t)M * 2048 * 2;
constexpr size_t R_GATE = R_PREP_END;
constexpr size_t R_Y2F = 0;
constexpr size_t R_Y2B = R_Y2F + (size_t)M * 2048 * 4;
constexpr size_t R_PART = (size_t)220 << 20;
constexpr size_t R_END = R_YS + (size_t)2 * M * 1024 * 2;
static_assert(R_LO + (size_t)M * LORA_N * 2 <= R_PREP, "LO fits the dead FA slot");
static_assert(R_V + (size_t)M * 2048 * 2 <= R_QL, "Q|K|V fit below the live QL/KVC/KR");
static_assert(R_GATE + (size_t)M * 6144 * 2 <= R_END, "GATE fits");
static_assert(R_Y2B + (size_t)M * 2048 * 2 <= R_GATE, "Y2 below GATE");
static_assert(R_PART >= R_ACT + (size_t)M * DFF * 2 && R_PART >= R_Y2B + (size_t)M * 2048 * 2 && R_PART + (size_t)4 * 1024 * 2048 * 4 <= R_GATE, "partials clear of ACT / Y2 / GATE");
constexpr size_t WS_END = WS_R + R_END;

constexpr int RING_BYTES = 145408;
constexpr int LDSCTL_OFF = RING_BYTES;
constexpr int LDS_BYTES = 147456;

#ifndef USE_F16
#define USE_F16 0
#endif
typedef __bf16 bf16x2_n __attribute__((ext_vector_type(2)));
typedef _Float16 f16x2_n __attribute__((ext_vector_type(2)));
typedef _Float16 f16x8_n __attribute__((ext_vector_type(8)));
__device__ __forceinline__ unsigned cvt_pk_bf16(float lo, float hi) { const f32x2 v = {lo, hi};
#if USE_F16
    const f16x2_n r = __builtin_convertvector(v, f16x2_n); return __builtin_bit_cast(unsigned, r);
#else
    const bf16x2_n r = __builtin_convertvector(v, bf16x2_n); return __builtin_bit_cast(unsigned, r);
#endif
}
#if USE_F16
__device__ __forceinline__ float bf_lo(unsigned w) { return (float)__builtin_bit_cast(f16x2_n, w)[0]; }
__device__ __forceinline__ float bf_hi(unsigned w) { return (float)__builtin_bit_cast(f16x2_n, w)[1]; }
__device__ __forceinline__ float bf2f(bf16_t b) { return (float)__builtin_bit_cast(_Float16, b); }
#define MFMA16(a, b, c) __builtin_amdgcn_mfma_f32_16x16x32_f16(__builtin_bit_cast(f16x8_n, a), __builtin_bit_cast(f16x8_n, b), c, 0, 0, 0)
#define MFMA32(a, b, c) __builtin_amdgcn_mfma_f32_32x32x16_f16(__builtin_bit_cast(f16x8_n, a), __builtin_bit_cast(f16x8_n, b), c, 0, 0, 0)
#else
__device__ __forceinline__ float bf_lo(unsigned w) { return __uint_as_float(w << 16); }
__device__ __forceinline__ float bf_hi(unsigned w) { return __uint_as_float(w & 0xffff0000u); }
__device__ __forceinline__ float bf2f(bf16_t b) { return __uint_as_float(((unsigned)b) << 16); }
#define MFMA16(a, b, c) __builtin_amdgcn_mfma_f32_16x16x32_bf16(a, b, c, 0, 0, 0)
#define MFMA32(a, b, c) __builtin_amdgcn_mfma_f32_32x32x16_bf16(a, b, c, 0, 0, 0)
#endif
__device__ __forceinline__ bf16_t f2bf(float f) { return (bf16_t)(cvt_pk_bf16(f, 0.f) & 0xffffu); }
__device__ __forceinline__ float wave_sum(float v) {
#pragma unroll
    for (int o = 1; o < 64; o <<= 1) v += __shfl_xor(v, o);
    return v;
}
__device__ __forceinline__ float sigmoidf_(float x) { return 1.0f / (1.0f + __expf(-x)); }
__device__ __forceinline__ float siluf_(float x) { return x / (1.0f + __expf(-x)); }
__device__ __forceinline__ float softplusf_(float x) { const float e = __expf(x); const float p = e * (1.0f - e * (0.5f - e * (0.33333334f - e * (0.25f - e * 0.2f)))); return x > 20.f ? x : (e < 0.125f ? p : __logf(1.0f + e)); }
__device__ __forceinline__ float gelu_tanh_(float x) { const float u = 0.7978845608028654f * (x + 0.044715f * x * x * x); return x * __builtin_amdgcn_rcpf(1.0f + __expf(-2.0f * u)); }
__device__ __forceinline__ u32x4 zero4() { unsigned z = 0u; asm volatile("" : "+v"(z)); return (u32x4){z, z, z, z}; }
__device__ __forceinline__ int modrow_of_panel(int pm) { return (pm % 17 == 0) ? 4 : pm / 17; }
#define MK_MULTI 0
namespace pg8 {
constexpr int BM = 256, BK = 64, HALF = 128, HTB = HALF * BK * 2  , STAGE_BYTES = 8 * HTB, NXCD = 8, WGM = 8;
__host__ __device__ __forceinline__ int lds_byte(int r, int c) { const int st = (r >> 4) * 2 + (c >> 5), rr = r & 15, cc = c & 31, ob = rr * 64 + cc * 2; return st * 1024 + (ob ^ (((ob >> 9) & 1) << 5)); }
__host__ __device__ __forceinline__ void stage_rc(int b, int& R, int& C) { const int st = b / 1024, sb = b % 1024, swz = sb ^ (((sb >> 9) & 1) << 5); R = (st >> 1) * 16 + swz / 64; C = (st & 1) * 32 + (swz % 64) / 2; }
__host__ __device__ __forceinline__ int perm32(int rho) { const int n = rho >> 4, i = rho & 15; return 8 * (i >> 2) + 4 * n + (i & 3); }

struct Unit { int pm, pn, g, ks; };
struct Gemm { const bf16_t* A; const bf16_t* Bt; int lda, ldb, K; int lru_groups; int ksplit; };
__device__ __forceinline__ size_t a_base(const Gemm& g, const Unit& u) { return (size_t)u.pm * 256 * g.lda * 2 + (g.lru_groups ? (size_t)(u.g >> 1) * 256 * 2 : 0) + (u.ks > 0 ? (size_t)u.ks * (g.K / g.ksplit) * 2 : 0); }
__device__ __forceinline__ size_t b_base(const Gemm& g, const Unit& u) { return (size_t)u.pn * 256 * g.ldb * 2 + (g.lru_groups ? (size_t)u.g * 512 * 256 * 2 : 0) + (u.ks > 0 ? (size_t)u.ks * (g.K / g.ksplit) * 2 : 0); }

struct Order {
    int nM, nN, nG, per, nwg, G, c, pmode, S;
    __device__ void init(int nM_, int nN_, int nG_, int G_, int c_, int pmode_, int S_ = 0) { nM = nM_; nN = nN_; nG = nG_; per = nM * nN; nwg = per * nG + (pmode_ == 2 ? 4 * nN_ * S_ : 0); G = G_; c = c_; pmode = pmode_; S = S_; }
    __device__ bool next(int i, Unit& u) const {
        const long L = (long)i * G + c; if (L >= nwg) return false;
        if (pmode == 2 && L >= per) { const int Lp = (int)(L - per); u.ks = Lp % S; const int t = Lp / S; u.pm = 17 * (t & 3); u.pn = t >> 2; u.g = 0; return true; }
        const int g = (int)(L / per); int wgid = (int)(L % per);
        { const int q = per / NXCD, r = per % NXCD, xcd = wgid % NXCD, off = wgid / NXCD; wgid = (xcd < r ? xcd * (q + 1) : r * (q + 1) + (xcd - r) * q) + off; }
        const int nig = WGM * nN, gid = wgid / nig, fm = gid * WGM, gsz = (nM - fm) < WGM ? (nM - fm) : WGM;
        int pm = fm + ((wgid % nig) % gsz); u.pn = (wgid % nig) / gsz; u.g = g; u.ks = -1;
        if (pmode >= 1) pm = (pm >> 4) * 17 + 1 + (pm & 15);
        u.pm = pm; return true;
    }
};

__device__ __forceinline__ void unpack8(const u32x4 w, float (&x)[8]) { x[0] = bf_lo(w.x); x[1] = bf_hi(w.x); x[2] = bf_lo(w.y); x[3] = bf_hi(w.y); x[4] = bf_lo(w.z); x[5] = bf_hi(w.z); x[6] = bf_lo(w.w); x[7] = bf_hi(w.w); }
typedef f32x4 Acc[2][2][4][2];

template <class Epi>
__device__ __forceinline__ void gemm_phase(LAS unsigned char* lds, const Gemm g, const Order S, const Epi E) {
    int tid_ = threadIdx.x; asm volatile("" : "+v"(tid_));
    const int tid = tid_, wid = __builtin_amdgcn_readfirstlane(tid >> 6), lane = tid & 63, wr = wid >> 2, wc = wid & 3, fr = lane & 15, fq = lane >> 4;
    const int ntf = g.K / BK, nts = g.ksplit > 0 ? g.K / g.ksplit / BK : ntf;
    unsigned voffA[2], voffB[2];
#pragma unroll
    for (int i = 0; i < 2; ++i) { int R, C; stage_rc(tid * 16 + i * 8192, R, C); const int Rb = Epi::PERM ? ((R & ~31) + perm32(R & 31)) : R;
        voffA[i] = (unsigned)(R * g.lda + C) * 2u; voffB[i] = (unsigned)(Rb * g.ldb + C) * 2u; }
    const size_t kstep = (size_t)(BK * 2);
    const size_t hstepA = (size_t)HALF * g.lda * 2, hstepB = (size_t)HALF * g.ldb * 2;
    const unsigned ldsw = (unsigned)wid * 1024u;
    const int aoff = lds_byte(wr * 64 + fr, fq * 8), boff = lds_byte(wc * 32 + fr, fq * 8);
#define PG8_SA(b, h) (((b) * 2 + (h)) * HTB)
#define PG8_SB(b, h) ((4 + (b) * 2 + (h)) * HTB)
#define PG8_STAGE(bufoff, gbase, voff) do { _Pragma("unroll") for (int _i = 0; _i < 2; ++_i) \
        __builtin_amdgcn_global_load_lds((const unsigned*)((const char*)(gbase) + (voff)[_i]), (LAS unsigned*)(lds + (bufoff) + ldsw + _i * 8192), 16, 0, 0); } while (0)
#define PG8_LDA(dst, b, h) do { _Pragma("unroll") for (int m = 0; m < 4; ++m) _Pragma("unroll") for (int k = 0; k < 2; ++k) dst[m][k] = *(const LAS bf16x8*)(lds + PG8_SA(b, h) + aoff + m * 2048 + k * 1024); } while (0)
#define PG8_LDB(dst, b, h) do { _Pragma("unroll") for (int n = 0; n < 2; ++n) _Pragma("unroll") for (int k = 0; k < 2; ++k) dst[n][k] = *(const LAS bf16x8*)(lds + PG8_SB(b, h) + boff + n * 2048 + k * 1024); } while (0)
#define PG8_MMA(ai, bj, At, Bt) do { __builtin_amdgcn_s_setprio(1); _Pragma("unroll") for (int m = 0; m < 4; ++m) _Pragma("unroll") for (int n = 0; n < 2; ++n) _Pragma("unroll") for (int k = 0; k < 2; ++k) \
        acc[ai][bj][m][n] = MFMA16(Bt[n][k], At[m][k], acc[ai][bj][m][n]); __builtin_amdgcn_s_setprio(0); } while (0)
#define PG8_WAIT_V(n) asm volatile("s_waitcnt vmcnt(" #n ")" ::: "memory")
#define PG8_WAIT_L(n) asm volatile("s_waitcnt lgkmcnt(" #n ")" ::: "memory")
#define PG8_BAR __builtin_amdgcn_s_barrier()
#define PG8_SCHED __builtin_amdgcn_sched_barrier(0)
    Unit cur, nxt; int ui = 0;
    if (!S.next(0, cur)) return;
    Acc acc;
#pragma unroll
    for (int a = 0; a < 2; ++a)
#pragma unroll
        for (int b = 0; b < 2; ++b)
#pragma unroll
            for (int m = 0; m < 4; ++m)
#pragma unroll
                for (int n = 0; n < 2; ++n) acc[a][b][m][n] = (f32x4){0.f, 0.f, 0.f, 0.f};
    bf16x8 At[4][2], B0[2][2], B1[2][2];
    const char* cA = (const char*)g.A + a_base(g, cur); const char* cB = (const char*)g.Bt + b_base(g, cur);
    PG8_STAGE(PG8_SB(0, 0), cB, voffB); PG8_STAGE(PG8_SB(0, 1), cB + hstepB, voffB); PG8_STAGE(PG8_SA(0, 0), cA, voffA); PG8_STAGE(PG8_SA(0, 1), cA + hstepA, voffA);
    PG8_STAGE(PG8_SB(1, 0), cB + kstep, voffB); PG8_STAGE(PG8_SA(1, 0), cA + kstep, voffA); PG8_STAGE(PG8_SB(1, 1), cB + hstepB + kstep, voffB);
    if (wr == 1) PG8_BAR;
    PG8_WAIT_V(8); PG8_BAR;
    PG8_WAIT_V(6); PG8_BAR;
    for (;;) {
        const bool has_next = S.next(ui + 1, nxt);
        const char* nA = has_next ? (const char*)g.A + a_base(g, nxt) : cA; const char* nB = has_next ? (const char*)g.Bt + b_base(g, nxt) : cB;
        const int nt = cur.ks >= 0 ? nts : ntf;
        for (int t = 0; t < nt; t += 2) {
            const bool last = (t == nt - 2);
            if constexpr (Epi::HOOK) { if (t == E.t1 || t == E.t2) E.mid(acc, cur, t == E.t2 ? 1 : 0, wr, wc, fr, fq); }
            const char* a1 = cA + (size_t)(t + 1) * kstep;
            const char* a2 = last ? nA : cA + (size_t)(t + 2) * kstep; const char* b2 = last ? nB : cB + (size_t)(t + 2) * kstep;
            const char* a3 = a2 + kstep; const char* b3 = b2 + kstep;
            PG8_LDB(B0, 0, 0); PG8_LDB(B1, 0, 1); PG8_SCHED; PG8_LDA(At, 0, 0); PG8_STAGE(PG8_SA(1, 1), a1 + hstepA, voffA);
            PG8_WAIT_V(8); PG8_WAIT_L(0); PG8_BAR; PG8_MMA(0, 0, At, B0); PG8_MMA(0, 1, At, B1); PG8_BAR; PG8_SCHED;
            PG8_LDA(At, 0, 1); PG8_STAGE(PG8_SB(0, 0), b2, voffB); PG8_STAGE(PG8_SB(0, 1), b2 + hstepB, voffB); PG8_STAGE(PG8_SA(0, 0), a2, voffA);
            PG8_WAIT_V(8); PG8_WAIT_L(0); PG8_BAR; PG8_MMA(1, 0, At, B0); PG8_MMA(1, 1, At, B1); PG8_BAR; PG8_SCHED;
            PG8_LDB(B0, 1, 0); PG8_LDB(B1, 1, 1); PG8_SCHED; PG8_LDA(At, 1, 0); PG8_STAGE(PG8_SA(0, 1), a2 + hstepA, voffA);
            PG8_WAIT_V(8); PG8_WAIT_L(0); PG8_BAR; PG8_MMA(0, 0, At, B0); PG8_MMA(0, 1, At, B1); PG8_BAR; PG8_SCHED;
            PG8_LDA(At, 1, 1); PG8_STAGE(PG8_SB(1, 0), b3, voffB); PG8_STAGE(PG8_SB(1, 1), b3 + hstepB, voffB); PG8_STAGE(PG8_SA(1, 0), a3, voffA);
            PG8_WAIT_V(8); PG8_WAIT_L(0); PG8_BAR; PG8_MMA(1, 0, At, B0); PG8_MMA(1, 1, At, B1); PG8_BAR; PG8_SCHED;
        }
        if (wr == 0) PG8_BAR;
        E(acc, cur, wr, wc, fr, fq);
        if (!has_next) break;
#pragma unroll
        for (int a = 0; a < 2; ++a)
#pragma unroll
            for (int b = 0; b < 2; ++b)
#pragma unroll
                for (int m = 0; m < 4; ++m)
#pragma unroll
                    for (int n = 0; n < 2; ++n) acc[a][b][m][n] = (f32x4){0.f, 0.f, 0.f, 0.f};
        cur = nxt; cA = nA; cB = nB; ++ui;
        if (wr == 1) PG8_BAR;
    }
    PG8_WAIT_V(0);
    PG8_BAR;
#undef PG8_SA
#undef PG8_SB
#undef PG8_STAGE
#undef PG8_LDA
#undef PG8_LDB
#undef PG8_MMA
#undef PG8_WAIT_V
#undef PG8_WAIT_L
#undef PG8_BAR
#undef PG8_SCHED
}

struct EpiBf16 {
    static constexpr bool PERM = true, HOOK = false;
    bf16_t* O; int ldc; int gcols;
    bf16_t* O2; int split_pn; int ldc2;
    __device__ __forceinline__ void operator()(const Acc& acc, const Unit& u, int wr, int wc, int fr, int fq) const {
        const bool second = u.pn >= split_pn; bf16_t* base = second ? O2 : O; const int ld = second ? ldc2 : ldc;
        const int row0 = u.pm * BM + wr * 64 + fr, col0 = u.g * gcols + (second ? u.pn - split_pn : u.pn) * BM + wc * 32 + 8 * fq;
#pragma unroll
        for (int ai = 0; ai < 2; ++ai)
#pragma unroll
            for (int m = 0; m < 4; ++m) { bf16_t* rowp = base + (size_t)(row0 + ai * HALF + m * 16) * ld + col0;
#pragma unroll
                for (int bj = 0; bj < 2; ++bj) { const f32x4 v0 = acc[ai][bj][m][0], v1 = acc[ai][bj][m][1];
                    u32x4 w; w.x = cvt_pk_bf16(v0[0], v0[1]); w.y = cvt_pk_bf16(v0[2], v0[3]); w.z = cvt_pk_bf16(v1[0], v1[1]); w.w = cvt_pk_bf16(v1[2], v1[3]);
                    *(u32x4*)(rowp + bj * HALF) = w; } }
    }
};
struct EpiSwiGLU {
    static constexpr bool PERM = true, HOOK = false;
    bf16_t* O; int ldc;
    __device__ __forceinline__ void operator()(const Acc& acc, const Unit& u, int wr, int wc, int fr, int fq) const {
        const int row0 = u.pm * BM + wr * 64 + fr, col0 = u.pn * HALF + wc * 32 + 8 * fq;
#pragma unroll
        for (int ai = 0; ai < 2; ++ai)
#pragma unroll
            for (int m = 0; m < 4; ++m) { bf16_t* rowp = O + (size_t)(row0 + ai * HALF + m * 16) * ldc + col0;
                float o[8];
#pragma unroll
                for (int n = 0; n < 2; ++n)
#pragma unroll
                    for (int j = 0; j < 4; ++j) { const float gg = acc[ai][0][m][n][j], uu = acc[ai][1][m][n][j]; o[n * 4 + j] = gg * uu * __builtin_amdgcn_rcpf(1.0f + __expf(-gg)); }
                u32x4 w; w.x = cvt_pk_bf16(o[0], o[1]); w.y = cvt_pk_bf16(o[2], o[3]); w.z = cvt_pk_bf16(o[4], o[5]); w.w = cvt_pk_bf16(o[6], o[7]);
                *(u32x4*)rowp = w; }
    }
};
struct EpiResid {
    static constexpr bool PERM = false, HOOK = false;
    float* X; const float* gvec; float coef; float alpha; int lnid; const float* xin;
    __device__ __forceinline__ void partial(const Acc& acc, const Unit& u, int wr, int wc, int fr, int fq) const {
        asm volatile("; K-split partial tile" ::: "memory");
        float* P = (float*)((char*)X + (WS_R + R_PART - WS_X));
        float* base = P + ((size_t)u.ks * 1024 + (u.pm / 17) * 256 + wr * 64 + fr) * D + u.pn * BM + wc * 32 + 4 * fq;
#pragma unroll
        for (int ai = 0; ai < 2; ++ai)
#pragma unroll
            for (int m = 0; m < 4; ++m) { float* rowp = base + (size_t)(ai * HALF + m * 16) * D;
#pragma unroll
                for (int bj = 0; bj < 2; ++bj)
#pragma unroll
                    for (int n = 0; n < 2; ++n) *(f32x4*)(rowp + bj * HALF + n * 16) = acc[ai][bj][m][n]; }
    }
    __device__ __forceinline__ void whole(const Acc& acc, const Unit& u, int wr, int wc, int fr, int fq) const {
        const int row0 = u.pm * BM + wr * 64 + fr, col0 = u.pn * BM + wc * 32 + 4 * fq;
        const float* gp = gvec + (size_t)modrow_of_panel(u.pm) * 18432 + col0;
        const f32x4 g00 = *(const f32x4*)(gp) * coef, g01 = *(const f32x4*)(gp + 16) * coef, g10 = *(const f32x4*)(gp + HALF) * coef, g11 = *(const f32x4*)(gp + HALF + 16) * coef;
        const float* lp = (const float*)((const char*)X + ((long)WS_LNT - (long)WS_X)) + lnid * 4096 + col0;
        const f32x4 ga00 = *(const f32x4*)(lp) * alpha, ga01 = *(const f32x4*)(lp + 16) * alpha, ga10 = *(const f32x4*)(lp + HALF) * alpha, ga11 = *(const f32x4*)(lp + HALF + 16) * alpha;
        const f32x4 be00 = *(const f32x4*)(lp + 2048) * alpha, be01 = *(const f32x4*)(lp + 2048 + 16) * alpha, be10 = *(const f32x4*)(lp + 2048 + HALF) * alpha, be11 = *(const f32x4*)(lp + 2048 + HALF + 16) * alpha;
        const float* st = (const float*)((const char*)X + ((long)WS_STATS - (long)WS_X)) + 2 * row0;
        const long dlt = xin ? (long)((const char*)(xin + ((size_t)(u.pm / 17) * SEQ + (size_t)(u.pm % 17 - 1) * BM) * D) - (const char*)(X + (size_t)u.pm * BM * D)) : 0l;
#pragma unroll
        for (int ai = 0; ai < 2; ++ai)
#pragma unroll
            for (int m2 = 0; m2 < 4; m2 += 2) {
                float* rp0 = X + (size_t)(row0 + ai * HALF + m2 * 16) * D + col0; float* rp1 = rp0 + (size_t)16 * D;
                const f32x4 xa0 = *(const f32x4*)((const char*)rp0 + dlt), xa1 = *(const f32x4*)((const char*)(rp0 + 16) + dlt), xa2 = *(const f32x4*)((const char*)(rp0 + HALF) + dlt), xa3 = *(const f32x4*)((const char*)(rp0 + HALF + 16) + dlt);
                const f32x4 xb0 = *(const f32x4*)((const char*)rp1 + dlt), xb1 = *(const f32x4*)((const char*)(rp1 + 16) + dlt), xb2 = *(const f32x4*)((const char*)(rp1 + HALF) + dlt), xb3 = *(const f32x4*)((const char*)(rp1 + HALF + 16) + dlt);
                { const int m = m2; const float mu = st[2 * (ai * HALF + m * 16)], rs = st[2 * (ai * HALF + m * 16) + 1]; const float nm = -mu * rs;
                  *(f32x4*)(rp0) = (xa0 * rs + nm) * ga00 + be00 + g00 * acc[ai][0][m][0]; *(f32x4*)(rp0 + 16) = (xa1 * rs + nm) * ga01 + be01 + g01 * acc[ai][0][m][1];
                  *(f32x4*)(rp0 + HALF) = (xa2 * rs + nm) * ga10 + be10 + g10 * acc[ai][1][m][0]; *(f32x4*)(rp0 + HALF + 16) = (xa3 * rs + nm) * ga11 + be11 + g11 * acc[ai][1][m][1]; }
                { const int m = m2 + 1; const float mu = st[2 * (ai * HALF + m * 16)], rs = st[2 * (ai * HALF + m * 16) + 1]; const float nm = -mu * rs;
                  *(f32x4*)(rp1) = (xb0 * rs + nm) * ga00 + be00 + g00 * acc[ai][0][m][0]; *(f32x4*)(rp1 + 16) = (xb1 * rs + nm) * ga01 + be01 + g01 * acc[ai][0][m][1];
                  *(f32x4*)(rp1 + HALF) = (xb2 * rs + nm) * ga10 + be10 + g10 * acc[ai][1][m][0]; *(f32x4*)(rp1 + HALF + 16) = (xb3 * rs + nm) * ga11 + be11 + g11 * acc[ai][1][m][1]; }
                asm volatile("" ::: "memory"); }
    }
    __device__ __forceinline__ void operator()(const Acc& acc, const Unit& u, int wr, int wc, int fr, int fq) const { if (u.ks >= 0) partial(acc, u, wr, wc, fr, fq); else whole(acc, u, wr, wc, fr, fq); }
};
struct EpiGate {
    static constexpr bool PERM = true, HOOK = false;
    bf16_t* O; const float* bias; int ldc;
    __device__ __forceinline__ void operator()(const Acc& acc, const Unit& u, int wr, int wc, int fr, int fq) const {
        const int row0 = u.pm * BM + wr * 64 + fr, col0 = u.pn * BM + wc * 32 + 8 * fq;
        f32x4 bv[2][2];
#pragma unroll
        for (int bj = 0; bj < 2; ++bj)
#pragma unroll
            for (int n = 0; n < 2; ++n) bv[bj][n] = *(const f32x4*)(bias + col0 + bj * HALF + 4 * n);
#pragma unroll
        for (int ai = 0; ai < 2; ++ai)
#pragma unroll
            for (int m = 0; m < 4; ++m) { bf16_t* rowp = O + (size_t)(row0 + ai * HALF + m * 16) * ldc + col0;
#pragma unroll
                for (int bj = 0; bj < 2; ++bj) { f32x4 v0 = acc[ai][bj][m][0] + bv[bj][0], v1 = acc[ai][bj][m][1] + bv[bj][1];
#pragma unroll
                    for (int j = 0; j < 4; ++j) { v0[j] = __builtin_amdgcn_rcpf(1.0f + __expf(-v0[j])); v1[j] = __builtin_amdgcn_rcpf(1.0f + __expf(-v1[j])); }
                    u32x4 w; w.x = cvt_pk_bf16(v0[0], v0[1]); w.y = cvt_pk_bf16(v0[2], v0[3]); w.z = cvt_pk_bf16(v1[0], v1[1]); w.w = cvt_pk_bf16(v1[2], v1[3]);
                    *(u32x4*)(rowp + bj * HALF) = w; } }
    }
};
template <int MODE> struct EpiMerge {
    static constexpr bool PERM = true, HOOK = false;
    const bf16_t* G; float* Yf; bf16_t* Yb; float gs;
    __device__ __forceinline__ void operator()(const Acc& acc, const Unit& u, int wr, int wc, int fr, int fq) const {
        const int row0 = u.pm * BM + wr * 64 + fr, col0 = u.pn * BM + wc * 32 + 8 * fq;
#pragma unroll
        for (int ai = 0; ai < 2; ++ai)
#pragma unroll
            for (int m = 0; m < 4; ++m) { const size_t r = (size_t)(row0 + ai * HALF + m * 16);
#pragma unroll
                for (int bj = 0; bj < 2; ++bj) { const int c = col0 + bj * HALF;
#ifdef DBG_GHALF
                    const u32x4 gw = (u32x4){0x3f003f00u, 0x3f003f00u, 0x3f003f00u, 0x3f003f00u};
#else
                    const u32x4 gw = *(const u32x4*)(G + r * GATE_IN + c);
#endif
                    f32x4 v0 = acc[ai][bj][m][0], v1 = acc[ai][bj][m][1];
                    v0[0] *= bf_lo(gw.x); v0[1] *= bf_hi(gw.x); v0[2] *= bf_lo(gw.y); v0[3] *= bf_hi(gw.y);
                    v1[0] *= bf_lo(gw.z); v1[1] *= bf_hi(gw.z); v1[2] *= bf_lo(gw.w); v1[3] *= bf_hi(gw.w); v0 *= gs; v1 *= gs;
                    float* yp = Yf + r * D + c;
                    if (MODE >= 1) { v0 += *(const f32x4*)yp; v1 += *(const f32x4*)(yp + 4); }
                    if (MODE <= 1) { *(f32x4*)yp = v0; *(f32x4*)(yp + 4) = v1; }
                    else { u32x4 w; w.x = cvt_pk_bf16(v0[0], v0[1]); w.y = cvt_pk_bf16(v0[2], v0[3]); w.z = cvt_pk_bf16(v1[0], v1[1]); w.w = cvt_pk_bf16(v1[2], v1[3]);
                        *(u32x4*)(Yb + r * D + c) = w; } }
                asm volatile("" ::: "memory"); }
    }
};
struct EpiMergeOne {
    static constexpr bool PERM = true, HOOK = true;
    const bf16_t* G; bf16_t* Yb; int t1, t2; LAS unsigned* flag;
    __device__ __forceinline__ void mid(Acc& acc, const Unit& u, int seg, int wr, int wc, int fr, int fq) const {
        const int row0 = u.pm * BM + wr * 64 + fr, col0 = u.pn * BM + wc * 32 + 8 * fq;
        const bf16_t* gp = G + (size_t)row0 * GATE_IN + seg * 2048 + col0;
#pragma unroll
        for (int ai = 0; ai < 2; ++ai)
#pragma unroll
            for (int m = 0; m < 4; ++m) { const bf16_t* rp = gp + (size_t)(ai * HALF + m * 16) * GATE_IN;
                const u32x4 a0 = *(const u32x4*)(rp), b0 = *(const u32x4*)(rp + 2048), a1 = *(const u32x4*)(rp + HALF), b1 = *(const u32x4*)(rp + 2048 + HALF);
                float ga[8], gb[8];
                unpack8(a0, ga); unpack8(b0, gb);
#pragma unroll
                for (int j = 0; j < 4; ++j) { acc[ai][0][m][0][j] *= ga[j] * __builtin_amdgcn_rcpf(gb[j]); acc[ai][0][m][1][j] *= ga[4 + j] * __builtin_amdgcn_rcpf(gb[4 + j]); }
                unpack8(a1, ga); unpack8(b1, gb);
#pragma unroll
                for (int j = 0; j < 4; ++j) { acc[ai][1][m][0][j] *= ga[j] * __builtin_amdgcn_rcpf(gb[j]); acc[ai][1][m][1][j] *= ga[4 + j] * __builtin_amdgcn_rcpf(gb[4 + j]); }
                asm volatile("" ::: "memory"); }
    }
    __device__ __forceinline__ void partial(const Acc& acc, const Unit& u, int wr, int wc, int fr, int fq) const {
        asm volatile("; K-split gated partial tile" ::: "memory");
        const int seg = (u.ks + 1) >> 1, bt = u.pm / 17;
        const int row0 = u.pm * BM + wr * 64 + fr, col0 = u.pn * BM + wc * 32 + 8 * fq;
        float* P = (float*)((char*)Yb + (R_PART - R_Y2B));
        { float* pb = P + ((size_t)u.ks * 1024 + bt * 256 + wr * 64 + fr) * D + col0;
#pragma unroll
        for (int ai = 0; ai < 2; ++ai)
#pragma unroll
            for (int m = 0; m < 4; ++m) { const size_t r = (size_t)(row0 + ai * HALF + m * 16);
#pragma unroll
                for (int bj = 0; bj < 2; ++bj) { const int c = col0 + bj * HALF; float g[8]; unpack8(*(const u32x4*)(G + r * GATE_IN + seg * 2048 + c), g);
                    const f32x4 v0 = acc[ai][bj][m][0], v1 = acc[ai][bj][m][1];
                    float* q = pb + (size_t)(ai * HALF + m * 16) * D + bj * HALF;
                    *(f32x4*)q = (f32x4){v0[0] * g[0], v0[1] * g[1], v0[2] * g[2], v0[3] * g[3]}; *(f32x4*)(q + 4) = (f32x4){v1[0] * g[4], v1[1] * g[5], v1[2] * g[6], v1[3] * g[7]}; }
                asm volatile("" ::: "memory"); } }
        asm volatile("s_waitcnt vmcnt(0)" ::: "memory");
        __builtin_amdgcn_s_barrier();
        const int tid = ((wr * 4 + wc) << 6) + (fq << 4) + fr;
        if (tid == 0) { unsigned* cnt = (unsigned*)((char*)Yb - (WS_R + R_Y2B - WS_CTL)) + 4096 + 16 * (bt + 4 * u.pn);
            __builtin_amdgcn_fence(__ATOMIC_RELEASE, "agent");
            const unsigned old = __hip_atomic_fetch_add(cnt, 1u, __ATOMIC_RELAXED, __HIP_MEMORY_SCOPE_AGENT);
            if (old == 3u) __builtin_amdgcn_fence(__ATOMIC_ACQUIRE, "agent");
            *(volatile LAS unsigned*)flag = old; asm volatile("s_waitcnt lgkmcnt(0)" ::: "memory"); }
        __builtin_amdgcn_s_barrier();
        if (*(volatile LAS unsigned*)flag == 3u) {
            const float* src = P + ((size_t)bt * 256 + (tid >> 5)) * D + u.pn * BM + (tid & 31) * 8;
            bf16_t* dst = Yb + ((size_t)u.pm * BM + (tid >> 5)) * D + u.pn * BM + (tid & 31) * 8;
#pragma unroll 4
            for (int it = 0; it < 16; ++it) { const float* sp = src + (size_t)it * 16 * D;
                f32x4 s0 = *(const f32x4*)sp, s1 = *(const f32x4*)(sp + 4);
#pragma unroll
                for (int k = 1; k < 4; ++k) { s0 += *(const f32x4*)(sp + (size_t)k * 1024 * D); s1 += *(const f32x4*)(sp + (size_t)k * 1024 * D + 4); }
                u32x4 w; w.x = cvt_pk_bf16(s0[0], s0[1]); w.y = cvt_pk_bf16(s0[2], s0[3]); w.z = cvt_pk_bf16(s1[0], s1[1]); w.w = cvt_pk_bf16(s1[2], s1[3]);
                *(u32x4*)(dst + (size_t)it * 16 * D) = w; }
        }
    }
    __device__ __forceinline__ void operator()(const Acc& acc, const Unit& u, int wr, int wc, int fr, int fq) const {
        if (u.ks >= 0) { partial(acc, u, wr, wc, fr, fq); return; }
        const int row0 = u.pm * BM + wr * 64 + fr, col0 = u.pn * BM + wc * 32 + 8 * fq;
#pragma unroll
        for (int ai = 0; ai < 2; ++ai)
#pragma unroll
            for (int m = 0; m < 4; ++m) { const size_t r = (size_t)(row0 + ai * HALF + m * 16);
#pragma unroll
                for (int bj = 0; bj < 2; ++bj) { const int c = col0 + bj * HALF; float g[8]; unpack8(*(const u32x4*)(G + r * GATE_IN + 4096 + c), g);
                    const f32x4 v0 = acc[ai][bj][m][0], v1 = acc[ai][bj][m][1];
                    u32x4 w; w.x = cvt_pk_bf16(v0[0] * g[0], v0[1] * g[1]); w.y = cvt_pk_bf16(v0[2] * g[2], v0[3] * g[3]); w.z = cvt_pk_bf16(v1[0] * g[4], v1[1] * g[5]); w.w = cvt_pk_bf16(v1[2] * g[6], v1[3] * g[7]);
                    *(u32x4*)(Yb + r * D + c) = w; }
                asm volatile("" ::: "memory"); }
    }
};
}
namespace att {
constexpr int NW = 8, QBLK = 32, KVBLK = 64;
constexpr float SCALE = 0.072168783648703216f;
constexpr float THR = 8.f;
constexpr int SDEPTH = 1;
constexpr int LDQ = 3072, LDK = 2048, LDR = 64, LDV = 2048, LDO = 4096;
constexpr int NQREG = 6;
constexpr int SHM_V = KVBLK * VD * 2, SHM_K = KVBLK * QKD * 2, SHM_QS = 2 * SHM_V + 2 * SHM_K + NW * 64 * 4, SHM_ATTN = SHM_QS + (12 - NQREG) * 8192;
#define KSWZ(row, colB) ((row) * 384 + ((colB) ^ ((((row) >> 1) & 7) << 4)))
#define SBAR() __builtin_amdgcn_sched_barrier(0)
__device__ __forceinline__ int crow(int r, int hi) { return (r & 3) + 8 * (r >> 2) + 4 * hi; }

__device__ __forceinline__ void partialSM(f32x16& p0, f32x16& p1, float& m_reg, float& mn, float& alpha) {
  constexpr float C = SCALE * 1.4426950408889634f;
  float pmax = p0[0];
#pragma unroll
  for (int r = 1; r < 16; ++r) pmax = fmaxf(pmax, p0[r]);
#pragma unroll
  for (int r = 0; r < 16; ++r) pmax = fmaxf(pmax, p1[r]);
  { auto rr = __builtin_amdgcn_permlane32_swap(__float_as_uint(pmax), __float_as_uint(pmax), false, false);
    pmax = fmaxf(__uint_as_float(rr[0]), __uint_as_float(rr[1])); }
  if (__builtin_expect(__all(pmax - m_reg <= THR / SCALE), 1)) { mn = m_reg; alpha = 1.f; }
  else { mn = fmaxf(m_reg, pmax); alpha = __builtin_amdgcn_exp2f((m_reg - mn) * C); m_reg = mn; }
  float mnC = -mn * C;
#pragma unroll
  for (int r = 0; r < 16; ++r) p0[r] = fmaf(p0[r], C, mnC);
#pragma unroll
  for (int r = 0; r < 16; ++r) p1[r] = fmaf(p1[r], C, mnC);
#pragma unroll
  for (int r = 0; r < 16; ++r) p0[r] = __builtin_amdgcn_exp2f(p0[r]);
}
__device__ __forceinline__ void finishSM(f32x16& p0, f32x16& p1, float alpha, float& l_reg, bf16x8& pa0, bf16x8& pa1, bf16x8& pa2, bf16x8& pa3) {
#pragma unroll
  for (int r = 0; r < 16; ++r) p1[r] = __builtin_amdgcn_exp2f(p1[r]);
  float ps = 0;
#pragma unroll
  for (int r = 0; r < 16; ++r) ps += p0[r];
#pragma unroll
  for (int r = 0; r < 16; ++r) ps += p1[r];
  { auto rr = __builtin_amdgcn_permlane32_swap(__float_as_uint(ps), __float_as_uint(ps), false, false);
    ps = __uint_as_float(rr[0]) + __uint_as_float(rr[1]); }
  l_reg = l_reg * alpha + ps;
#define PK4(P, BASE, OUT) do { unsigned a0 = cvt_pk_bf16(P[BASE + 0], P[BASE + 1]), a1 = cvt_pk_bf16(P[BASE + 2], P[BASE + 3]);   \
    unsigned b0 = cvt_pk_bf16(P[BASE + 4], P[BASE + 5]), b1 = cvt_pk_bf16(P[BASE + 6], P[BASE + 7]);                              \
    auto r0 = __builtin_amdgcn_permlane32_swap(a0, b0, false, false); auto r1 = __builtin_amdgcn_permlane32_swap(a1, b1, false, false); \
    u32x4 w = {r0[0], r1[0], r0[1], r1[1]}; OUT = *reinterpret_cast<bf16x8*>(&w); } while (0)
  PK4(p0, 0, pa0); PK4(p0, 8, pa1); PK4(p1, 0, pa2); PK4(p1, 8, pa3);
#undef PK4
}
__device__ __forceinline__ void qkt(f32x16& p0, f32x16& p1, const char* Ks, const bf16x8* qr, const char* qsp, int r32, int hi) {
  p0 = f32x16{}; p1 = f32x16{};
#pragma unroll
  for (int d0 = 0; d0 < 12; ++d0) { const int cb = (d0 * 16 + hi * 8) * 2;
    bf16x8 b0 = *reinterpret_cast<const bf16x8*>(Ks + KSWZ(r32, cb));
    bf16x8 b1 = *reinterpret_cast<const bf16x8*>(Ks + KSWZ(32 + r32, cb));
    bf16x8 qv; if (d0 < NQREG) qv = qr[d0]; else qv = *reinterpret_cast<const bf16x8*>(qsp + (d0 - NQREG) * 8192);
    p0 = MFMA32(b0, qv, p0);
    p1 = MFMA32(b1, qv, p1);
    if (d0 == 5) SBAR(); }
}
__device__ __forceinline__ int v_st(int k, int c) { const int kk = (k & ~0xC) | ((k & 4) << 1) | ((k & 8) >> 1); return ((kk >> 3) * 4 + (c >> 5)) * 512 + ((kk & 7) * 32 + (c & 31)) * 2; }
__device__ __forceinline__ int v_rd_base(int lane) { return ((lane & 3) << 3) | (((lane >> 2) & 3) << 6) | (((lane >> 4) & 1) << 5) | (((lane >> 5) & 1) << 8); }
constexpr int v_rd_off(int d0, int ks, int half) { return d0 * 512 + ks * 4096 + half * 2048; }
template <int OFF> __device__ __forceinline__ s16x4 tr_read(int vb) {
  s16x4 r; asm volatile("ds_read_b64_tr_b16 %0, %1 offset:%2" : "=&v"(r) : "v"(vb), "i"(OFF) : "memory"); return r;
}
template <int D0> __device__ __forceinline__ void pv_one(f32x16& od, int vb, bf16x8 pa0, bf16x8 pa1, bf16x8 pa2, bf16x8 pa3) {
  const s16x4 l0 = tr_read<v_rd_off(D0, 0, 0)>(vb), h0 = tr_read<v_rd_off(D0, 0, 1)>(vb), l1 = tr_read<v_rd_off(D0, 1, 0)>(vb), h1 = tr_read<v_rd_off(D0, 1, 1)>(vb);
  const s16x4 l2 = tr_read<v_rd_off(D0, 2, 0)>(vb), h2 = tr_read<v_rd_off(D0, 2, 1)>(vb), l3 = tr_read<v_rd_off(D0, 3, 0)>(vb), h3 = tr_read<v_rd_off(D0, 3, 1)>(vb);
  asm volatile("s_waitcnt lgkmcnt(0)" ::: "memory"); SBAR();
#define PK(L, H) (bf16x8){L[0], L[1], L[2], L[3], H[0], H[1], H[2], H[3]}
  od = MFMA32(pa0, PK(l0, h0), od);
  od = MFMA32(pa1, PK(l1, h1), od);
  od = MFMA32(pa2, PK(l2, h2), od);
  od = MFMA32(pa3, PK(l3, h3), od);
#undef PK
}
__device__ __forceinline__ void pv_d0(f32x16* o, int vb, bf16x8 pa0, bf16x8 pa1, bf16x8 pa2, bf16x8 pa3) {
  pv_one<0>(o[0], vb, pa0, pa1, pa2, pa3); pv_one<1>(o[1], vb, pa0, pa1, pa2, pa3); pv_one<2>(o[2], vb, pa0, pa1, pa2, pa3); pv_one<3>(o[3], vb, pa0, pa1, pa2, pa3);
}
__device__ __forceinline__ void attn_body(const bf16_t* __restrict__ Qb, const bf16_t* __restrict__ Kh, const bf16_t* __restrict__ Rh, const bf16_t* __restrict__ Vh, bf16_t* __restrict__ Ob, int seq, const float* __restrict__ rope  , char* lds) {
  int tid_ = threadIdx.x; asm volatile("" : "+v"(tid_));
  const int tid = tid_, wid = tid >> 6, lane = tid & 63, r32 = lane & 31, hi = lane >> 5;
  char* V_lds = lds; char* K_lds = lds + 2 * SHM_V;
  float* ws = (float*)(lds + 2 * SHM_V + 2 * SHM_K) + wid * 64; float* li_l = ws; float* al_l = ws + 32;
  float m_reg = -1e30f, l_reg = 0; f32x16 o[4] = {}; bf16x8 qr[NQREG];
  const bf16_t* Qw = Qb + (long)(wid * QBLK + r32) * LDQ + hi * 8;
  char* qsp = lds + SHM_QS + tid * 16;
#pragma unroll
  for (int d0 = 0; d0 < 12; ++d0) { bf16x8 qv = *reinterpret_cast<const bf16x8*>(Qw + d0 * 16);
    if (d0 >= 8 && rope) {
      const f32x4* cs = reinterpret_cast<const f32x4*>(rope + ((long)(wid * QBLK + r32) * 32 + (d0 - 8) * 8 + hi * 4) * 2); const f32x4 c0 = cs[0], c1 = cs[1];
      const u32x4 w = *reinterpret_cast<const u32x4*>(&qv);
      const float x0 = bf_lo(w.x), x1 = bf_hi(w.x), x2 = bf_lo(w.y), x3 = bf_hi(w.y), x4 = bf_lo(w.z), x5 = bf_hi(w.z), x6 = bf_lo(w.w), x7 = bf_hi(w.w);
      u32x4 o; o.x = cvt_pk_bf16(x0 * c0[0] - x1 * c0[1], x0 * c0[1] + x1 * c0[0]); o.y = cvt_pk_bf16(x2 * c0[2] - x3 * c0[3], x2 * c0[3] + x3 * c0[2]);
      o.z = cvt_pk_bf16(x4 * c1[0] - x5 * c1[1], x4 * c1[1] + x5 * c1[0]); o.w = cvt_pk_bf16(x6 * c1[2] - x7 * c1[3], x6 * c1[3] + x7 * c1[2]);
      qv = *reinterpret_cast<const bf16x8*>(&o); }
    if (d0 < NQREG) qr[d0] = qv; else *reinterpret_cast<bf16x8*>(qsp + (d0 - NQREG) * 8192) = qv; }
  const int sr = tid >> 4, sc = (tid & 15) * 8, vst0 = v_st(sr, sc);
  const int krow = tid >> 3, kc = tid & 7, kst = krow * 384 + ((kc * 16) ^ (((krow >> 1) & 7) << 4));
  const bf16_t* Vg = Vh + (long)sr * LDV + sc; const bf16_t* Kg = Kh + (long)krow * LDK + kc * 8; const bf16_t* Rg = Rh + (long)krow * LDR + kc * 8;
  const int vb0 = (int)(uintptr_t)V_lds + v_rd_base(lane);
  struct { bf16x8 vs0, vs1, ks0, ks1, ks2; } sr_[SDEPTH];
#define SLOAD(i, k0) do { sr_[i].vs0 = *reinterpret_cast<const bf16x8*>(Vg + (long)(k0) * LDV); sr_[i].vs1 = *reinterpret_cast<const bf16x8*>(Vg + (long)((k0) + 32) * LDV); \
    sr_[i].ks0 = *reinterpret_cast<const bf16x8*>(Kg + (long)(k0) * LDK); sr_[i].ks1 = *reinterpret_cast<const bf16x8*>(Kg + (long)(k0) * LDK + 64); \
    sr_[i].ks2 = *reinterpret_cast<const bf16x8*>(Rg + (long)(k0) * LDR); } while (0)
#define SWRITE(b, i) do { *(bf16x8*)(V_lds + (b) * SHM_V + vst0) = sr_[i].vs0; *(bf16x8*)(V_lds + (b) * SHM_V + vst0 + 8192) = sr_[i].vs1; \
    *(bf16x8*)(K_lds + (b) * SHM_K + kst) = sr_[i].ks0; *(bf16x8*)(K_lds + (b) * SHM_K + kst + 128) = sr_[i].ks1; *(bf16x8*)(K_lds + (b) * SHM_K + kst + 256) = sr_[i].ks2; } while (0)
#define SWAIT() do { if constexpr (SDEPTH == 2) asm volatile("s_waitcnt vmcnt(5)" ::: "memory"); else asm volatile("s_waitcnt vmcnt(0)" ::: "memory"); } while (0)
#define RESC(a) do { if (__any((a) < 1.f)) { if (hi == 0) al_l[r32] = (a); asm volatile("s_waitcnt lgkmcnt(0)" ::: "memory"); \
    _Pragma("unroll") for (int d = 0; d < 4; ++d) _Pragma("unroll") for (int r = 0; r < 16; ++r) o[d][r] *= al_l[crow(r, hi)]; } } while (0)
  f32x16 pA0, pA1, pB0, pB1; float mnA, mnB, alA, alB; bf16x8 pa0, pa1, pa2, pa3; const int NT = seq / KVBLK;
  constexpr int SE = 0, SO = SDEPTH - 1;
  SLOAD(SE, 0); asm volatile("s_waitcnt vmcnt(0)" ::: "memory"); SWRITE(0, SE); __syncthreads();
  qkt(pA0, pA1, K_lds, qr, qsp, r32, hi); partialSM(pA0, pA1, m_reg, mnA, alA);
  SLOAD(SO, KVBLK); if constexpr (SDEPTH == 2) { if (2 < NT) SLOAD(SE, 2 * KVBLK); }
  SWAIT(); SWRITE(1, SO); __syncthreads();
  for (int j = 1; j + 1 < NT; j += 2) {
    SBAR(); qkt(pB0, pB1, K_lds + SHM_K, qr, qsp, r32, hi);
    finishSM(pA0, pA1, alA, l_reg, pa0, pa1, pa2, pa3); SBAR();
    SLOAD(SO, (j + SDEPTH) * KVBLK); SBAR();
    pv_d0(o, vb0, pa0, pa1, pa2, pa3); partialSM(pB0, pB1, m_reg, mnB, alB);
    __syncthreads(); SWAIT(); SWRITE(0, SE);
    RESC(alB); __syncthreads();
    SBAR(); qkt(pA0, pA1, K_lds, qr, qsp, r32, hi);
    finishSM(pB0, pB1, alB, l_reg, pa0, pa1, pa2, pa3); SBAR();
    if (SDEPTH == 1 || j + 3 < NT) SLOAD(SE, (j + 1 + SDEPTH) * KVBLK); SBAR();
    pv_d0(o, vb0 + (int)SHM_V, pa0, pa1, pa2, pa3); partialSM(pA0, pA1, m_reg, mnA, alA);
    __syncthreads(); SWAIT(); SWRITE(1, SO);
    RESC(alA); __syncthreads();
  }
  SBAR(); qkt(pB0, pB1, K_lds + SHM_K, qr, qsp, r32, hi);
  finishSM(pA0, pA1, alA, l_reg, pa0, pa1, pa2, pa3); SBAR();
  pv_d0(o, vb0, pa0, pa1, pa2, pa3); partialSM(pB0, pB1, m_reg, mnB, alB);
  __syncthreads(); RESC(alB);
  finishSM(pB0, pB1, alB, l_reg, pa0, pa1, pa2, pa3); SBAR();
  pv_d0(o, vb0 + (int)SHM_V, pa0, pa1, pa2, pa3);
  if (hi == 0) li_l[r32] = l_reg; asm volatile("s_waitcnt lgkmcnt(0)" ::: "memory");
  float rli[16];
#pragma unroll
  for (int r = 0; r < 16; ++r) rli[r] = __builtin_amdgcn_rcpf(li_l[crow(r, hi)]);
  bf16_t* Ow = Ob + (long)(wid * QBLK) * LDO;
#pragma unroll
  for (int r = 0; r < 16; ++r) { const int orow = crow(r, hi);
#pragma unroll
    for (int d0 = 0; d0 < 4; ++d0) Ow[(long)orow * LDO + d0 * 32 + r32] = f2bf(o[d0][r] * rli[r]); }
#undef SLOAD
#undef SWRITE
#undef SWAIT
#undef RESC
}
}
#define RLX_AGENT __ATOMIC_RELAXED, __HIP_MEMORY_SCOPE_AGENT
#define LDS_WAIT() asm volatile("s_waitcnt lgkmcnt(0)" ::: "memory")
#define VM_WAIT() asm volatile("s_waitcnt vmcnt(0)" ::: "memory")

#define XB_TMO      128
#define XB_XCNT(j)  (256  + 64 * (j))
#define XB_XSUB(j)  (1280 + 64 * (j))
#define XB_XGEN(j)  (2304 + 64 * (j))
#define XB_TOP      3328
#define XB_TOPGEN   3392
#define XCD_BAR_WORDS 3456
#define XB_SPIN_CAP (1u << 22)
__device__ __forceinline__ unsigned xb_ld(unsigned* p)              { return __hip_atomic_load(p, __ATOMIC_RELAXED, __HIP_MEMORY_SCOPE_AGENT); }
__device__ __forceinline__ unsigned xb_add(unsigned* p, unsigned v) { return __hip_atomic_fetch_add(p, v, __ATOMIC_RELAXED, __HIP_MEMORY_SCOPE_AGENT); }
__device__ __forceinline__ unsigned xb_xcc_id() { return (unsigned)__builtin_amdgcn_s_getreg((3 << 11) | 20) & 0xFu; }
#define XB_SPIN(cond, bar) do { unsigned _sp = 0; while (cond) { __builtin_amdgcn_s_sleep(1); \
    if ((++_sp & 255u) == 0u) { if (xb_ld(&(bar)[XB_TMO])) break; if (_sp > XB_SPIN_CAP) { atomicAdd(&(bar)[XB_TMO], 1u); break; } } } } while (0)
struct XcdBarrier { unsigned* bar; unsigned x; volatile LAS unsigned* st; };
__device__ __forceinline__ XcdBarrier xcd_barrier_post(unsigned* bar, volatile LAS unsigned* st) {
    XcdBarrier b; b.bar = bar; b.x = xb_xcc_id(); b.st = st;
    if (threadIdx.x == 0) (void)xb_add(&bar[XB_XCNT(b.x)], 1u);
    return b;
}
__device__ __forceinline__ void xcd_barrier_complete(unsigned* bar, unsigned x, unsigned& nloc, unsigned& nx) {
    const unsigned G = gridDim.x * gridDim.y * gridDim.z;
    unsigned sum, cnt, mine, sp = 0u;
    for (;;) {
        sum = 0u; cnt = 0u; mine = 0u;
#pragma unroll
        for (unsigned j = 0; j < 16; ++j) { const unsigned c = xb_ld(&bar[XB_XCNT(j)]); sum += c; cnt += (c > 0u) ? 1u : 0u; mine = (j == x) ? c : mine; }
        if (sum == G) break;
        __builtin_amdgcn_s_sleep(1);
        if ((++sp & 255u) == 0u) { if (xb_ld(&bar[XB_TMO])) break; if (sp > XB_SPIN_CAP) { atomicAdd(&bar[XB_TMO], 1u); break; } }
    }
    nloc = mine > 0u ? mine : 1u; nx = cnt > 0u ? cnt : 1u;
}
__device__ __forceinline__ void xcd_barrier(const XcdBarrier& b) {
    asm volatile("s_waitcnt vmcnt(0)" ::: "memory");
    __syncthreads();
    if (threadIdx.x == 0) {
        unsigned* bar = b.bar;
        __builtin_amdgcn_s_waitcnt(0);
        unsigned nloc = b.st[0], nx = b.st[1];
        if (nloc == 0u) { xcd_barrier_complete(bar, b.x, nloc, nx); b.st[0] = nloc; b.st[1] = nx; }
        const unsigned old = xb_add(&bar[XB_XSUB(b.x)], 1u);
        const unsigned gen = old / nloc;
        if (old + 1u == (gen + 1u) * nloc) {
            __builtin_amdgcn_fence(__ATOMIC_RELEASE, "agent");
            asm volatile("s_waitcnt vmcnt(0)" ::: "memory");
            const unsigned og = xb_add(&bar[XB_TOP], 1u);
            const unsigned tg = og / nx;
            if (og + 1u == (tg + 1u) * nx) xb_add(&bar[XB_TOPGEN], 1u);
            else XB_SPIN(xb_ld(&bar[XB_TOPGEN]) == tg, bar);
            __builtin_amdgcn_fence(__ATOMIC_ACQUIRE, "agent");
            xb_add(&bar[XB_XGEN(b.x)], 1u);
            asm volatile("s_waitcnt vmcnt(0)" ::: "memory");
        } else {
            XB_SPIN(xb_ld(&bar[XB_XGEN(b.x)]) == gen, bar);
            __builtin_amdgcn_fence(__ATOMIC_ACQUIRE, "agent");
            asm volatile("s_waitcnt vmcnt(0)" ::: "memory");
        }
    }
    __syncthreads();
}

enum { I_X = 0, I_C, I_CTX, I_CCTX, I_ADAW, I_ADAB, I_LNG, I_LNB, I_WGATE, I_WUP, I_WDOWN, I_WIN, I_GATEB, I_MU, I_W0, I_WUPL, I_A0, I_AUP, I_GUP, I_KK, I_KA, I_RK, I_LNXG, I_LNXB,
       I_QNORM, I_KVNORM, I_WUQ, I_WUK, I_WUV, I_CONVW, I_CONVB, I_LRUWA, I_LRUBA, I_LRUWX, I_LRUBX, I_LAMBDA, I_PRWKV, I_PMLA, I_PLRU, I_WOUT };

struct Ctx {
    LAS unsigned char* lds; unsigned char* ws; const float* const __attribute__((address_space(4)))* in; float* out;
    int tid, lane, wave, G, vcu, gw, NGW;
};

constexpr int MODP_KC = 14;
__device__ __forceinline__ void ph_modp(Ctx& F) {
    LAS float* sl = (LAS float*)F.lds;
    for (int i = F.tid; i < 5 * 2048; i += 512) { const int r = i >> 11, k = i & 2047; const float v = r < 4 ? F.in[I_C][r * 2048 + k] : F.in[I_CCTX][k]; sl[i] = siluf_(v); }
    __syncthreads();
    float* modp = (float*)(F.ws + WS_R + R_MODP);
    const int NIT = MODP_KC * 9216;
    for (int it = blockIdx.x * 512 + F.tid; it < NIT; it += F.G * 512) {
        const int kc = it / 9216, c4 = it % 9216, cc = c4 * 4, l = cc / 18432, c = cc % 18432; const int k0 = kc * 2048 / MODP_KC, k1 = (kc + 1) * 2048 / MODP_KC;
        const float* w = F.in[I_ADAW] + ((size_t)l * 2048 + k0) * 18432 + c;
        f32x4 a0 = {0, 0, 0, 0}, a1 = a0, a2 = a0, a3 = a0, a4 = a0;
#pragma unroll 16
        for (int k = k0; k < k1; ++k) { const f32x4 wv = *(const f32x4*)(w + (size_t)(k - k0) * 18432);
            a0 += wv * sl[k]; a1 += wv * sl[2048 + k]; a2 += wv * sl[4096 + k]; a3 += wv * sl[6144 + k]; a4 += wv * sl[8192 + k]; }
        float* o = modp + (size_t)kc * 5 * 36864 + cc;
        *(f32x4*)(o) = a0; *(f32x4*)(o + 36864) = a1; *(f32x4*)(o + 2 * 36864) = a2; *(f32x4*)(o + 3 * 36864) = a3; *(f32x4*)(o + 4 * 36864) = a4;
    }
    __syncthreads();
}
__device__ __forceinline__ void ph_rope(Ctx& F) {
    float* rope = (float*)(F.ws + WS_ROPE);
    for (int i = blockIdx.x * 512 + F.tid; i < 4096 * 32; i += F.G * 512) { const int t = i >> 5, p = i & 31;
        const float inv = powf(10000.0f, -(float)(p & 15) / 16.0f); const float pos = (float)(p < 16 ? (t >> 6) : (t & 63)); const float ang = pos * inv;
        rope[2 * i] = cosf(ang); rope[2 * i + 1] = sinf(ang); }
}
__device__ __forceinline__ void ph_xasm(Ctx& F) {
    f32x4* X = (f32x4*)(F.ws + WS_X); float* LB = (float*)(F.ws + WS_LB);
    for (int i = blockIdx.x * 512 + F.tid; i < 2 * 4096; i += F.G * 512) { const int l = i >> 12, c = i & 4095; LB[i] = c < 2048 ? F.in[I_W0][l * 2048 + c] : F.in[I_A0][l * 2048 + c - 2048]; }
    { float* ST = (float*)(F.ws + WS_STATS); float* LT = (float*)(F.ws + WS_LNT);
      for (int i = blockIdx.x * 512 + F.tid; i < M; i += F.G * 512) { ST[2 * i] = 0.f; ST[2 * i + 1] = 1.f; }
      for (int i = blockIdx.x * 512 + F.tid; i < 7 * 4096; i += F.G * 512) { const int e = i >> 12, c = i & 4095;
          LT[i] = e == 0 ? (c < 2048 ? 1.f : 0.f) : (c < 2048 ? F.in[I_LNG][(e - 1) * 2048 + c] : F.in[I_LNB][(e - 1) * 2048 + c - 2048]); } }
}
struct CvtJob { const float* src; int sld, K, N, n0;  bf16_t* dst; int dld, kd0, rgrp, rstride, roff; };
__device__ __forceinline__ void cvt_item2(const CvtJob& J, int ia, int ib, LAS float* scr, int lane) {
    const int nblk = J.N / 32;
    float va[32], vb[32];
    { const int kb = ia / nblk, nb = ia % nblk, k0 = 64 * kb, n0 = 32 * nb;
#pragma unroll
      for (int i = 0; i < 32; ++i) { const int kk = 2 * i + (lane >> 5); va[i] = (k0 + kk < J.K) ? J.src[(size_t)(k0 + kk) * J.sld + J.n0 + n0 + (lane & 31)] : 0.f; } }
    if (ib >= 0) { const int kb = ib / nblk, nb = ib % nblk, k0 = 64 * kb, n0 = 32 * nb;
#pragma unroll
      for (int i = 0; i < 32; ++i) { const int kk = 2 * i + (lane >> 5); vb[i] = (k0 + kk < J.K) ? J.src[(size_t)(k0 + kk) * J.sld + J.n0 + n0 + (lane & 31)] : 0.f; } }
#pragma unroll
    for (int i = 0; i < 32; ++i) { const int kk = 2 * i + (lane >> 5); scr[kk * 33 + (lane & 31)] = va[i]; }
    if (ib >= 0) {
#pragma unroll
      for (int i = 0; i < 32; ++i) { const int kk = 2 * i + (lane >> 5); scr[64 * 33 + kk * 33 + (lane & 31)] = vb[i]; } }
    LDS_WAIT(); asm volatile("" ::: "memory");
    const int c = lane & 7;
#pragma unroll
    for (int h = 0; h < 2; ++h) { const int item = h ? ib : ia; if (item < 0) continue;
        const int kb = item / nblk, nb = item % nblk, k0 = 64 * kb, n0 = 32 * nb;
        if (k0 + 8 * c < J.K) {
#pragma unroll
        for (int j = 0; j < 4; ++j) { const int n = (lane >> 3) + 8 * j; const LAS float* s = scr + h * 64 * 33 + (8 * c) * 33 + n;
            u32x4 o; o.x = cvt_pk_bf16(s[0 * 33], s[1 * 33]); o.y = cvt_pk_bf16(s[2 * 33], s[3 * 33]); o.z = cvt_pk_bf16(s[4 * 33], s[5 * 33]); o.w = cvt_pk_bf16(s[6 * 33], s[7 * 33]);
            const int nn = n0 + n; const int row = (nn / J.rgrp) * J.rstride + nn % J.rgrp + J.roff;
            *(u32x4*)(J.dst + (size_t)row * J.dld + J.kd0 + k0 + 8 * c) = o; }
        } }
    LDS_WAIT(); asm volatile("" ::: "memory");
}
constexpr int NCVT = 20 + 32;
__device__ __forceinline__ CvtJob cvt_job(Ctx& F, int l, int j) {
    unsigned char* W = F.ws + WS_W; CvtJob J; const int BIG = 1 << 30;
    J.n0 = 0; J.kd0 = 0; J.rgrp = BIG; J.rstride = 0; J.roff = 0;
    switch (j) {
    case 0: case 1: case 2: case 3: { const int ff = j >> 1, up = j & 1;
        J.src = F.in[up ? I_WUP : I_WGATE] + ((size_t)l * 2 + ff) * 2048 * DFF; J.sld = DFF; J.K = 2048; J.N = DFF; J.dst = (bf16_t*)(W + (ff ? W_GU1 : W_GU0)); J.dld = 2048; J.rgrp = 128; J.rstride = 256; J.roff = up * 128; break; }
    case 4: case 5: { const int ff = j - 4; J.src = F.in[I_WDOWN] + ((size_t)l * 2 + ff) * DFF * 2048; J.sld = 2048; J.K = DFF; J.N = 2048; J.dst = (bf16_t*)(W + (ff ? W_D1 : W_D0)); J.dld = DFF; break; }
    case 6: J.src = F.in[I_WIN] + (size_t)l * 2048 * IN_COLS; J.sld = IN_COLS; J.K = 2048; J.N = FA; J.dst = (bf16_t*)(W + W_INA); J.dld = 2048; J.rgrp = OFF_GB; J.rstride = GB_ROW0; break;
    case 7: J.src = F.in[I_WIN] + (size_t)l * 2048 * IN_COLS; J.sld = IN_COLS; J.K = 2048; J.N = GATE_IN; J.n0 = FA; J.dst = (bf16_t*)(W + W_ING); J.dld = 2048; break;
    case 8: J.src = F.in[I_WUQ] + (size_t)l * 512 * 3072; J.sld = 3072; J.K = 512; J.N = 3072; J.dst = (bf16_t*)(W + W_UQ); J.dld = 512; break;
    case 9: J.src = F.in[I_WUK] + (size_t)l * 256 * 2048; J.sld = 2048; J.K = 256; J.N = 2048; J.dst = (bf16_t*)(W + W_UKV); J.dld = 256; break;
    case 10: J.src = F.in[I_WUV] + (size_t)l * 256 * 2048; J.sld = 2048; J.K = 256; J.N = 2048; J.dst = (bf16_t*)(W + W_UKV); J.dld = 256; J.roff = 2048; break;
    case 11: case 12: { const int d = j - 11; J.src = F.in[I_WUPL] + ((size_t)l * 2 + d) * 64 * 1024; J.sld = 1024; J.K = 64; J.N = 1024; J.dst = (bf16_t*)(W + W_LORA); J.dld = LORA_K; J.roff = d * 1024; break; }
    case 13: case 14: { const int d = j - 13; J.src = F.in[I_AUP] + ((size_t)l * 2 + d) * 64 * 1024; J.sld = 1024; J.K = 64; J.N = 1024; J.dst = (bf16_t*)(W + W_LORA); J.dld = LORA_K; J.roff = 2048 + d * 1024; J.kd0 = 64; break; }
    case 15: J.src = F.in[I_GUP] + (size_t)l * 160 * 1024; J.sld = 1024; J.K = 160; J.N = 1024; J.dst = (bf16_t*)(W + W_LORA); J.dld = LORA_K; J.roff = 4096; J.kd0 = 128; break;
    case 16: J.src = F.in[I_PRWKV] + (size_t)l * 1024 * 2048; J.sld = 2048; J.K = 1024; J.N = 2048; J.dst = (bf16_t*)(W + W_PROJ); J.dld = 4096; J.kd0 = 0; break;
    case 17: J.src = F.in[I_PMLA] + (size_t)l * 2048 * 2048; J.sld = 2048; J.K = 2048; J.N = 2048; J.dst = (bf16_t*)(W + W_PROJ); J.dld = 4096; J.kd0 = 1024; break;
    case 18: J.src = F.in[I_PLRU] + (size_t)l * 1024 * 2048; J.sld = 2048; J.K = 1024; J.N = 2048; J.dst = (bf16_t*)(W + W_PROJ); J.dld = 4096; J.kd0 = 3072; break;
    case 19: J.src = F.in[I_WOUT] + (size_t)l * 2048 * 2048; J.sld = 2048; J.K = 2048; J.N = 2048; J.dst = (bf16_t*)(W + W_OUT); J.dld = 2048; break;
    default: { const int q = j - 20, x = q >> 4, d = (q >> 3) & 1, nb = q & 7;
        J.src = F.in[x ? I_LRUWX : I_LRUWA] + (((size_t)l * 2 + d) * 8 + nb) * 128 * 128; J.sld = 128; J.K = 128; J.N = 128; J.dst = (bf16_t*)(W + W_LRU) + (size_t)nb * 512 * 256; J.dld = 256; J.roff = d * 256 + x * 128; J.kd0 = (nb & 1) * 128; break; }
    }
    return J;
}
__device__ __forceinline__ int cvt_items(const CvtJob& J) { return ((J.K + 63) / 64) * (J.N / 32); }
__device__ __forceinline__ void zero_rect(Ctx& F, bf16_t* dst, int ld, int row0, int nrows, int k0, int nk) {
    const int per = nk / 8; const long tot = (long)nrows * per;
    for (long i = (long)blockIdx.x * 512 + F.tid; i < tot; i += (long)F.G * 512) { const int r = (int)(i / per), c = (int)(i % per);
        *(u32x4*)(dst + (size_t)(row0 + r) * ld + k0 + c * 8) = zero4(); }
}
__device__ __forceinline__ void ph_cvt_m(Ctx& F, int l, unsigned long long mask, int me = -2, int nw = -1, bool zf = true) {
    LAS float* scr = (LAS float*)(F.lds + F.wave * 18176);
    if (nw < 0) nw = F.NGW;
    if (me == -2) me = F.gw;
    if (me >= 0 && me < nw) { int base = 0;
        for (int j = 0; j < NCVT; ++j) { if (!((mask >> j) & 1ull)) continue;
            const CvtJob J = cvt_job(F, l, j); const int ni = cvt_items(J);
            int first = (me - base % nw + nw) % nw;
            for (int it = first; it < ni; it += 2 * nw) cvt_item2(J, it, it + nw < ni ? it + nw : -1, scr, F.lane);
            base += ni; } }
    if (!zf) return;
    unsigned char* W = F.ws + WS_W;
    zero_rect(F, (bf16_t*)(W + W_INA), 2048, OFF_GB, GB_ROW0 - OFF_GB, 0, 2048);
    zero_rect(F, (bf16_t*)(W + W_LORA), LORA_K, 0, 2048, 64, LORA_K - 64);
    zero_rect(F, (bf16_t*)(W + W_LORA), LORA_K, 2048, 2048, 0, 64);
    zero_rect(F, (bf16_t*)(W + W_LORA), LORA_K, 2048, 2048, 128, LORA_K - 128);
    zero_rect(F, (bf16_t*)(W + W_LORA), LORA_K, 4096, 1024, 0, 128);
    zero_rect(F, (bf16_t*)(W + W_LORA), LORA_K, 4096, 1024, 288, LORA_K - 288);
    for (int nb = 0; nb < 8; ++nb) zero_rect(F, (bf16_t*)(W + W_LRU) + (size_t)nb * 512 * 256, 256, 0, 512, (1 - (nb & 1)) * 128, 128);
}
__device__ __forceinline__ void ph_cvt(Ctx& F, int l, int j0 = 0, int j1 = NCVT, int me = -2, int nw = -1, bool zf = true) { ph_cvt_m(F, l, ((1ull << j1) - 1ull) & ~((1ull << j0) - 1ull), me, nw, zf); }
constexpr unsigned long long CVT_ALL = (1ull << NCVT) - 1ull;
#ifndef CVT_SPLIT
#define CVT_SPLIT 1
#endif
constexpr unsigned long long CVT_FFN0 = (1ull << 0) | (1ull << 1) | (1ull << 4);
constexpr unsigned long long CVT_EARLY = CVT_ALL & ~((1ull << 2) | (1ull << 3) | (1ull << 5) | (0xFull << 16)) & ~(CVT_SPLIT ? CVT_FFN0 : 0ull);
constexpr unsigned long long CVT_MID = (1ull << 2) | (1ull << 3) | (CVT_SPLIT ? (1ull << 0) | (1ull << 1) : 0ull);
constexpr unsigned long long CVT_LATE = (1ull << 5) | (0xFull << 16) | (CVT_SPLIT ? (1ull << 4) : 0ull);
__device__ __forceinline__ void ph_modr(Ctx& F) {
    const float* modp = (const float*)(F.ws + WS_R + R_MODP); float* mod = (float*)(F.ws + WS_MOD);
    for (int i = blockIdx.x * 512 + F.tid; i < 5 * 36864; i += F.G * 512) { const int r = i / 36864, cc = i % 36864, l = cc / 18432, c = cc % 18432;
        float s = F.in[I_ADAB][cc];
#pragma unroll
        for (int kc = 0; kc < MODP_KC; ++kc) s += modp[(size_t)kc * 5 * 36864 + i];
        mod[((size_t)l * 5 + r) * 18432 + c] = s; }
}
__device__ __forceinline__ void ph_h0(Ctx& F) {
    bf16_t* H = (bf16_t*)(F.ws + WS_H); const float* mod = (const float*)(F.ws + WS_MOD);
    LAS float* ptab_ = (LAS float*)F.lds;
    { for (int i = F.tid; i < 5 * 512; i += 512) { const int mr_ = i >> 9, c_ = i & 511;
          ((LAS f32x4*)ptab_)[i] = ((const f32x4*)(mod + (size_t)mr_ * 18432 + 2048))[c_] + 1.0f; ((LAS f32x4*)ptab_)[2560 + i] = ((const f32x4*)(mod + (size_t)mr_ * 18432))[c_]; }
      __syncthreads(); }
    for (int n0 = F.gw; n0 < M; n0 += 3 * F.NGW) { f32x4 v[3][8];
#pragma unroll
        for (int u = 0; u < 3; ++u) { const int n = n0 + u * F.NGW < M ? n0 + u * F.NGW : n0; const int b_ = n / TPB, j_ = n % TPB;
            const float* src = j_ < CTX ? F.in[I_CTX] + ((size_t)b_ * CTX + j_) * D : F.in[I_X] + ((size_t)b_ * SEQ + (j_ - CTX)) * D;
#pragma unroll
            for (int j = 0; j < 8; ++j) v[u][j] = *(const f32x4*)(src + 4 * F.lane + 256 * j); }
#pragma unroll
        for (int u = 0; u < 3; ++u) { const int n = n0 + u * F.NGW; if (n >= M) break; const int mr = (n % TPB) < CTX ? 4 : n / TPB;
            int lo_ = 0; asm volatile("" : "+v"(lo_)); LAS const float* psc = ptab_ + lo_ + 4 * F.lane + mr * 2048; LAS const float* psh = psc + 5 * 2048;
#pragma unroll
            for (int j = 0; j < 8; ++j) { const int c = 4 * F.lane + 256 * j; const f32x4 y = v[u][j] * *(LAS const f32x4*)(psc + 256 * j) + *(LAS const f32x4*)(psh + 256 * j);
                u32x2 w; w.x = cvt_pk_bf16(y[0], y[1]); w.y = cvt_pk_bf16(y[2], y[3]); *(u32x2*)(H + (size_t)n * D + c) = w; } } }
}
#ifndef LN_NR
#define LN_NR 3
#endif
template <bool final_>
__device__ __forceinline__ void ph_ln_t(Ctx& F, const float* g, const float* b, const float* modl  , int sh_chunk, int sc_chunk, bool skip_ctx,
                                      const float* part, const float* pg, float pcoef, int previd) {
    float* X = (float*)(F.ws + WS_X); bf16_t* H = (bf16_t*)(F.ws + WS_H); float* ST = (float*)(F.ws + WS_STATS); const float* PL = (const float*)(F.ws + WS_LNT) + previd * 4096;
    LAS float* ptab_ = (LAS float*)F.lds;
    { for (int i = F.tid; i < 512; i += 512) { ((LAS f32x4*)ptab_)[i] = ((const f32x4*)g)[i]; ((LAS f32x4*)ptab_)[512 + i] = ((const f32x4*)b)[i]; }
      if (!final_) for (int i = F.tid; i < 5 * 512; i += 512) { const int mr_ = i >> 9, c_ = i & 511;
          ((LAS f32x4*)ptab_)[1024 + i] = ((const f32x4*)(modl + (size_t)mr_ * 18432 + sc_chunk * 2048))[c_] + 1.0f; ((LAS f32x4*)ptab_)[1024 + 2560 + i] = ((const f32x4*)(modl + (size_t)mr_ * 18432 + sh_chunk * 2048))[c_]; }
      __syncthreads(); }
    if (!final_ && part) {
        for (int n = F.gw; n < M; n += F.NGW) { const int bb = n / TPB, j0 = n % TPB; if (j0 >= CTX) continue;
            const float* pr = part + ((size_t)bb * 256 + j0) * D + 4 * F.lane; const float pmu = ST[2 * n], prs = ST[2 * n + 1]; const float pnm = -pmu * prs;
            const float* xs = previd == 0 ? F.in[I_CTX] + ((size_t)bb * CTX + j0) * D : X + (size_t)n * D;
#pragma unroll
            for (int j = 0; j < 8; ++j) { const int c = 4 * F.lane + 256 * j; f32x4 a = *(const f32x4*)(pr + 256 * j); const f32x4 x = *(const f32x4*)(xs + c);
#pragma unroll
                for (int sidx = 1; sidx < 4; ++sidx) a += *(const f32x4*)(pr + (size_t)sidx * 1024 * D + 256 * j);
                *(f32x4*)(X + (size_t)n * D + c) = ((x * prs + pnm) * *(const f32x4*)(PL + c) + *(const f32x4*)(PL + 2048 + c)) * ALPHA + a * (*(const f32x4*)(pg + 4 * 18432 + c) * pcoef); } }
        VM_WAIT(); }
    auto load2 = [&](f32x4 (&vv)[LN_NR][8], int n0) {
#pragma unroll
        for (int u = 0; u < LN_NR; ++u) { const int n = n0 + u * F.NGW; const int j0 = n % TPB; const bool on = n < M && !((final_ || skip_ctx) && j0 < CTX); const int nc = on ? n : n0 % M;
#pragma unroll
            for (int j = 0; j < 8; ++j) vv[u][j] = *(const f32x4*)(X + (size_t)nc * D + 4 * F.lane + 256 * j); } };
    auto proc2 = [&](f32x4 (&vv)[LN_NR][8], int n0) {
#pragma unroll
        for (int u = 0; u < LN_NR; ++u) { const int n = n0 + u * F.NGW; if (n >= M) continue; const int bb = n / TPB, j0 = n % TPB; if ((final_ || skip_ctx) && j0 < CTX) continue; const int mr = j0 < CTX ? 4 : bb;
        f32x4 (&v)[8] = vv[u]; float s = 0.f;
#pragma unroll
        for (int j = 0; j < 8; ++j) s += (v[j][0] + v[j][1]) + (v[j][2] + v[j][3]);
        const float mean = wave_sum(s) * (1.f / D); float s2 = 0.f;
#pragma unroll
        for (int j = 0; j < 8; ++j) { v[j] = v[j] - mean; s2 += (v[j][0] * v[j][0] + v[j][1] * v[j][1]) + (v[j][2] * v[j][2] + v[j][3] * v[j][3]); }
        const float rstd = __builtin_amdgcn_rsqf(wave_sum(s2) * (1.f / D) + LN_EPS);
        if (!final_ && F.lane == 0) { ST[2 * n] = mean; ST[2 * n + 1] = rstd; }
        int lo_ = 0; asm volatile("" : "+v"(lo_)); LAS const float* pt = ptab_ + lo_ + 4 * F.lane;
        LAS const float* psc = pt + 4096 + mr * 2048; LAS const float* psh = psc + 5 * 2048;
#pragma unroll
        for (int j = 0; j < 8; ++j) { const int c = 4 * F.lane + 256 * j; const f32x4 y = v[j] * rstd * *(LAS const f32x4*)(pt + 256 * j) + *(LAS const f32x4*)(pt + 2048 + 256 * j);
            if (final_) { *(f32x4*)(F.out + ((size_t)bb * SEQ + (j0 - CTX)) * D + c) = y; }
            else { const f32x4 h = y * *(LAS const f32x4*)(psc + 256 * j) + *(LAS const f32x4*)(psh + 256 * j);
                u32x2 w; w.x = cvt_pk_bf16(h[0], h[1]); w.y = cvt_pk_bf16(h[2], h[3]); *(u32x2*)(H + (size_t)n * D + c) = w; } } } };
    const int step = LN_NR * F.NGW; int n0 = F.gw;
    if (n0 < M) { f32x4 va[LN_NR][8], vb[LN_NR][8];
        load2(va, n0);
        for (;;) {
            const int n1 = n0 + step; if (n1 < M) load2(vb, n1);
            proc2(va, n0); if (n1 >= M) break;
            const int n2 = n1 + step; if (n2 < M) load2(va, n2);
            proc2(vb, n1); if (n2 >= M) break;
            n0 = n2; } }
}
__device__ __forceinline__ void ph_ln(Ctx& F, const float* g, const float* b, const float* modl, int sh_chunk, int sc_chunk, bool final_, bool skip_ctx = false,
                                      const float* part = nullptr, const float* pg = nullptr, float pcoef = 0.f, int previd = 0) {
    if (final_) ph_ln_t<true>(F, g, b, modl, sh_chunk, sc_chunk, skip_ctx, nullptr, pg, pcoef, previd);
    else ph_ln_t<false>(F, g, b, modl, sh_chunk, sc_chunk, skip_ctx, part, pg, pcoef, previd);
}
#ifndef DBG_RW_D0
#define DBG_RW_D0 1.0f
#endif
#ifndef DBG_RW_D1
#define DBG_RW_D1 1.0f
#endif
#ifndef DBG_LRU_D0
#define DBG_LRU_D0 1.0f
#endif
#ifndef DBG_LRU_D1
#define DBG_LRU_D1 1.0f
#endif
__device__ __forceinline__ void unpack8(const u32x4 w, float (&x)[8]) { x[0] = bf_lo(w.x); x[1] = bf_hi(w.x); x[2] = bf_lo(w.y); x[3] = bf_hi(w.y); x[4] = bf_lo(w.z); x[5] = bf_hi(w.z); x[6] = bf_lo(w.w); x[7] = bf_hi(w.w); }
__device__ __forceinline__ u32x4 pack8(const float (&x)[8]) { u32x4 w; w.x = cvt_pk_bf16(x[0], x[1]); w.y = cvt_pk_bf16(x[2], x[3]); w.z = cvt_pk_bf16(x[4], x[5]); w.w = cvt_pk_bf16(x[6], x[7]); return w; }
__device__ __forceinline__ int seq_j(int dir, int p) { return dir == 0 ? p : (p < CTX ? (CTX - 1 - p) : (TPB + CTX - 1 - p)); }

__device__ __forceinline__ float dpp_red8(float x) {
    x += __builtin_bit_cast(float, __builtin_amdgcn_update_dpp(0, __builtin_bit_cast(int, x), 0xB1, 0xF, 0xF, true));
    x += __builtin_bit_cast(float, __builtin_amdgcn_update_dpp(0, __builtin_bit_cast(int, x), 0x4E, 0xF, 0xF, true));
    x += __builtin_bit_cast(float, __builtin_amdgcn_update_dpp(0, __builtin_bit_cast(int, x), 0x141, 0xF, 0xF, true));
    return x;
}
__device__ __forceinline__ void ph_prep(Ctx& F, int l) {
    const bf16_t* FAp = (const bf16_t*)(F.ws + WS_R + R_FA);
    bf16_t* LIN = (bf16_t*)(F.ws + WS_R + R_LIN); bf16_t* RKV = (bf16_t*)(F.ws + WS_R + R_RKV); bf16_t* XC = (bf16_t*)(F.ws + WS_R + R_XC);
    bf16_t* QL = (bf16_t*)(F.ws + WS_R + R_QL); bf16_t* KVC = (bf16_t*)(F.ws + WS_R + R_KVC); bf16_t* KR = (bf16_t*)(F.ws + WS_R + R_KR);
    const float* mu = F.in[I_MU] + (size_t)l * RW_IN; const float* qn = F.in[I_QNORM] + (size_t)l * 512; const float* kvn = F.in[I_KVNORM] + (size_t)l * 256;
    float* KKN = (float*)(F.ws + WS_R + R_KKN); const float* kkp = F.in[I_KK] + (size_t)l * 1024;
    const float* cw = F.in[I_CONVW] + (size_t)l * 4 * 1024; const float* cb = F.in[I_CONVB] + (size_t)l * 1024; const float* rope = (const float*)(F.ws + WS_ROPE);
    const int lane = F.lane;
    {
        f32x4 mreg[7][2];
#pragma unroll
        for (int it = 0; it < 7; ++it) { const int ch = lane + 64 * it; const int chc = ch < 420 ? ch : 0; mreg[it][0] = *(const f32x4*)(mu + chc * 8); mreg[it][1] = *(const f32x4*)(mu + chc * 8 + 4); }
        f32x4 kkr[2][2];
#pragma unroll
        for (int it = 0; it < 2; ++it) { kkr[it][0] = *(const f32x4*)(kkp + (lane + 64 * it) * 8); kkr[it][1] = *(const f32x4*)(kkp + (lane + 64 * it) * 8 + 4); }
        for (int n = F.gw; n < M; n += F.NGW) {
            const int j = n % TPB; const bool isctx = j < CTX; const int t = j - CTX;
            int nb0, nb1, nb2, nb3;
            if (isctx) { nb0 = j > 0 ? n - 1 : -1; nb1 = j < CTX - 1 ? n + 1 : -1; nb2 = nb0; nb3 = nb1; }
            else { const int gc = t & 63, gr = t >> 6; nb0 = gc > 0 ? n - 1 : -1; nb1 = gc < 63 ? n + 1 : -1; nb2 = gr > 0 ? n - 64 : -1; nb3 = gr < 63 ? n + 64 : -1; }
            const bf16_t* Fr = FAp + (size_t)n * FA_PAD;
            u32x4 ow[7], sw[7];
#pragma unroll
            for (int it = 0; it < 7; ++it) { const int ch = lane + 64 * it; const int chc = ch < 420 ? ch : 0; const int q = chc / 105; const int nb = q == 0 ? nb0 : (q == 1 ? nb1 : (q == 2 ? nb2 : nb3));
                ow[it] = *(const u32x4*)(Fr + chc * 8); sw[it] = *(const u32x4*)(FAp + (size_t)(nb >= 0 ? nb : n) * FA_PAD + chc * 8); { const unsigned mk = nb >= 0 ? 0xffffffffu : 0u; sw[it].x &= mk; sw[it].y &= mk; sw[it].z &= mk; sw[it].w &= mk; } }
#pragma unroll
            for (int it = 0; it < 7; ++it) { const int ch = lane + 64 * it; if (ch >= 420) break;
                float own[8], sh[8], f[8]; unpack8(ow[it], own); unpack8(sw[it], sh);
#pragma unroll
                for (int i = 0; i < 8; ++i) { const float mm = i < 4 ? mreg[it][0][i] : mreg[it][1][i - 4]; f[i] = own[i] + (sh[i] - own[i]) * mm; }
                if (it == 2 || it == 3) { float ss = 0.f;
#pragma unroll
                    for (int i = 0; i < 8; ++i) { const float kv = f[i] * (i < 4 ? kkr[it - 2][0][i] : kkr[it - 2][1][i - 4]); ss += kv * kv; }
                    ss = dpp_red8(ss); if ((lane & 7) == 0) KKN[(size_t)n * 16 + ((ch - 128) >> 3)] = fminf(__builtin_amdgcn_rsqf(ss), 1e12f); }
                if (ch < 384) { *(u32x4*)(RKV + (size_t)n * 3072 + ch * 8) = pack8(f); }
                else if (ch < 392) {
#pragma unroll
                    for (int i = 0; i < 8; ++i) { const float e2 = __expf(2.0f * f[i]); f[i] = 1.0f - 2.0f * __builtin_amdgcn_rcpf(e2 + 1.0f); }
                    *(u32x4*)(LIN + (size_t)n * LORA_K + (ch - 384) * 8) = pack8(f); }
                else if (ch < 400) { *(u32x4*)(LIN + (size_t)n * LORA_K + 64 + (ch - 392) * 8) = pack8(f); }
                else {
#pragma unroll
                    for (int i = 0; i < 8; ++i) f[i] = __builtin_amdgcn_rcpf(1.0f + __expf(-f[i]));
                    *(u32x4*)(LIN + (size_t)n * LORA_K + 128 + (ch - 400) * 8) = pack8(f); }
            }
            if (lane < 12) *(u32x4*)(LIN + (size_t)n * LORA_K + 288 + lane * 8) = zero4();
        }
    }
    {
        const int ll = lane & 31;
        f32x4 qg[2], kg[2], cwr[2][4][2], cbr[2][2];
        qg[0] = *(const f32x4*)(qn + lane * 8); qg[1] = *(const f32x4*)(qn + lane * 8 + 4); kg[0] = *(const f32x4*)(kvn + ll * 8); kg[1] = *(const f32x4*)(kvn + ll * 8 + 4);
#pragma unroll
        for (int it = 0; it < 2; ++it) { const int c0 = (lane + 64 * it) * 8; cbr[it][0] = *(const f32x4*)(cb + c0); cbr[it][1] = *(const f32x4*)(cb + c0 + 4);
#pragma unroll
            for (int jj = 0; jj < 4; ++jj) { cwr[it][jj][0] = *(const f32x4*)(cw + jj * 1024 + c0); cwr[it][jj][1] = *(const f32x4*)(cw + jj * 1024 + c0 + 4); } }
        for (int n = F.gw; n < M; n += F.NGW) {
            const int j = n % TPB; const bool isctx = j < CTX; const int t = j - CTX; const bf16_t* Fr = FAp + (size_t)n * FA_PAD;
            const int spos = isctx ? j : t, slen = isctx ? CTX : SEQ;
            const u32x4 qw = *(const u32x4*)(Fr + OFF_QLAT + lane * 8), kw = *(const u32x4*)(Fr + OFF_KVLAT + ll * 8), rw = *(const u32x4*)(Fr + OFF_KROPE + (lane & 7) * 8);
            u32x4 xw[2][4];
#pragma unroll
            for (int it = 0; it < 2; ++it) { const int c0 = (lane + 64 * it) * 8;
#pragma unroll
                for (int jj = 0; jj < 4; ++jj) { const int pos = spos - 2 + jj; const bool ok = pos >= 0 && pos < slen; xw[it][jj] = *(const u32x4*)(FAp + (size_t)(ok ? n - 2 + jj : n) * FA_PAD + OFF_XR + c0); { const unsigned mk = ok ? 0xffffffffu : 0u; xw[it][jj].x &= mk; xw[it][jj].y &= mk; xw[it][jj].z &= mk; xw[it][jj].w &= mk; } } }
            f32x4 cs0 = {1.f, 0.f, 1.f, 0.f}, cs1 = cs0;
            if (!isctx) { const f32x4* cs = (const f32x4*)(rope + ((size_t)t * 32 + (lane & 7) * 4) * 2); cs0 = cs[0]; cs1 = cs[1]; }
            { float x[8]; unpack8(qw, x); float ss = 0.f;
#pragma unroll
              for (int i = 0; i < 8; ++i) ss += x[i] * x[i];
              const float r = __builtin_amdgcn_rsqf(wave_sum(ss) * (1.f / 512.f) + LN_EPS);
#pragma unroll
              for (int i = 0; i < 8; ++i) x[i] = x[i] * r * (i < 4 ? qg[0][i] : qg[1][i - 4]);
              *(u32x4*)(QL + (size_t)n * 512 + lane * 8) = pack8(x); }
            { float x[8]; unpack8(kw, x); float ss = 0.f;
#pragma unroll
              for (int i = 0; i < 8; ++i) ss += x[i] * x[i];
              if (lane >= 32) ss = 0.f;
              const float r = __builtin_amdgcn_rsqf(wave_sum(ss) * (1.f / 256.f) + LN_EPS);
#pragma unroll
              for (int i = 0; i < 8; ++i) x[i] = x[i] * r * (i < 4 ? kg[0][i] : kg[1][i - 4]);
              if (lane < 32) *(u32x4*)(KVC + (size_t)n * 256 + ll * 8) = pack8(x); }
            if (lane < 8) { float x[8], y[8]; unpack8(rw, x);
                y[0] = x[0] * cs0[0] - x[1] * cs0[1]; y[1] = x[0] * cs0[1] + x[1] * cs0[0]; y[2] = x[2] * cs0[2] - x[3] * cs0[3]; y[3] = x[2] * cs0[3] + x[3] * cs0[2];
                y[4] = x[4] * cs1[0] - x[5] * cs1[1]; y[5] = x[4] * cs1[1] + x[5] * cs1[0]; y[6] = x[6] * cs1[2] - x[7] * cs1[3]; y[7] = x[6] * cs1[3] + x[7] * cs1[2];
                *(u32x4*)(KR + (size_t)n * 64 + lane * 8) = pack8(y); }
#pragma unroll
            for (int it = 0; it < 2; ++it) { const int c0 = (lane + 64 * it) * 8; float acc[8];
#pragma unroll
                for (int i = 0; i < 8; ++i) acc[i] = i < 4 ? cbr[it][0][i] : cbr[it][1][i - 4];
#pragma unroll
                for (int jj = 0; jj < 4; ++jj) { float x[8]; unpack8(xw[it][jj], x);
#pragma unroll
                    for (int i = 0; i < 8; ++i) acc[i] += x[i] * (i < 4 ? cwr[it][jj][0][i] : cwr[it][jj][1][i - 4]); }
                *(u32x4*)(XC + (size_t)n * 1024 + c0) = pack8(acc); }
        }
    }
}
constexpr int SC_T = 32, SC_STEP = 352  , SC_BUF = SC_T * SC_STEP, SC_NCH = TPB / SC_T;
__device__ __forceinline__ float wave_sum_fast(float x) {
    x = dpp_red8(x);
    x += __builtin_bit_cast(float, __builtin_amdgcn_update_dpp(0, __builtin_bit_cast(int, x), 0x140, 0xF, 0xF, true));
    { auto r = __builtin_amdgcn_permlane16_swap(__float_as_uint(x), __float_as_uint(x), false, false); x = __uint_as_float(r[0]) + __uint_as_float(r[1]); }
    { auto r = __builtin_amdgcn_permlane32_swap(__float_as_uint(x), __float_as_uint(x), false, false); x = __uint_as_float(r[0]) + __uint_as_float(r[1]); }
    return x;
}
struct ScOps { f32x4 d0, d1, k0, k1, a0, a1, m0, m1, r0, r1; float vv; };
__device__ __forceinline__ void sc_load(ScOps& o, const LAS float* p, const LAS float* pv) {
    o.d0 = *(const LAS f32x4*)(p); o.d1 = *(const LAS f32x4*)(p + 4); o.k0 = *(const LAS f32x4*)(p + 64); o.k1 = *(const LAS f32x4*)(p + 68);
    o.a0 = *(const LAS f32x4*)(p + 128); o.a1 = *(const LAS f32x4*)(p + 132); o.m0 = *(const LAS f32x4*)(p + 192); o.m1 = *(const LAS f32x4*)(p + 196);
    o.r0 = *(const LAS f32x4*)(p + 256); o.r1 = *(const LAS f32x4*)(p + 260); o.vv = *pv;
}
__device__ __forceinline__ float sc_step(const ScOps& o, f32x2& s0, f32x2& s1, f32x2& s2, f32x2& s3) {
    const f32x2 p0 = s0 * (f32x2){o.k0[0], o.k0[1]} + s1 * (f32x2){o.k0[2], o.k0[3]}, p1 = s2 * (f32x2){o.k1[0], o.k1[1]} + s3 * (f32x2){o.k1[2], o.k1[3]};
    const f32x2 acc = p0 + p1; const float sa = dpp_red8(acc[0] + acc[1]);
    s0 = s0 * (f32x2){o.d0[0], o.d0[1]} - sa * (f32x2){o.a0[0], o.a0[1]} + o.vv * (f32x2){o.m0[0], o.m0[1]};
    s1 = s1 * (f32x2){o.d0[2], o.d0[3]} - sa * (f32x2){o.a0[2], o.a0[3]} + o.vv * (f32x2){o.m0[2], o.m0[3]};
    s2 = s2 * (f32x2){o.d1[0], o.d1[1]} - sa * (f32x2){o.a1[0], o.a1[1]} + o.vv * (f32x2){o.m1[0], o.m1[1]};
    s3 = s3 * (f32x2){o.d1[2], o.d1[3]} - sa * (f32x2){o.a1[2], o.a1[3]} + o.vv * (f32x2){o.m1[2], o.m1[3]};
    const f32x2 y0 = s0 * (f32x2){o.r0[0], o.r0[1]} + s1 * (f32x2){o.r0[2], o.r0[3]}, y1 = s2 * (f32x2){o.r1[0], o.r1[1]} + s3 * (f32x2){o.r1[2], o.r1[3]};
    const f32x2 ya = y0 + y1; return ya[0] + ya[1];
}
__device__ __forceinline__ void ph_rwkv_scan(Ctx& F, int l) {
    const bf16_t* RKV = (const bf16_t*)(F.ws + WS_R + R_RKV); const bf16_t* LO = (const bf16_t*)(F.ws + WS_R + R_LO); bf16_t* YS = (bf16_t*)(F.ws + WS_R + R_YS);
    LAS float* OP = (LAS float*)F.lds; LAS float* YB = (LAS float*)(F.lds + 2 * SC_BUF * 4);
    const int lane = F.lane, wave = F.wave;
    for (int item = F.vcu; item < 256; item += F.G) {
        const int vhalf = item & 1, dir = (item >> 1) & 1, h = (item >> 2) & 15, b = item >> 6;
        const int ch = h * 64 + lane; const size_t nb0 = (size_t)b * TPB;
        if (wave >= 4) {
            const float kkc = F.in[I_KK][(size_t)l * 1024 + ch], kac = F.in[I_KA][(size_t)l * 1024 + ch];
            const int sw = wave - 4, st = F.tid - 256; const float* KKN = (const float*)(F.ws + WS_R + R_KKN);
            bf16_t vr[8], vk[8], vv[8], vw[8], va[8]; float vn[8];
#define SC_FETCH(cn) do { _Pragma("unroll") for (int q = 0; q < 8; ++q) { const size_t n = nb0 + seq_j(dir, (cn) * SC_T + sw * 8 + q); \
                vr[q] = RKV[n * 3072 + ch]; vk[q] = RKV[n * 3072 + 1024 + ch]; vv[q] = RKV[n * 3072 + 2048 + ch]; vw[q] = LO[n * LORA_N + dir * 1024 + ch]; va[q] = LO[n * LORA_N + 2048 + dir * 1024 + ch]; vn[q] = KKN[n * 16 + h]; } } while (0)
            SC_FETCH(0);
            for (int ci = -1; ci < SC_NCH; ++ci) {
                if (ci + 1 < SC_NCH) { const int cn = ci + 1; LAS float* ob = OP + (cn & 1) * SC_BUF;
                    float fr[8], fk[8], fv[8], fw[8], fa[8], fn[8];
#pragma unroll
                    for (int q = 0; q < 8; ++q) { fr[q] = bf2f(vr[q]); fk[q] = bf2f(vk[q]); fv[q] = bf2f(vv[q]); fw[q] = bf2f(vw[q]); fa[q] = bf2f(va[q]); fn[q] = vn[q]; }
                    if (cn + 1 < SC_NCH) SC_FETCH(cn + 1);
#pragma unroll
                    for (int q = 0; q < 8; ++q) { const int s = sw * 8 + q; LAS float* o = ob + s * SC_STEP;
                        const float kx = fk[q]; const float kk = kx * kkc * fn[q];
                        const float dec = __expf(-0.60653065971263342f * fw[q]);
                        const float a = fa[q]; const float km = kx * (1.0f + (a - 1.0f) * kac);
                        o[lane] = dec; o[64 + lane] = kk; o[128 + lane] = a * kk; o[192 + lane] = km; o[256 + lane] = fr[q];
                        if ((lane >> 5) == vhalf) o[320 + (lane & 31)] = fv[q]; } }
                if (ci >= 1) { const int cp = ci - 1; const LAS float* yb = YB + (cp & 1) * (SC_T * 32); const int s = st >> 3, i0 = (st & 7) * 4;
                    const size_t n = nb0 + seq_j(dir, cp * SC_T + s); const f32x4 y = *(const LAS f32x4*)(yb + s * 32 + i0);
                    u32x2 w; w.x = cvt_pk_bf16(y[0], y[1]); w.y = cvt_pk_bf16(y[2], y[3]);
                    *(u32x2*)(YS + ((size_t)dir * M + n) * 1024 + h * 64 + vhalf * 32 + i0) = w; }
                LDS_WAIT(); __builtin_amdgcn_s_barrier(); asm volatile("" ::: "memory");
            }
#undef SC_FETCH
            { const int cp = SC_NCH - 1; const LAS float* yb = YB + (cp & 1) * (SC_T * 32); const int s = st >> 3, i0 = (st & 7) * 4;
                const size_t n = nb0 + seq_j(dir, cp * SC_T + s); const f32x4 y = *(const LAS f32x4*)(yb + s * 32 + i0);
                u32x2 w; w.x = cvt_pk_bf16(y[0], y[1]); w.y = cvt_pk_bf16(y[2], y[3]);
                *(u32x2*)(YS + ((size_t)dir * M + n) * 1024 + h * 64 + vhalf * 32 + i0) = w; }
        } else {
            const int rl = lane >> 3, c = lane & 7, rowl = wave * 8 + rl;
            f32x2 s0 = {0.f, 0.f}, s1 = s0, s2 = s0, s3 = s0;
            __builtin_amdgcn_s_barrier(); asm volatile("" ::: "memory");
            for (int ci = 0; ci < SC_NCH; ++ci) { const LAS float* ob = OP + (ci & 1) * SC_BUF + 8 * c; const LAS float* vb = OP + (ci & 1) * SC_BUF + 320 + rowl; LAS float* yb = YB + (ci & 1) * (SC_T * 32) + rowl;
                ScOps A, B; sc_load(A, ob, vb);
#pragma unroll 1
                for (int s8 = 0; s8 < SC_T; s8 += 8) { float ys[8];
#pragma unroll
                    for (int q = 0; q < 8; q += 2) { const int s = s8 + q;
                        sc_load(B, ob + (s + 1) * SC_STEP, vb + (s + 1) * SC_STEP);
                        ys[q] = sc_step(A, s0, s1, s2, s3);
                        if (s + 2 < SC_T) sc_load(A, ob + (s + 2) * SC_STEP, vb + (s + 2) * SC_STEP);
                        ys[q + 1] = sc_step(B, s0, s1, s2, s3); }
#pragma unroll
                    for (int q = 0; q < 8; ++q) ys[q] = dpp_red8(ys[q]);
                    if (c == 0) {
#pragma unroll
                        for (int q = 0; q < 8; ++q) yb[(s8 + q) * 32] = ys[q]; } }
                LDS_WAIT(); __builtin_amdgcn_s_barrier(); asm volatile("" ::: "memory");
            }
        }
        __syncthreads();
    }
}
__device__ __forceinline__ void rwkv_readout_half(const u32x4 y0w, const u32x4 y1w, const u32x4 rw, const u32x4 kw, const u32x4 vw, const u32x4 a0w, const u32x4 a1w, const u32x4 gw_,
                                                  const float (&lg)[8], const float (&lb)[8], const float (&rk)[8], const float (&ka)[8], const float (&a00)[8], const float (&a01)[8], bf16_t* dst) {
    float y0[8], y1[8], r[8], k[8], v[8], al0[8], al1[8], g[8], y[8], o[8];
    unpack8(y0w, y0); unpack8(y1w, y1); unpack8(rw, r); unpack8(kw, k); unpack8(vw, v); unpack8(a0w, al0); unpack8(a1w, al1); unpack8(gw_, g);
    float s = 0.f;
#pragma unroll
    for (int i = 0; i < 8; ++i) { y[i] = DBG_RW_D0 * y0[i] + DBG_RW_D1 * y1[i]; s += y[i]; }
    const float mu_ = dpp_red8(s) * (1.f / 64.f); float q = 0.f, bp = 0.f;
#pragma unroll
    for (int i = 0; i < 8; ++i) { y[i] -= mu_; q += y[i] * y[i];
        const float a_0 = al0[i], a_1 = al1[i];
        const float kb = k[i] * (1.0f + (0.5f * (a_0 + a_1) - 1.0f) * ka[i]); bp += r[i] * kb * rk[i]; }
    const float rstd = __builtin_amdgcn_rsqf(dpp_red8(q) * (1.f / 64.f) + GN_EPS); const float bonus = dpp_red8(bp);
#pragma unroll
    for (int i = 0; i < 8; ++i) o[i] = (y[i] * rstd * lg[i] + lb[i] + bonus * v[i]) * g[i];
    *(u32x4*)dst = pack8(o);
}
__device__ __forceinline__ void ph_rwkv_readout(Ctx& F, int l) {
    const bf16_t* RKV = (const bf16_t*)(F.ws + WS_R + R_RKV); const bf16_t* LO = (const bf16_t*)(F.ws + WS_R + R_LO); const bf16_t* YS = (const bf16_t*)(F.ws + WS_R + R_YS);
    bf16_t* YC = (bf16_t*)(F.ws + WS_YCAT);
    const int half = F.gw & 1, c0 = half * 512 + F.lane * 8;
    float lg[8], lb[8], rk[8], ka[8], a00[8], a01[8];
#pragma unroll
    for (int i = 0; i < 8; ++i) { lg[i] = F.in[I_LNXG][(size_t)l * 1024 + c0 + i]; lb[i] = F.in[I_LNXB][(size_t)l * 1024 + c0 + i]; rk[i] = F.in[I_RK][(size_t)l * 1024 + c0 + i];
        ka[i] = F.in[I_KA][(size_t)l * 1024 + c0 + i]; a00[i] = F.in[I_A0][(size_t)l * 2048 + c0 + i]; a01[i] = F.in[I_A0][(size_t)l * 2048 + 1024 + c0 + i]; }
    const int NW2 = F.NGW >> 1;
    for (int n = F.gw >> 1; n < M; n += 2 * NW2) { const int n2 = n + NW2; const bool two = n2 < M; const size_t m2 = two ? n2 : n;
        const u32x4 y0a = *(const u32x4*)(YS + (size_t)n * 1024 + c0), y1a = *(const u32x4*)(YS + ((size_t)M + n) * 1024 + c0), ra = *(const u32x4*)(RKV + (size_t)n * 3072 + c0), ka_ = *(const u32x4*)(RKV + (size_t)n * 3072 + 1024 + c0),
                    va = *(const u32x4*)(RKV + (size_t)n * 3072 + 2048 + c0), a0a = *(const u32x4*)(LO + (size_t)n * LORA_N + 2048 + c0), a1a = *(const u32x4*)(LO + (size_t)n * LORA_N + 3072 + c0), ga = *(const u32x4*)(LO + (size_t)n * LORA_N + 4096 + c0);
        const u32x4 y0b = *(const u32x4*)(YS + m2 * 1024 + c0), y1b = *(const u32x4*)(YS + ((size_t)M + m2) * 1024 + c0), rb = *(const u32x4*)(RKV + m2 * 3072 + c0), kb_ = *(const u32x4*)(RKV + m2 * 3072 + 1024 + c0),
                    vb = *(const u32x4*)(RKV + m2 * 3072 + 2048 + c0), a0b = *(const u32x4*)(LO + m2 * LORA_N + 2048 + c0), a1b = *(const u32x4*)(LO + m2 * LORA_N + 3072 + c0), gb = *(const u32x4*)(LO + m2 * LORA_N + 4096 + c0);
        rwkv_readout_half(y0a, y1a, ra, ka_, va, a0a, a1a, ga, lg, lb, rk, ka, a00, a01, YC + (size_t)n * 4096 + c0);
        if (two) rwkv_readout_half(y0b, y1b, rb, kb_, vb, a0b, a1b, gb, lg, lb, rk, ka, a00, a01, YC + m2 * 4096 + c0);
    }
}
constexpr int LR_CL = 34, LR_NC = TPB / LR_CL;
__device__ __forceinline__ float one_minus_exp(float x) {
    const float p = -x * (1.0f + x * (0.5f + x * (0.16666667f + x * 0.041666668f))); const float e = 1.0f - __expf(x); return x > -0.06f ? p : e;
}
template <int NB, bool PASS2>
__device__ __forceinline__ void lru_batch(bf16_t* GT, const bf16_t* XC, size_t nb0, int dir, int p0, int gcol, int c0, const float (&sp8)[8], const float (&ba)[8], const float (&bx)[8], float (&A)[8], float (&hh)[8], bool store) {
    u32x4 gr[NB], gi[NB], xx[NB];
#pragma unroll
    for (int q = 0; q < NB; ++q) { const size_t n = nb0 + seq_j(dir, p0 + q); gr[q] = *(const u32x4*)(GT + n * 4096 + gcol); gi[q] = *(const u32x4*)(GT + n * 4096 + gcol + 128); xx[q] = *(const u32x4*)(XC + n * 1024 + c0); }
#pragma unroll
    for (int q = 0; q < NB; ++q) { float r[8], ii[8], x[8], o[8]; unpack8(gr[q], r); unpack8(gi[q], ii); unpack8(xx[q], x);
#pragma unroll
        for (int i = 0; i < 8; ++i) {
            const float dr = 1.0f + __expf(fminf(-(r[i] + ba[i]), 40.f)), di = 1.0f + __expf(fminf(-(ii[i] + bx[i]), 40.f)); const float rc = __builtin_amdgcn_rcpf(dr * di);
            const float g_r = di * rc, g_i = dr * rc;
            const float la = sp8[i] * g_r; const float a = __expf(la); const float x2 = 2.0f * la;
            const float om = x2 > -0.06f ? -x2 * (1.0f + x2 * (0.5f + x2 * (0.16666667f + x2 * 0.041666668f))) : 1.0f - a * a;
            const float bb = __builtin_amdgcn_sqrtf(om) * g_i * x[i];
            if (!PASS2) A[i] *= a; hh[i] = a * hh[i] + bb; o[i] = hh[i]; }
        if (PASS2 && store) *(u32x4*)(GT + (nb0 + seq_j(dir, p0 + q)) * 4096 + gcol) = pack8(o);
        __builtin_amdgcn_sched_barrier(0); }
}
__device__ __forceinline__ void ph_lru_scan(Ctx& F, int l, bool store = true) {
    bf16_t* GT = (bf16_t*)(F.ws + WS_R + R_GT); const bf16_t* XC = (const bf16_t*)(F.ws + WS_R + R_XC);
    LAS float* agg = (LAS float*)F.lds;
    for (int item = F.vcu; item < 256; item += F.G) {
        const int cg = item & 31, dir = (item >> 5) & 1, b = item >> 6; const int tc = F.tid >> 2, o = F.tid & 3, c0 = cg * 32 + o * 8, blk = c0 >> 7, e0 = c0 & 127;
        float sp8[8], ba[8], bx[8];
#pragma unroll
        for (int i = 0; i < 8; ++i) { sp8[i] = -8.0f * softplusf_(-F.in[I_LAMBDA][((size_t)l * 2 + dir) * 1024 + c0 + i]); ba[i] = F.in[I_LRUBA][((size_t)l * 2 + dir) * 1024 + c0 + i]; bx[i] = F.in[I_LRUBX][((size_t)l * 2 + dir) * 1024 + c0 + i]; }
        const size_t nb0 = (size_t)b * TPB; const int gcol = blk * 512 + dir * 256 + e0; const int p0 = tc * LR_CL;
        float A[8], hh[8];
#pragma unroll
        for (int i = 0; i < 8; ++i) { A[i] = 1.f; hh[i] = 0.f; }
#pragma unroll 1
        for (int bb = 0; bb < 8; ++bb) lru_batch<4, false>(GT, XC, nb0, dir, p0 + 4 * bb, gcol, c0, sp8, ba, bx, A, hh, false);
        lru_batch<2, false>(GT, XC, nb0, dir, p0 + 32, gcol, c0, sp8, ba, bx, A, hh, false);
        { LAS float* ag = agg + (size_t)(tc * 4 + o) * 16;
          *(LAS f32x4*)(ag) = (f32x4){A[0], A[1], A[2], A[3]}; *(LAS f32x4*)(ag + 4) = (f32x4){A[4], A[5], A[6], A[7]}; *(LAS f32x4*)(ag + 8) = (f32x4){hh[0], hh[1], hh[2], hh[3]}; *(LAS f32x4*)(ag + 12) = (f32x4){hh[4], hh[5], hh[6], hh[7]}; }
        __syncthreads();
#pragma unroll
        for (int i = 0; i < 8; ++i) hh[i] = 0.f;
        for (int i = 0; i < tc; ++i) { const LAS float* ag = agg + (size_t)(i * 4 + o) * 16; const f32x4 a0 = *(const LAS f32x4*)(ag), a1 = *(const LAS f32x4*)(ag + 4), h0 = *(const LAS f32x4*)(ag + 8), h1 = *(const LAS f32x4*)(ag + 12);
#pragma unroll
            for (int j = 0; j < 4; ++j) { hh[j] = a0[j] * hh[j] + h0[j]; hh[4 + j] = a1[j] * hh[4 + j] + h1[j]; } }
#pragma unroll 1
        for (int bb = 0; bb < 8; ++bb) lru_batch<4, true>(GT, XC, nb0, dir, p0 + 4 * bb, gcol, c0, sp8, ba, bx, A, hh, store);
        lru_batch<2, true>(GT, XC, nb0, dir, p0 + 32, gcol, c0, sp8, ba, bx, A, hh, store);
        if (!store && hh[0] == 12345.678f) GT[0] = 0;
        __syncthreads();
    }
}
__device__ __forceinline__ void ph_lru_readout(Ctx& F) {
    const bf16_t* GT = (const bf16_t*)(F.ws + WS_R + R_GT); const bf16_t* GB = (const bf16_t*)(F.ws + WS_R + R_GB); bf16_t* YC = (bf16_t*)(F.ws + WS_YCAT);
    const int NIT = 2 * M;
    for (int it0 = F.gw; it0 < NIT; it0 += 4 * F.NGW) { u32x4 h0w[4], h1w[4], gw_[4];
#pragma unroll
        for (int u = 0; u < 4; ++u) { const int it = it0 + u * F.NGW; const int itc = it < NIT ? it : it0; const int n = itc >> 1, c0 = (itc & 1) * 512 + F.lane * 8, blk = c0 >> 7, e0 = c0 & 127;
            h0w[u] = *(const u32x4*)(GT + (size_t)n * 4096 + blk * 512 + e0); h1w[u] = *(const u32x4*)(GT + (size_t)n * 4096 + blk * 512 + 256 + e0); gw_[u] = *(const u32x4*)(GB + (size_t)n * 1024 + c0); }
#pragma unroll
        for (int u = 0; u < 4; ++u) { const int it = it0 + u * F.NGW; if (it >= NIT) break; const int n = it >> 1, c0 = (it & 1) * 512 + F.lane * 8; float h0[8], h1[8], g[8], o[8];
            unpack8(h0w[u], h0); unpack8(h1w[u], h1); unpack8(gw_[u], g);
#pragma unroll
            for (int i = 0; i < 8; ++i) o[i] = (DBG_LRU_D0 * h0[i] + DBG_LRU_D1 * h1[i]) * gelu_tanh_(g[i]);
            *(u32x4*)(YC + (size_t)n * 4096 + 3072 + c0) = pack8(o); } }
}
__device__ __forceinline__ void ph_attn(Ctx& F, bool with_ctx, char* lds_gen) {
    const bf16_t* Q = (const bf16_t*)(F.ws + WS_R + R_Q); const bf16_t* KN = (const bf16_t*)(F.ws + WS_R + R_KN); const bf16_t* KR = (const bf16_t*)(F.ws + WS_R + R_KR); const bf16_t* V = (const bf16_t*)(F.ws + WS_R + R_V); bf16_t* YC = (bf16_t*)(F.ws + WS_YCAT);
    const int NU = 1024 + (with_ctx ? 64 : 0);
    for (int u = F.vcu; u < NU; u += F.G) {
        int b, h, seq; size_t q0; const float* rp = nullptr;
        if (u < 1024) { b = u >> 8; h = (u >> 4) & 15; q0 = (size_t)b * TPB + CTX + (size_t)(u & 15) * 256; seq = TPB; rp = (const float*)(F.ws + WS_ROPE) + (size_t)(u & 15) * 256 * 64; }
        else { const int uu = u - 1024; b = uu >> 4; h = uu & 15; q0 = (size_t)b * TPB; seq = CTX; }
        att::attn_body(Q + q0 * 3072 + h * QKD, KN + (size_t)b * TPB * 2048 + h * QK_NOPE, KR + (size_t)b * TPB * 64, V + (size_t)b * TPB * 2048 + h * VD, YC + q0 * 4096 + 1024 + h * VD, seq, rp, lds_gen);
        __syncthreads();
    }
}
namespace sc2 {
constexpr int BS = 8, NBLK = TPB / BS  , RB = 8, NSTG = 6;
constexpr int SL_X = 0, SL_W2T = 4096, SL_QT = 8192, SL_VT = 9216, SL_G = 10240, SLOT = 10496;
constexpr int ST_PM = 0, ST_GM = 4096, ST_T = 5120, ST_TG = 5376, STG = 5632;
constexpr int OFF_STG = RB * SLOT, OFF_FLAG = OFF_STG + NSTG * STG;
__device__ __forceinline__ unsigned lds_ld(volatile LAS unsigned* p) { return *p; }
__device__ __forceinline__ int keyperm(int ks, int q) { return 16 * (ks >> 2) + 4 * q + (ks & 3); }
}
#ifndef SC2_VARIANT
#define SC2_VARIANT 0
#endif
__device__ __forceinline__ void ph_rwkv_scan2(Ctx& F, int l, int pass = 0) {
    const int variant = pass ? SC2_VARIANT : 0;
    using namespace sc2;
    const bf16_t* RKV = (const bf16_t*)(F.ws + WS_R + R_RKV); const bf16_t* LO = (const bf16_t*)(F.ws + WS_R + R_LO); bf16_t* YS = (bf16_t*)(F.ws + WS_R + R_YS); const float* KKN = (const float*)(F.ws + WS_R + R_KKN);
    const int lane = F.lane, wave = F.wave;
    volatile LAS unsigned* flags = (volatile LAS unsigned*)(F.lds + OFF_FLAG);
    for (int item = F.vcu; item < 256; item += F.G) {
        const int vhalf = item & 1, dir = (item >> 1) & 1, h = (item >> 2) & 15, b = item >> 6; const size_t nb0 = (size_t)b * TPB;
        __syncthreads();
        if (F.tid < 16) flags[F.tid] = 0u;
        for (int i = F.tid; i < RB * 256; i += 512) { const int s = i >> 8, e = i & 255; if (e >= 128) ((LAS float*)(F.lds + s * SLOT + SL_QT))[e] = 0.f; }
        __syncthreads();
        if (wave < 2) {
            const int n = lane & 15, q = lane >> 4; const int rowg = h * 64 + vhalf * 32 + wave * 16 + n;
            f32x4 S[4]; S[0] = S[1] = S[2] = S[3] = (f32x4){0.f, 0.f, 0.f, 0.f};
            for (int blk = 0; blk < NBLK; ++blk) { const int slot = blk & (RB - 1); const LAS unsigned char* sp = F.lds + slot * SLOT;
                { unsigned spin = 0; while (lds_ld(flags + slot) != (unsigned)(blk + 1)) { __builtin_amdgcn_s_sleep(1); if (++spin > (1u << 24)) break; } }
                asm volatile("" ::: "memory");
                f32x4 xa[4];
#pragma unroll
                for (int mb = 0; mb < 4; ++mb) xa[mb] = *(const LAS f32x4*)(sp + SL_X + (n * 64 + 16 * mb + 4 * q) * 4);
                const f32x4 vt = *(const LAS f32x4*)(sp + SL_VT + ((wave * 16 + n) * 8 + 4 * (q & 1)) * 4);
                f32x4 w2[4];
#pragma unroll
                for (int mb = 0; mb < 4; ++mb) w2[mb] = *(const LAS f32x4*)(sp + SL_W2T + ((16 * mb + n) * 16 + 4 * q) * 4);
                const f32x4 qt = *(const LAS f32x4*)(sp + SL_QT + (n * 16 + 4 * q) * 4);
                f32x4 gm[4];
#pragma unroll
                for (int mb = 0; mb < 4; ++mb) gm[mb] = *(const LAS f32x4*)(sp + SL_G + (16 * mb + 4 * q) * 4);
                if (variant == 1) { asm volatile("s_waitcnt lgkmcnt(0)" ::: "memory"); if (lane == 0) flags[8 + wave] = (unsigned)(blk + 1); continue; }
                f32x4 D1 = {0.f, 0.f, 0.f, 0.f}, D1b = D1;
#pragma unroll
                for (int mb = 0; mb < 4; mb += 2)
#pragma unroll
                    for (int i = 0; i < 4; ++i) { D1 = __builtin_amdgcn_mfma_f32_16x16x4f32(xa[mb][i], S[mb][i], D1, 0, 0, 0); D1b = __builtin_amdgcn_mfma_f32_16x16x4f32(xa[mb + 1][i], S[mb + 1][i], D1b, 0, 0, 0); }
                f32x4 Sg[4];
#pragma unroll
                for (int mb = 0; mb < 4; ++mb) Sg[mb] = S[mb] * gm[mb];
                D1 += D1b;
                f32x4 bop;
#pragma unroll
                for (int i = 0; i < 4; ++i) bop[i] = q < 2 ? vt[i] : D1[i];
                f32x4 Dy;
#pragma unroll
                for (int i = 0; i < 4; ++i) Dy[i] = q < 2 ? D1[i] : 0.f;
#pragma unroll
                for (int i = 0; i < 4; ++i) Dy = __builtin_amdgcn_mfma_f32_16x16x4f32(qt[i], bop[i], Dy, 0, 0, 0);
                { f32x4 Dm0 = Sg[0], Dm1 = Sg[1], Dm2 = Sg[2], Dm3 = Sg[3];
#pragma unroll
                  for (int i = 0; i < 4; ++i) { Dm0 = __builtin_amdgcn_mfma_f32_16x16x4f32(w2[0][i], bop[i], Dm0, 0, 0, 0); Dm1 = __builtin_amdgcn_mfma_f32_16x16x4f32(w2[1][i], bop[i], Dm1, 0, 0, 0);
                      Dm2 = __builtin_amdgcn_mfma_f32_16x16x4f32(w2[2][i], bop[i], Dm2, 0, 0, 0); Dm3 = __builtin_amdgcn_mfma_f32_16x16x4f32(w2[3][i], bop[i], Dm3, 0, 0, 0); }
                  S[0] = Dm0; S[1] = Dm1; S[2] = Dm2; S[3] = Dm3; }
                asm volatile("s_waitcnt lgkmcnt(0)" ::: "memory");
                if (lane == 0) flags[8 + wave] = (unsigned)(blk + 1);
                if (q < 2 && !pass) {
#pragma unroll
                    for (int i = 0; i < 4; ++i) { const size_t nt = nb0 + seq_j(dir, blk * BS + 4 * q + i); YS[((size_t)dir * M + nt) * 1024 + rowg] = f2bf(Dy[i]); } }
            }
        } else {
            const int sw = wave - 2; const int ch = h * 64 + lane;
            LAS unsigned char* sc = F.lds + OFF_STG + sw * STG;
            const float kkc = F.in[I_KK][(size_t)l * 1024 + ch], kac = F.in[I_KA][(size_t)l * 1024 + ch];
            bf16_t pr[8], pk[8], pv[8], pw[8], pa_[8]; float pn[8];
#define SC2_FETCH(bk) do { _Pragma("unroll") for (int t = 0; t < 8; ++t) { const size_t nt = nb0 + seq_j(dir, (bk) * BS + t); \
                pr[t] = RKV[nt * 3072 + ch]; pk[t] = RKV[nt * 3072 + 1024 + ch]; pv[t] = RKV[nt * 3072 + 2048 + h * 64 + vhalf * 32 + (lane & 31)]; \
                pw[t] = LO[nt * LORA_N + dir * 1024 + ch]; pa_[t] = LO[nt * LORA_N + 2048 + dir * 1024 + ch]; pn[t] = KKN[nt * 16 + h]; } } while (0)
#ifndef SC2_WEIGHTED
#define SC2_WEIGHTED 1
#endif
            const int pA = sw == 0 ? 0 : sw == 1 ? 1 : sw == 4 ? 2 : sw == 5 ? 3 : sw == 2 ? 8 : 9; const bool two = !(sw == 2 || sw == 3);
#define SC2_BLK(it) (SC2_WEIGHTED == 2 ? (two ? (it) * 4 + pA : NBLK) : SC2_WEIGHTED ? (two ? ((it) >> 1) * 10 + pA + 4 * ((it) & 1) : (it) * 10 + pA) : sw + (it) * NSTG)
            SC2_FETCH(SC2_BLK(0));
            for (int it_ = 0;; ++it_) { const int blk = SC2_BLK(it_); if (blk >= NBLK) break; const int nblk_ = SC2_BLK(it_ + 1);
                const int slot = blk & (RB - 1); LAS unsigned char* sp = F.lds + slot * SLOT;
                float fr[8], fk[8], fv[8], fw[8], fa[8], fn[8];
#pragma unroll
                for (int t = 0; t < 8; ++t) { fr[t] = bf2f(pr[t]); fk[t] = bf2f(pk[t]); fv[t] = bf2f(pv[t]); fw[t] = bf2f(pw[t]); fa[t] = bf2f(pa_[t]); fn[t] = pn[t]; }
                if (nblk_ < NBLK) SC2_FETCH(nblk_);
                if (blk >= RB) { unsigned spin = 0; while (lds_ld(flags + 8) < (unsigned)(blk - RB + 1) || lds_ld(flags + 9) < (unsigned)(blk - RB + 1)) { __builtin_amdgcn_s_sleep(2); if (++spin > (1u << 24)) break; } }
                asm volatile("" ::: "memory");
                if (variant == 2) { if (lane == 0) flags[slot] = (unsigned)(blk + 1); continue; }
                float bt[8], km[8]; float g = 1.f;
#pragma unroll
                for (int t = 0; t < 8; ++t) { const float dec = __expf(-0.60653065971263342f * fw[t]); const float kk = fk[t] * kkc * fn[t]; const float gp = g; g *= dec; const float ig = __builtin_amdgcn_rcpf(g);
                    const float a = fa[t]; bt[t] = a * kk * ig; km[t] = fk[t] * (1.0f + (a - 1.0f) * kac) * ig;
                    ((LAS float*)(sp + SL_X))[t * 64 + lane] = g * fr[t]; ((LAS float*)(sp + SL_X))[(8 + t) * 64 + lane] = gp * kk;
                    ((LAS float*)(sc + ST_PM))[t * 64 + lane] = bt[t]; ((LAS float*)(sc + ST_PM))[(8 + t) * 64 + lane] = km[t];
                    if (lane < 32) ((LAS float*)(sp + SL_VT))[lane * 8 + t] = fv[t]; }
                ((LAS float*)(sp + SL_G))[lane] = g;
                asm volatile("s_waitcnt lgkmcnt(0)" ::: "memory");
                { const int n = lane & 15, q = lane >> 4; f32x4 Gp[4], pa[4], xb[4];
#pragma unroll
                  for (int mb = 0; mb < 4; ++mb) { pa[mb] = *(const LAS f32x4*)(sc + ST_PM + (n * 64 + 16 * mb + 4 * q) * 4); xb[mb] = *(const LAS f32x4*)(sp + SL_X + (n * 64 + 16 * mb + 4 * q) * 4); Gp[mb] = (f32x4){0.f, 0.f, 0.f, 0.f}; }
#pragma unroll
                  for (int i = 0; i < 4; ++i)
#pragma unroll
                      for (int mb = 0; mb < 4; ++mb) Gp[mb] = __builtin_amdgcn_mfma_f32_16x16x4f32(pa[mb][i], xb[mb][i], Gp[mb], 0, 0, 0);
                  const f32x4 Gd = (Gp[0] + Gp[1]) + (Gp[2] + Gp[3]);
#pragma unroll
                  for (int i = 0; i < 4; ++i) ((LAS float*)(sc + ST_GM))[(4 * q + i) * 16 + n] = Gd[i]; }
                asm volatile("s_waitcnt lgkmcnt(0)" ::: "memory");
                const LAS float* GM = (const LAS float*)(sc + ST_GM); LAS float* Tm = (LAS float*)(sc + ST_T); LAS float* TG = (LAS float*)(sc + ST_TG);
                const int p = lane & 7;
                { f32x4 g0[8][4];
#pragma unroll
                  for (int i = 0; i < 8; ++i)
#pragma unroll
                      for (int c4 = 0; c4 < 4; ++c4) g0[i][c4] = *(const LAS f32x4*)(GM + i * 16 + 4 * c4);
                  float Tr[8], Q1r[8];
#pragma unroll
                  for (int c = 0; c < 8; ++c) { float acc = (c == p) ? 1.f : 0.f;
#pragma unroll
                      for (int i = 0; i < 8; ++i) if (i < c) acc -= Tr[i] * g0[i][2 + (c >> 2)][c & 3];
                      Tr[c] = acc; }
#pragma unroll
                  for (int t = 0; t < 8; ++t) { float acc = 0.f;
#pragma unroll
                      for (int j = 0; j < 8; ++j) if (j <= t) acc += Tr[j] * g0[j][t >> 2][t & 3];
                      Q1r[t] = acc; }
                  if (lane < 8) { *(LAS f32x4*)(Tm + p * 8) = (f32x4){Tr[0], Tr[1], Tr[2], Tr[3]}; *(LAS f32x4*)(Tm + p * 8 + 4) = (f32x4){Tr[4], Tr[5], Tr[6], Tr[7]};
                                  *(LAS f32x4*)(TG + p * 8) = (f32x4){Q1r[0], Q1r[1], Q1r[2], Q1r[3]}; *(LAS f32x4*)(TG + p * 8 + 4) = (f32x4){Q1r[4], Q1r[5], Q1r[6], Q1r[7]}; }
                  asm volatile("s_waitcnt lgkmcnt(0)" ::: "memory");
                  f32x4 tg[8][2], gr[4];
#pragma unroll
                  for (int j = 0; j < 8; ++j) { tg[j][0] = *(const LAS f32x4*)(TG + j * 8); tg[j][1] = *(const LAS f32x4*)(TG + j * 8 + 4); }
#pragma unroll
                  for (int c4 = 0; c4 < 4; ++c4) gr[c4] = *(const LAS f32x4*)(GM + (8 + p) * 16 + 4 * c4);
                  float q2[8];
#pragma unroll
                  for (int t = 0; t < 8; ++t) { float acc = (p <= t) ? gr[t >> 2][t & 3] : 0.f;
#pragma unroll
                      for (int j = 1; j < 8; ++j) { const float cj = (j > p) ? gr[2 + (j >> 2)][j & 3] : 0.f; acc -= cj * tg[j][t >> 2][t & 3]; }
                      q2[t] = acc; }
                  if (lane < 8) { LAS float* QT = (LAS float*)(sp + SL_QT);
#pragma unroll
                      for (int t = 0; t < 8; ++t) { QT[t * 16 + p] = q2[t]; QT[t * 16 + 8 + p] = -Q1r[t]; } }
                }
                { float M1[8];
#pragma unroll
                  for (int i = 0; i < 8; ++i) { float acc = 0.f;
#pragma unroll
                      for (int j = 0; j < 8; ++j) if (j >= i) acc += Tm[i * 8 + j] * bt[j];
                      M1[i] = acc; }
                  float K2[8];
#pragma unroll
                  for (int i = 0; i < 8; ++i) { float acc = km[i];
#pragma unroll
                      for (int j = 0; j < 8; ++j) if (j > i) acc -= GM[(8 + i) * 16 + 8 + j] * M1[j];
                      K2[i] = acc; }
                  LAS f32x4* wo = (LAS f32x4*)(sp + SL_W2T + lane * 64); const float ng = -g;
                  wo[0] = (f32x4){K2[0], K2[1], K2[2], K2[3]} * g; wo[1] = (f32x4){K2[4], K2[5], K2[6], K2[7]} * g; wo[2] = (f32x4){M1[0], M1[1], M1[2], M1[3]} * ng; wo[3] = (f32x4){M1[4], M1[5], M1[6], M1[7]} * ng; }
                asm volatile("s_waitcnt lgkmcnt(0)" ::: "memory");
                if (lane == 0) flags[slot] = (unsigned)(blk + 1);
            }
#undef SC2_FETCH
#undef SC2_BLK
        }
    }
    __syncthreads();
}
#ifndef MK_MULTI
#define MK_MULTI 0
#endif
constexpr int NPL = 16, NPH = 3 + DEPTH * NPL;
#ifndef DBG_MIX
#define DBG_MIX 1.0f
#endif
#ifndef DBG_FFN
#define DBG_FFN 1.0f
#endif
#ifndef DBG_RW
#define DBG_RW 1.0f
#endif
#ifndef DBG_MLA
#define DBG_MLA 1.0f
#endif
#ifndef DBG_LRU
#define DBG_LRU 1.0f
#endif
struct Args { const float* in[40]; float* out; unsigned char* ws; int ph_lo, ph_hi; };
#define CAS __attribute__((address_space(4)))
#define GEMM(EPI, e, Aptr, Bptr, lda_, ldb_, K_, nM_, nN_, nG_, pmode_, lrug_) do { pg8::Gemm g_{(const bf16_t*)(Aptr), (const bf16_t*)(Bptr), lda_, ldb_, K_, lrug_, (pmode_) == 2 ? 4 : 0}; pg8::Order S_; \
        S_.init(nM_, nN_, nG_, G, (bx + G - rot) % G, pmode_, 4); pg8::gemm_phase<EPI>(F.lds, g_, S_, e); rot = (rot + (nM_) * (nN_) * (nG_)) % G; } while (0)
__device__ __forceinline__ void make_ctx(Ctx& F, const CAS Args& args, unsigned char* lds_) {
    unsigned char* ws = args.ws;
    int tid = threadIdx.x; asm volatile("" : "+v"(tid));
    F.lds = (LAS unsigned char*)lds_; F.ws = ws; F.in = args.in; F.out = args.out;
    F.tid = tid; F.lane = F.tid & 63; F.wave = __builtin_amdgcn_readfirstlane(F.tid >> 6);
    F.G = gridDim.x; { int bx = blockIdx.x; asm volatile("" : "+s"(bx)); F.vcu = (F.G % 8 == 0) ? (bx % 8) * (F.G / 8) + bx / 8 : bx; }
    F.gw = F.vcu * 8 + F.wave; F.NGW = F.G * 8;
}
template <int KIND> __device__ __forceinline__ void run_phase(const Args& args_, int l_, unsigned char* lds_, int pass = 0) {
    int l = l_; asm volatile("" : "+s"(l));
    unsigned long long kp_ = (unsigned long long)__builtin_amdgcn_kernarg_segment_ptr(); asm volatile("" : "+s"(kp_));
    const CAS Args& args = *(const CAS Args*)kp_; (void)args_;
    Ctx F; make_ctx(F, args, lds_); char* lds_gen = (char*)lds_;
    unsigned char* W = F.ws + WS_W; unsigned char* R = F.ws + WS_R;
    bf16_t* H = (bf16_t*)(F.ws + WS_H); float* X = (float*)(F.ws + WS_X); bf16_t* YC = (bf16_t*)(F.ws + WS_YCAT);
    int bx = blockIdx.x; asm volatile("" : "+s"(bx)); const int G = F.G; int rot = 0;
    const float* modl = (const float*)(F.ws + WS_MOD) + (size_t)l * 5 * 18432;
    const bool lastl = (l + 1 == DEPTH); const int PM = lastl ? 1 : 0, NP = lastl ? 64 : NPAN;
    float* PART = (float*)(R + R_PART); const int PMS = lastl ? 1 : 2;
    const float* lng = F.in[I_LNG] + (size_t)l * 3 * D; const float* lnb = F.in[I_LNB] + (size_t)l * 3 * D;
    if constexpr (KIND == 0) { ph_modp(F); ph_rope(F); ph_xasm(F); ph_cvt(F, 0); }
    if constexpr (KIND == 1) { ph_modr(F); }
    if constexpr (KIND == 2) { ph_h0(F); }
    if constexpr (KIND == 3) { pg8::EpiSwiGLU e{(bf16_t*)(R + R_ACT), DFF}; GEMM(pg8::EpiSwiGLU, e, H, W + W_GU0, D, D, D, NPAN, 44, 1, 0, 0); }
    if constexpr (KIND == 4) { pg8::EpiResid e{X, modl + 2 * 2048, pass ? 0.f : 0.5f * DBG_FFN, pass ? 1.f : ALPHA, 3 * l, l == 0 ? F.in[I_X] : nullptr}; GEMM(pg8::EpiResid, e, R + R_ACT, W + W_D0, DFF, DFF, DFF, 64, 8, 1, 2, 0); }
    if constexpr (KIND == 5) { ph_ln(F, lng, lnb, modl, 3, 4, false, false, pass ? nullptr : PART, modl + 2 * 2048, 0.5f * DBG_FFN, 3 * l); }
    if constexpr (KIND == 6) { pg8::EpiBf16 e{(bf16_t*)(R + R_FA), FA_PAD, 0, (bf16_t*)(R + R_GB), GB_TILE0, 1024};     GEMM(pg8::EpiBf16, e, H, W + W_INA, D, D, D, NPAN, FA_PAD / 256, 1, 0, 0); }
    if constexpr (KIND == 7) { ph_prep(F, l); }
    if constexpr (KIND == 8) { { pg8::EpiGate e{(bf16_t*)(R + R_LO), (const float*)(F.ws + WS_LB) + (size_t)l * 4096, LORA_N}; GEMM(pg8::EpiGate, e, R + R_LIN, W + W_LORA, LORA_K, LORA_K, LORA_K, NPAN, 16, 1, 0, 0); }
                               { pg8::EpiBf16 e{(bf16_t*)(R + R_LO) + 4096, LORA_N, 0, nullptr, 1 << 30, 0}; GEMM(pg8::EpiBf16, e, R + R_LIN, (bf16_t*)(W + W_LORA) + (size_t)4096 * LORA_K, LORA_K, LORA_K, LORA_K, NPAN, 4, 1, 0, 0); }
                               { pg8::EpiBf16 e{(bf16_t*)(R + R_GT), 4096, 512, nullptr, 1 << 30, 0}; GEMM(pg8::EpiBf16, e, R + R_XC, W + W_LRU, 1024, 256, 256, NPAN, 2, 8, 0, 1); } }
#ifndef MERGE_KSPLIT
#define MERGE_KSPLIT 1
#endif
#ifndef CVT_IN_MERGE
#define CVT_IN_MERGE 0
#endif
#ifndef SCAN_V
#define SCAN_V 2
#endif
    if constexpr (KIND == 9) { if (pass < 2) { if (SCAN_V == 2) ph_rwkv_scan2(F, l, pass); else ph_rwkv_scan(F, l); } if (pass != 1) ph_lru_scan(F, l, pass == 0); }
    if constexpr (KIND == 10) { ph_rwkv_readout(F, l); ph_lru_readout(F); }
    if constexpr (KIND == 11) { { pg8::EpiBf16 e{(bf16_t*)(R + R_Q), 3072, 0, nullptr, 1 << 30, 0}; GEMM(pg8::EpiBf16, e, R + R_QL, W + W_UQ, 512, 512, 512, NP, 12, 1, PM, 0); }
                                { pg8::EpiBf16 e{(bf16_t*)(R + R_KN), 2048, 0, (bf16_t*)(R + R_V), 8, 2048}; GEMM(pg8::EpiBf16, e, R + R_KVC, W + W_UKV, 256, 256, 256, NPAN, 16, 1, 0, 0); } }
    if constexpr (KIND == 12) { ph_attn(F, l + 1 < DEPTH, lds_gen);
                                { pg8::EpiGate e{(bf16_t*)(R + R_GATE), F.in[I_GATEB] + (size_t)l * GATE_IN, GATE_IN}; GEMM(pg8::EpiGate, e, H, W + W_ING, D, D, D, NP, 24, 1, PM, 0); } }
    if constexpr (KIND == 13) { pg8::EpiMergeOne e{(const bf16_t*)(R + R_GATE), (bf16_t*)(R + R_Y2B), 16, 48, (LAS unsigned*)(F.lds + LDSCTL_OFF + 64)}; GEMM(pg8::EpiMergeOne, e, YC, W + W_PROJ, 4096, 4096, 4096, 64, 8, 1, MERGE_KSPLIT ? PMS : PM, 0);
#if CVT_IN_MERGE
                                if (!lastl && !pass) { const int nwg = NP * 8, nlast = nwg - ((nwg - 1) / G) * G, i0 = (2 * nlast < G) ? nlast : 0;
                                    __syncthreads(); if (bx >= i0) ph_cvt_m(F, l + 1, CVT_EARLY, (bx - i0) * 8 + F.wave, (G - i0) * 8, false); }
#endif
                              }
    if constexpr (KIND == 14) { pg8::EpiResid e{X, modl + 5 * 2048, pass ? 0.f : 1.0f * DBG_MIX, pass ? 1.f : ALPHA, 3 * l + 1, nullptr}; GEMM(pg8::EpiResid, e, R + R_Y2B, W + W_OUT, D, D, D, 64, 8, 1, PMS, 0); }
    if constexpr (KIND == 15) { ph_ln(F, lng + D, lnb + D, modl, 6, 7, false, lastl, (lastl || pass) ? nullptr : PART, modl + 5 * 2048, 1.0f * DBG_MIX, 3 * l + 1); }
    if constexpr (KIND == 16) { pg8::EpiSwiGLU e{(bf16_t*)(R + R_ACT), DFF}; GEMM(pg8::EpiSwiGLU, e, H, W + W_GU1, D, D, D, NP, 44, 1, PM, 0); }
    if constexpr (KIND == 17) { pg8::EpiResid e{X, modl + 8 * 2048, pass ? 0.f : 0.5f * DBG_FFN, pass ? 1.f : ALPHA, 3 * l + 2, nullptr}; GEMM(pg8::EpiResid, e, R + R_ACT, W + W_D1, DFF, DFF, DFF, 64, 8, 1, PMS, 0);
                                if (!lastl && !pass) { __syncthreads(); ph_cvt_m(F, l + 1, CVT_IN_MERGE ? CVT_MID : 0xFull, bx * 8 + F.wave, G * 8, false); } }
    if constexpr (KIND == 18) { ph_ln(F, lng + 2 * D, lnb + 2 * D, modl + 5 * 18432, 0, 1, l + 1 == DEPTH, false, lastl ? nullptr : PART, modl + 8 * 2048, 0.5f * DBG_FFN, 3 * l + 2); if (l + 1 < DEPTH) { __syncthreads(); ph_cvt_m(F, l + 1, CVT_IN_MERGE ? CVT_LATE : (CVT_ALL & ~0xFull)); } }
}
#if MK_MULTI
template <int KIND> __global__ void __launch_bounds__(512, 2) k_one(Args args, int l) {
    extern __shared__ __attribute__((aligned(16))) unsigned char lds_[];
    run_phase<KIND>(args, l, lds_);
}
#else
__device__ __forceinline__ void grid_bar(const Args& args, unsigned char* lds_) {
    XcdBarrier bar; bar.bar = (unsigned*)(args.ws + WS_CTL); bar.x = xb_xcc_id(); bar.st = (volatile LAS unsigned*)((LAS unsigned char*)lds_ + LDSCTL_OFF) + 8;
    xcd_barrier(bar);
}
__global__ void __launch_bounds__(512, 2) fwd(Args args) {
    extern __shared__ __attribute__((aligned(16))) unsigned char lds_[];
    { volatile LAS unsigned* MISC = (volatile LAS unsigned*)((LAS unsigned char*)lds_ + LDSCTL_OFF);
      for (int u = threadIdx.x; u < 256; u += 512) MISC[u] = 0u;
      __syncthreads();
      (void)xcd_barrier_post((unsigned*)(args.ws + WS_CTL), MISC + 8); }
#ifndef REP3
#define REP3 1
#endif
#ifndef REP4
#define REP4 1
#endif
#ifndef REP6
#define REP6 1
#endif
#ifndef REP7
#define REP7 1
#endif
#ifndef REP8
#define REP8 1
#endif
#ifndef REP9
#define REP9 1
#endif
#ifndef REP10
#define REP10 1
#endif
#ifndef REP11
#define REP11 1
#endif
#ifndef REP12
#define REP12 1
#endif
#ifndef REP19
#define REP19 1
#endif
#ifndef REP13
#define REP13 1
#endif
#ifndef REP14
#define REP14 1
#endif
#ifndef REP16
#define REP16 1
#endif
#ifndef REP17
#define REP17 1
#endif
#define PH(K, l) run_phase<K>(args, l, lds_); grid_bar(args, lds_);
#define PHR(K, l, REP) for (int rep_ = 0; rep_ < (REP); ++rep_) { run_phase<K>(args, l, lds_, rep_); grid_bar(args, lds_); }
#ifndef REP0
#define REP0 1
#endif
#ifndef REP9L
#define REP9L 0
#endif
#ifndef REPLN
#define REPLN 1
#endif
#ifndef REPBAR
#define REPBAR 0
#endif
#ifndef REP2
#define REP2 1
#endif
    PHR(0, 0, REP0) PH(1, 0) PHR(2, 0, REP2)
    for (int rb_ = 0; rb_ < REPBAR; ++rb_) grid_bar(args, lds_);
    for (int l = 0; l < DEPTH; ++l) {
        PHR(3, l, REP3) PHR(4, l, REP4) PHR(5, l, REPLN) PHR(6, l, REP6) PHR(7, l, REP7) PHR(8, l, REP8) PHR(9, l, REP9) if (REP9L) { run_phase<9>(args, l, lds_, 2); grid_bar(args, lds_); } PHR(10, l, REP10) PHR(11, l, REP11) PHR(12, l, REP12) PHR(13, l, REP13) PHR(14, l, REP14) PHR(15, l, REPLN) PHR(16, l, REP16) PHR(17, l, REP17)
        run_phase<18>(args, l, lds_); if (l + 1 < DEPTH) grid_bar(args, lds_);
    }
#undef PHR
#undef PH
}
#endif


#if MK_MULTI
template <int K> static void launch_kind(int grid, hipStream_t stream, const Args& a, int l) {
    static bool attr = false;
    if (!attr) { (void)hipFuncSetAttribute((const void*)k_one<K>, hipFuncAttributeMaxDynamicSharedMemorySize, LDS_BYTES); attr = true; }
    hipLaunchKernelGGL(k_one<K>, dim3(grid), dim3(512), LDS_BYTES, stream, a, l);
}
template <int K> static void launch_layer(int grid, hipStream_t stream, const Args& a, int l) { if constexpr (K <= 18) { launch_kind<K>(grid, stream, a, l); if (K == 12) {
#if defined(DBG_PROBE)
        if (DBG_PROBE == 1 && l == 0) hipLaunchKernelGGL(k_dbg_gate, dim3(32), dim3(256), 0, stream, a, l);
        if (DBG_PROBE >= 6 && DBG_PROBE <= 11 && l == 0) { (void)hipMemsetAsync((char*)a.ws + WS_CTL + 8201 * 4, 0xff, 4, stream); hipLaunchKernelGGL(k_dbg_gate_tiles, dim3(68 * 24), dim3(256), 0, stream, a); hipLaunchKernelGGL(k_dbg_tiles_fin, dim3(1), dim3(64), 0, stream, a, DBG_PROBE); }
        if (DBG_PROBE >= 3 && DBG_PROBE <= 5 && l == 0) { (void)hipMemsetAsync((char*)a.ws + WS_CTL + 8201 * 4, 0xff, 4, stream); hipLaunchKernelGGL(k_dbg_gate_range, dim3(1024), dim3(256), 0, stream, a, DBG_PROBE); hipLaunchKernelGGL(k_dbg_range_fin, dim3(1), dim3(64), 0, stream, a, DBG_PROBE); }
#endif
        }
#if defined(DBG_PROBE)
        if (K == 6 && DBG_PROBE == 2 && l == 0) hipLaunchKernelGGL(k_dbg_fa, dim3(32), dim3(256), 0, stream, a, l);
        if (K == 4 && DBG_PROBE == 21 && l == 0) hipLaunchKernelGGL(k_dbg_ffn, dim3(96), dim3(256), 0, stream, a);
        if (K == 7 && DBG_PROBE == 24 && l == 0) hipLaunchKernelGGL(k_dbg_prep, dim3(16), dim3(256), 0, stream, a, l);
        if (K == 3 && DBG_PROBE == 23 && l == 0) hipLaunchKernelGGL(k_dbg_mod, dim3(8), dim3(256), 0, stream, a);
        if (K == 10 && DBG_PROBE == 22 && l == 0) hipLaunchKernelGGL(k_dbg_rwkv, dim3(32), dim3(64), 0, stream, a, l);
        if (K == 10 && DBG_PROBE == 20 && l == 0) hipLaunchKernelGGL(k_dbg_lru, dim3(4), dim3(64), 0, stream, a, l);
#endif
        launch_layer<K + 1>(grid, stream, a, l); } }
#endif
extern "C" void kernel_launch(void* const* d_in, const int* in_sizes, int n_in, void* d_out, int out_size, void* d_ws, size_t ws_size, hipStream_t stream) {
    static int grid = 0;
    if (grid == 0) {
        if (n_in != 40 || in_sizes[0] != NB * SEQ * D || out_size != NB * SEQ * D || ws_size < WS_END) {
            fprintf(stderr, "kernel_launch: shape mismatch: n_in %d in0 %d out %d ws %zu (need %zu); nothing launched\n", n_in, n_in > 0 ? in_sizes[0] : -1, out_size, ws_size, (size_t)WS_END); grid = -1; return; }
        int dev = 0, cus = 0;
        if (hipGetDevice(&dev) != hipSuccess || hipDeviceGetAttribute(&cus, hipDeviceAttributeMultiprocessorCount, dev) != hipSuccess) { grid = -1; return; }
#if !MK_MULTI
        int per_cu = 0;
        if (hipFuncSetAttribute((const void*)fwd, hipFuncAttributeMaxDynamicSharedMemorySize, LDS_BYTES) != hipSuccess) { fprintf(stderr, "kernel_launch: hipFuncSetAttribute failed\n"); grid = -1; return; }
        if (hipOccupancyMaxActiveBlocksPerMultiprocessor(&per_cu, (const void*)fwd, 512, LDS_BYTES) != hipSuccess || per_cu < 1) { fprintf(stderr, "kernel_launch: occupancy query says %d blocks per CU\n", per_cu); }
        (void)hipGetLastError();
#endif
        grid = cus;
    }
    if (grid < 0) return;
    if (hipMemsetAsync((char*)d_ws + WS_CTL, 0, CTL_BYTES, stream) != hipSuccess) return;
    Args a{};
    for (int i = 0; i < 40; ++i) a.in[i] = (const float*)d_in[i];
    a.out = (float*)d_out; a.ws = (unsigned char*)d_ws; a.ph_lo = 0; a.ph_hi = NPH;
#if MK_MULTI
    launch_kind<0>(grid, stream, a, 0); launch_kind<1>(grid, stream, a, 0); launch_kind<2>(grid, stream, a, 0);
    for (int l = 0; l < DEPTH; ++l) launch_layer<3>(grid, stream, a, l);
#if defined(DBG_PROBE)
    hipLaunchKernelGGL(k_dbg_final, dim3(1), dim3(64), 0, stream, a);
#endif
#else
    hipLaunchKernelGGL(fwd, dim3(grid), dim3(512), LDS_BYTES, stream, a);
#endif
    const hipError_t le = hipPeekAtLastError();
    if (le != hipSuccess) fprintf(stderr, "kernel_launch: launch failed: %s\n", hipGetErrorName(le));
}
```
